# Optimizing an MI355X kernel written in HIP

```python
import math
import jax, jax.numpy as jnp
from jax import lax
import numpy as np

D_MODEL = 4096
BATCH = 4
SEQ = 4096
DEPTH = 4

HEAD_DIM = 128
N_HEADS = D_MODEL // HEAD_DIM
N_RET_HEADS = (N_HEADS * 3) // 8
N_SB_HEADS = (N_HEADS - N_RET_HEADS) // 2
N_DIFF_HEADS = N_HEADS - N_RET_HEADS - N_SB_HEADS
RET_W = N_RET_HEADS * HEAD_DIM
SB_W = N_SB_HEADS * HEAD_DIM
DIFF_W = N_DIFF_HEADS * HEAD_DIM
MIX_W = RET_W + SB_W + DIFF_W
DIFF_QK_DIM = HEAD_DIM // 2
BLOCK = 128
DEEPNORM_ALPHA = (2.0 * DEPTH) ** 0.25
DEEPNORM_BETA = (8.0 * DEPTH) ** -0.25
LN_EPS = 1e-5

kernel_name = "hybrid_ret_sb_diff_deepnorm"


def _split_points():
    widths = [RET_W] * 4 + [SB_W] * 4 + [DIFF_W] * 4
    pts, acc = [], 0
    for w in widths[:-1]:
        acc += w
        pts.append(acc)
    return pts


def _alibi_slopes(n):
    def pow2(m):
        start = 2.0 ** (-8.0 / m)
        return [start ** (i + 1) for i in range(m)]
    if math.log2(n).is_integer():
        s = pow2(n)
    else:
        c = 2 ** math.floor(math.log2(n))
        s = pow2(c) + pow2(2 * c)[0::2][: n - c]
    return jnp.asarray(np.asarray(s, dtype=np.float32))


def _retention_log_decay(n):
    g = 1.0 - 2.0 ** (-5.0 - np.arange(n))
    return jnp.asarray(np.log(g).astype(np.float32))


def layer_norm(x, g, b):
    xf = x.astype(jnp.float32)
    mu = jnp.mean(xf, axis=-1, keepdims=True)
    xc = xf - mu
    var = jnp.mean(xc * xc, axis=-1, keepdims=True)
    return (xc * lax.rsqrt(var + LN_EPS)).astype(x.dtype) * g + b


def head_layer_norm(o):
    of = o.astype(jnp.float32)
    mu = jnp.mean(of, axis=-1, keepdims=True)
    oc = of - mu
    var = jnp.mean(oc * oc, axis=-1, keepdims=True)
    return oc * lax.rsqrt(var + LN_EPS)


def head_rms_norm(o):
    of = o.astype(jnp.float32)
    return of * lax.rsqrt(jnp.mean(of * of, axis=-1, keepdims=True) + LN_EPS)


def retention_chunkwise(q, k, v, log_gamma):
    B, S, H, Dh = q.shape
    n = S // BLOCK
    to_chunks = lambda a: a.reshape(B, n, BLOCK, H, Dh).transpose(1, 0, 3, 2, 4)
    qc, kc, vc = to_chunks(q), to_chunks(k), to_chunks(v)
    idx = jnp.arange(BLOCK, dtype=jnp.float32)
    rel = idx[:, None] - idx[None, :]
    causal = rel >= 0
    inner_decay = jnp.where(causal, jnp.exp(log_gamma[:, None, None] * jnp.where(causal, rel, 0.0)), 0.0)
    q_decay = jnp.exp(log_gamma[:, None] * (idx + 1.0))[None, :, :, None]
    k_decay = jnp.exp(log_gamma[:, None] * (BLOCK - 1.0 - idx))[None, :, :, None]
    chunk_decay = jnp.exp(log_gamma * BLOCK)[None, :, None, None]

    def step(state, inp):
        qb, kb, vb = inp
        scores = jnp.einsum('bhqd,bhkd->bhqk', qb, kb) * inner_decay
        inner = jnp.einsum('bhqk,bhkd->bhqd', scores, vb)
        cross = jnp.einsum('bhqd,bhde->bhqe', qb, state) * q_decay
        new_state = state * chunk_decay + jnp.einsum('bhkd,bhke->bhde', kb * k_decay, vb)
        return new_state, inner + cross

    state0 = jnp.zeros((B, H, Dh, Dh), jnp.float32)
    _, out = lax.scan(step, state0, (qc, kc, vc))
    return out.transpose(1, 0, 3, 2, 4).reshape(B, S, H, Dh)


def stick_breaking_attention(q, k, v):
    S, Dh = q.shape[2], q.shape[3]
    scale = Dh ** -0.5
    outs = []
    for blk in range(S // BLOCK):
        q0, kend = blk * BLOCK, (blk + 1) * BLOCK
        qb, kb, vb = q[:, :, q0:kend], k[:, :, :kend], v[:, :, :kend]
        z = jnp.einsum('bhqd,bhkd->bhqk', qb, kb).astype(jnp.float32) * scale
        t = q0 + jnp.arange(BLOCK)
        s = jnp.arange(kend)
        mask = s[None, :] < t[:, None]
        log_1mb = jnp.where(mask, jax.nn.log_sigmoid(-z), 0.0)
        cum = jnp.cumsum(log_1mb, axis=-1)
        log_a = jax.nn.log_sigmoid(z) + (cum[..., -1:] - cum)
        a = jnp.where(mask, jnp.exp(log_a), 0.0)
        outs.append(jnp.einsum('bhqk,bhkd->bhqd', a.astype(vb.dtype), vb))
    return jnp.concatenate(outs, axis=2)


def differential_attention(q1, q2, k1, k2, v, lam, slopes):
    S = q1.shape[2]
    scale = q1.shape[3] ** -0.5
    outs = []
    for blk in range(S // BLOCK):
        q0, kend = blk * BLOCK, (blk + 1) * BLOCK
        t = q0 + jnp.arange(BLOCK)
        s = jnp.arange(kend)
        rel = (t[:, None] - s[None, :]).astype(jnp.float32)
        causal = rel >= 0
        bias = -slopes[:, None, None] * rel

        def probs(qx, kx):
            z = jnp.einsum('bhqd,bhkd->bhqk', qx[:, :, q0:kend], kx[:, :, :kend]).astype(jnp.float32) * scale + bias
            return jax.nn.softmax(jnp.where(causal, z, -jnp.inf), axis=-1)

        a = probs(q1, k1) - lam * probs(q2, k2)
        vb = v[:, :, :kend]
        outs.append(jnp.einsum('bhqk,bhkd->bhqd', a.astype(vb.dtype), vb))
    return jnp.concatenate(outs, axis=2)


def setup_inputs(seed: int = 0) -> dict:
    key = jax.random.key(seed)
    ks = jax.random.split(key, 12)
    f32 = jnp.float32
    x = jax.random.normal(ks[0], (BATCH, SEQ, D_MODEL), f32)
    w_in = jax.random.normal(ks[1], (DEPTH, D_MODEL, 4 * MIX_W), f32) * (D_MODEL ** -0.5)
    w_out = jax.random.normal(ks[2], (DEPTH, MIX_W, D_MODEL), f32) * ((MIX_W ** -0.5) * DEEPNORM_BETA)
    ln_g = 1.0 + 0.02 * jax.random.normal(ks[3], (DEPTH, D_MODEL), f32)
    ln_b = 0.02 * jax.random.normal(ks[4], (DEPTH, D_MODEL), f32)
    ret_gn_g = 1.0 + 0.02 * jax.random.normal(ks[5], (DEPTH, RET_W), f32)
    diff_ln_g = 1.0 + 0.02 * jax.random.normal(ks[6], (DEPTH, DIFF_W), f32)
    lam_q1 = 0.1 * jax.random.normal(ks[7], (DEPTH, DIFF_QK_DIM), f32)
    lam_k1 = 0.1 * jax.random.normal(ks[8], (DEPTH, DIFF_QK_DIM), f32)
    lam_q2 = 0.1 * jax.random.normal(ks[9], (DEPTH, DIFF_QK_DIM), f32)
    lam_k2 = 0.1 * jax.random.normal(ks[10], (DEPTH, DIFF_QK_DIM), f32)
    return {"x": x, "w_in": w_in, "w_out": w_out, "ln_g": ln_g, "ln_b": ln_b,
            "ret_gn_g": ret_gn_g, "diff_ln_g": diff_ln_g,
            "lam_q1": lam_q1, "lam_k1": lam_k1, "lam_q2": lam_q2, "lam_k2": lam_k2}


def reference(x, w_in, w_out, ln_g, ln_b, ret_gn_g, diff_ln_g, lam_q1, lam_k1, lam_q2, lam_k2):
    B, S, _ = x.shape
    log_gamma = _retention_log_decay(N_RET_HEADS)
    slopes = _alibi_slopes(N_DIFF_HEADS)
    split_pts = _split_points()
    to_heads = lambda a, h: a.reshape(B, S, h, HEAD_DIM)
    bhsd = lambda a: a.transpose(0, 2, 1, 3)

    for layer in range(DEPTH):
        proj = jnp.einsum('bsd,de->bse', x, w_in[layer])
        (r_q, r_k, r_v, r_g, s_q, s_k, s_v, s_g, d_q, d_k, d_v, d_g) = jnp.split(proj, split_pts, axis=-1)

        rq = to_heads(r_q, N_RET_HEADS)
        rk = to_heads(r_k, N_RET_HEADS) * (HEAD_DIM ** -0.5)
        rv = to_heads(r_v, N_RET_HEADS)
        ro = retention_chunkwise(rq, rk, rv, log_gamma)
        ro = head_layer_norm(ro).reshape(B, S, RET_W).astype(x.dtype) * ret_gn_g[layer]
        ro = ro * jax.nn.silu(r_g)

        so = stick_breaking_attention(bhsd(to_heads(s_q, N_SB_HEADS)), bhsd(to_heads(s_k, N_SB_HEADS)),
                                      bhsd(to_heads(s_v, N_SB_HEADS)))
        so = so.transpose(0, 2, 1, 3).reshape(B, S, SB_W) * jax.nn.silu(s_g)

        lambda_init = 0.8 - 0.6 * math.exp(-0.3 * layer)
        lam = (jnp.exp(jnp.sum(lam_q1[layer].astype(jnp.float32) * lam_k1[layer].astype(jnp.float32)))
               - jnp.exp(jnp.sum(lam_q2[layer].astype(jnp.float32) * lam_k2[layer].astype(jnp.float32)))
               + lambda_init)
        dq = bhsd(to_heads(d_q, N_DIFF_HEADS))
        dk = bhsd(to_heads(d_k, N_DIFF_HEADS))
        dv = bhsd(to_heads(d_v, N_DIFF_HEADS))
        do = differential_attention(dq[..., :DIFF_QK_DIM], dq[..., DIFF_QK_DIM:],
                                    dk[..., :DIFF_QK_DIM], dk[..., DIFF_QK_DIM:], dv, lam, slopes)
        do = head_rms_norm(do.transpose(0, 2, 1, 3)).reshape(B, S, DIFF_W).astype(x.dtype)
        do = do * diff_ln_g[layer] * (1.0 - lambda_init) * jax.nn.silu(d_g)

        mixed = jnp.concatenate([ro, so, do.astype(ro.dtype)], axis=-1)
        y = jnp.einsum('bse,ed->bsd', mixed, w_out[layer]).astype(x.dtype)
        x = layer_norm(DEEPNORM_ALPHA * x + y, ln_g[layer], ln_b[layer])
    return x
```

```cpp
#include <hip/hip_runtime.h>
#include <cstdio>
#include <cstdint>
namespace pg8 {
#define PG8_LAS __attribute__((address_space(3)))
typedef unsigned short bf16_t;
typedef short bf16x8 __attribute__((ext_vector_type(8)));
typedef float f32x4 __attribute__((ext_vector_type(4)));
typedef unsigned u32x4 __attribute__((ext_vector_type(4)));
constexpr int BM = 256, BK = 64, HALF = 128, HTB = HALF * BK * 2  , STAGE_BYTES = 8 * HTB, NXCD = 8, WGM = 8;

__host__ __device__ __forceinline__ int lds_byte(int r, int c) { const int st = (r >> 4) * 2 + (c >> 5), rr = r & 15, cc = c & 31, ob = rr * 64 + cc * 2; return st * 1024 + (ob ^ (((ob >> 9) & 1) << 5)); }
__host__ __device__ __forceinline__ void stage_rc(int b, int& R, int& C) { const int st = b / 1024, sb = b % 1024, swz = sb ^ (((sb >> 9) & 1) << 5); R = (st >> 1) * 16 + swz / 64; C = (st & 1) * 32 + (swz % 64) / 2; }
__host__ __device__ __forceinline__ int perm32(int rho) { const int n = rho >> 4, i = rho & 15; return 8 * (i >> 2) + 4 * n + (i & 3); }

struct Unit { int pm, pn; };
struct Gemm { const bf16_t* A; const bf16_t* Bt; int M, N, K; };

struct StaticOrder {
    int nM, nN, nwg, G, c;
    __host__ __device__ void init(int M, int N, int G_, int c_) { nM = M / BM; nN = N / BM; nwg = nM * nN; G = G_; c = c_; }
    __host__ __device__ bool next(int i, Unit& u) const {
        const long L = (long)i * G + c; if (L >= nwg) return false;
        int wgid = (int)L; { const int q = nwg / NXCD, r = nwg % NXCD, xcd = wgid % NXCD, off = wgid / NXCD; wgid = (xcd < r ? xcd * (q + 1) : r * (q + 1) + (xcd - r) * q) + off; }
        const int nig = WGM * nN, gid = wgid / nig, fm = gid * WGM, gsz = (nM - fm) < WGM ? (nM - fm) : WGM;
        u.pm = fm + ((wgid % nig) % gsz); u.pn = (wgid % nig) / gsz; return true;
    }
    __device__ __forceinline__ void a_ready(const Unit&) const {}
    __device__ __forceinline__ void done(const Unit&) const {}
};
struct PanelOrder {
    int nM, c;
    __host__ __device__ void init(int M, int c_) { nM = M / BM; c = c_; }
    __host__ __device__ bool next(int i, Unit& u) const { if (16 * i >= nM) return false; const int x = c & 7, t = c >> 3; u.pm = 16 * i + 4 * (x >> 1) + (t >> 3); u.pn = 8 * (x & 1) + (t & 7); return true; }
    __device__ __forceinline__ void a_ready(const Unit&) const {}
    __device__ __forceinline__ void done(const Unit&) const {}
};
__device__ __forceinline__ unsigned cvt_pk_bf16(float lo, float hi) { unsigned r; asm volatile("v_cvt_pk_bf16_f32 %0, %1, %2" : "=v"(r) : "v"(lo), "v"(hi)); return r; }
struct EpiBf16 {
    static constexpr bool PERM = true, AFTER_DRAIN = false;
    bf16_t* O; int ldc; int sc_lo, sc_hi; float sc; int sd_lo, sd_hi; float sd;
    __device__ __forceinline__ void operator()(const f32x4 (&acc)[2][2][4][2], const Unit& u, int wr, int wc, int fr, int fq) const {
        const int row0 = u.pm * BM + wr * 64 + fr; const int col0 = u.pn * BM + wc * 32 + 8 * fq;
        const float s = (u.pn >= sc_lo && u.pn < sc_hi) ? sc : ((u.pn >= sd_lo && u.pn < sd_hi) ? sd : 1.0f);
#pragma unroll
        for (int ai = 0; ai < 2; ++ai)
#pragma unroll
            for (int m = 0; m < 4; ++m) { bf16_t* rowp = O + (size_t)(row0 + ai * HALF + m * 16) * ldc + col0;
#pragma unroll
                for (int bj = 0; bj < 2; ++bj) { const f32x4 v0 = acc[ai][bj][m][0] * s, v1 = acc[ai][bj][m][1] * s;
                    u32x4 w; w.x = cvt_pk_bf16(v0[0], v0[1]); w.y = cvt_pk_bf16(v0[2], v0[3]); w.z = cvt_pk_bf16(v1[0], v1[1]); w.w = cvt_pk_bf16(v1[2], v1[3]);
                    *(u32x4*)(rowp + bj * HALF) = w; } }
    }
};

__device__ __forceinline__ float xsum16(float x) {
    auto s = __builtin_amdgcn_permlane16_swap(__float_as_uint(x), __float_as_uint(x), false, false); x = __uint_as_float(s[0]) + __uint_as_float(s[1]);
    auto t = __builtin_amdgcn_permlane32_swap(__float_as_uint(x), __float_as_uint(x), false, false); return __uint_as_float(t[0]) + __uint_as_float(t[1]);
}
struct EpiLnFused {
    static constexpr bool PERM = false, AFTER_DRAIN = false;
    const float* X; float* XO; bf16_t* XBo; int ldc; float alpha; const float* gamma; const float* beta;
    unsigned long long* slots; unsigned* cnt; unsigned* tmo; PG8_LAS unsigned char* tab; int wave;
    __device__ __forceinline__ void operator()(f32x4 (&acc)[2][2][4][2], const Unit& u, int wr, int wc, int fr, int fq) const {
        typedef float f32x2v __attribute__((ext_vector_type(2)));
        const int row0 = u.pm * BM + wr * 64 + fr, col0 = u.pn * BM + wc * 32 + 4 * fq;
        PG8_LAS f32x2v* P = (PG8_LAS f32x2v*)tab;
        PG8_LAS f32x2v* S = (PG8_LAS f32x2v*)(tab + 8192);
        f32x4 xv[4][2][2];
        const unsigned ptab = (unsigned)(size_t)tab + (unsigned)((wr * 64 + fr) * 4 + wc) * 8u;
#define LNF_LDX(Q) do { const float* p_ = X + (size_t)(row0 + ((Q) >> 2) * HALF + ((Q) & 3) * 16) * ldc + col0; \
            asm volatile("global_load_dwordx4 %0, %4, off\n\tglobal_load_dwordx4 %1, %4, off offset:64\n\tglobal_load_dwordx4 %2, %4, off offset:512\n\tglobal_load_dwordx4 %3, %4, off offset:576" \
                         : "=&v"(xv[(Q) & 3][0][0]), "=&v"(xv[(Q) & 3][0][1]), "=&v"(xv[(Q) & 3][1][0]), "=&v"(xv[(Q) & 3][1][1]) : "v"(p_) : "memory"); } while (0)
#define LNF_WAIT(Q, N) asm volatile("s_waitcnt vmcnt(" #N ")" : "+v"(xv[(Q) & 3][0][0]), "+v"(xv[(Q) & 3][0][1]), "+v"(xv[(Q) & 3][1][0]), "+v"(xv[(Q) & 3][1][1]) :: "memory")
        static_assert(HALF == 128, "row offsets of the residual loads");
        LNF_LDX(0); LNF_LDX(1); LNF_LDX(2); LNF_LDX(3);
#pragma unroll
        for (int q = 0; q < 8; ++q) { const int ai = q >> 2, m = q & 3;
            if (q <= 4) LNF_WAIT(q, 12); else if (q == 5) LNF_WAIT(q, 8); else if (q == 6) LNF_WAIT(q, 4); else LNF_WAIT(q, 0);
            float s = 0.f, ss = 0.f;
#pragma unroll
            for (int bj = 0; bj < 2; ++bj)
#pragma unroll
                for (int n = 0; n < 2; ++n) { const f32x4 h = acc[ai][bj][m][n] + xv[q & 3][bj][n] * alpha; acc[ai][bj][m][n] = h;
                    s += (h[0] + h[1]) + (h[2] + h[3]); ss += (h[0] * h[0] + h[1] * h[1]) + (h[2] * h[2] + h[3] * h[3]); }
            if (q + 4 < 8) LNF_LDX(q + 4);
            s = xsum16(s); ss = xsum16(ss);
            if (fq == 0) { const f32x2v v_ = (f32x2v){s, ss}; asm volatile("ds_write_b64 %0, %1 offset:%2" :: "v"(ptab), "v"(v_), "n"((ai * HALF + m * 16) * 32) : "memory"); } }
#undef LNF_LDX
#undef LNF_WAIT
        asm volatile("s_waitcnt lgkmcnt(0)" ::: "memory"); __builtin_amdgcn_s_barrier(); asm volatile("" ::: "memory");
        const int lane = fr + 16 * fq, row = wave * 64 + lane;
        if (wave < 4) {
            const f32x2v a = P[row * 4 + 0], b = P[row * 4 + 1], c = P[row * 4 + 2], d = P[row * 4 + 3];
            const float s = (a.x + b.x) + (c.x + d.x), ss = (a.y + b.y) + (c.y + d.y);
            __hip_atomic_store(slots + ((size_t)(u.pm * BM + row) * 16 + u.pn), ((unsigned long long)__float_as_uint(ss) << 32) | __float_as_uint(s), __ATOMIC_RELAXED, __HIP_MEMORY_SCOPE_AGENT);
            asm volatile("s_waitcnt vmcnt(0)" ::: "memory");
        }
        __builtin_amdgcn_s_barrier(); asm volatile("" ::: "memory");
        if (wave == 0) {
            if (lane == 0) __hip_atomic_fetch_add(cnt + 64 * u.pm, 1u, __ATOMIC_RELAXED, __HIP_MEMORY_SCOPE_AGENT);
            unsigned spins = 0;
            while ((unsigned)__builtin_amdgcn_readfirstlane(__hip_atomic_load(cnt + 64 * u.pm, __ATOMIC_RELAXED, __HIP_MEMORY_SCOPE_AGENT)) < 16u) {
                if (++spins > (1u << 22)) { if (lane == 0) __hip_atomic_store(tmo, 1u, __ATOMIC_RELAXED, __HIP_MEMORY_SCOPE_AGENT); break; }
                __builtin_amdgcn_s_sleep(8); }
            __builtin_amdgcn_fence(__ATOMIC_ACQUIRE, "agent");
        }
        asm volatile("s_waitcnt vmcnt(0) lgkmcnt(0)" ::: "memory"); __builtin_amdgcn_s_barrier(); asm volatile("" ::: "memory");
        if (wave < 4) {
            const unsigned long long* sl = slots + (size_t)(u.pm * BM + row) * 16; float s = 0.f, ss = 0.f;
            f32x4 w[8];
            asm volatile("global_load_dwordx4 %0, %8, off sc1\n\tglobal_load_dwordx4 %1, %8, off offset:16 sc1\n\tglobal_load_dwordx4 %2, %8, off offset:32 sc1\n\tglobal_load_dwordx4 %3, %8, off offset:48 sc1\n\t"
                         "global_load_dwordx4 %4, %8, off offset:64 sc1\n\tglobal_load_dwordx4 %5, %8, off offset:80 sc1\n\tglobal_load_dwordx4 %6, %8, off offset:96 sc1\n\tglobal_load_dwordx4 %7, %8, off offset:112 sc1\n\t"
                         "s_waitcnt vmcnt(0)"
                         : "=&v"(w[0]), "=&v"(w[1]), "=&v"(w[2]), "=&v"(w[3]), "=&v"(w[4]), "=&v"(w[5]), "=&v"(w[6]), "=&v"(w[7]) : "v"(sl) : "memory");
#pragma unroll
            for (int t = 0; t < 8; ++t) { s += w[t][0] + w[t][2]; ss += w[t][1] + w[t][3]; }
            const float mean = s * (1.0f / 4096.0f), var = fmaxf(ss * (1.0f / 4096.0f) - mean * mean, 0.f);
            S[row] = (f32x2v){mean, 1.0f / sqrtf(var + 1e-5f)};
        }
        asm volatile("s_waitcnt lgkmcnt(0)" ::: "memory"); __builtin_amdgcn_s_barrier(); asm volatile("" ::: "memory");
        f32x4 gv[2][2], bv[2][2];
#pragma unroll
        for (int bj = 0; bj < 2; ++bj)
#pragma unroll
            for (int n = 0; n < 2; ++n) { gv[bj][n] = *(const f32x4*)(gamma + col0 + bj * HALF + n * 16); bv[bj][n] = *(const f32x4*)(beta + col0 + bj * HALF + n * 16); }
#pragma unroll
        for (int ai = 0; ai < 2; ++ai)
#pragma unroll
            for (int m = 0; m < 4; ++m) { const int r = ai * HALF + wr * 64 + m * 16 + fr; const f32x2v sr = S[r]; const size_t off = (size_t)(u.pm * BM + r) * ldc + col0;
#pragma unroll
                for (int bj = 0; bj < 2; ++bj)
#pragma unroll
                    for (int n = 0; n < 2; ++n) { const f32x4 y = ((acc[ai][bj][m][n] - sr.x) * sr.y) * gv[bj][n] + bv[bj][n];
                        *(f32x4*)(XO + off + bj * HALF + n * 16) = y;
                        if (XBo) { typedef unsigned u32x2v __attribute__((ext_vector_type(2))); u32x2v w; w.x = cvt_pk_bf16(y[0], y[1]); w.y = cvt_pk_bf16(y[2], y[3]); *(u32x2v*)(XBo + off + bj * HALF + n * 16) = w; } } }
    }
};

template <class Epi, class Sched, bool ALIGN_EPI = false, bool SP2 = false>
__device__ __forceinline__ void gemm_phase(PG8_LAS unsigned char* lds, const Gemm g, const Sched& S, const Epi& E, int wave_id  ) {
    int tid_; asm volatile("v_mbcnt_lo_u32_b32 %0, -1, 0\n\tv_mbcnt_hi_u32_b32 %0, -1, %0" : "=v"(tid_)); tid_ += 64 * wave_id;
    const int tid = tid_, wid = __builtin_amdgcn_readfirstlane(tid >> 6), lane = tid & 63, wr = wid >> 2, wc = wid & 3, fr = lane & 15, fq = lane >> 4;
    const int K = g.K, nt = K / BK;
    unsigned voffA[2], voffB[2];
#pragma unroll
    for (int i = 0; i < 2; ++i) { int R, C; stage_rc(tid * 16 + i * 8192, R, C); const int Rb = Epi::PERM ? ((R & ~31) + perm32(R & 31)) : R;
        voffA[i] = (unsigned)(R * K + C) * 2u; voffB[i] = (unsigned)(Rb * K + C) * 2u; }
    const size_t kstep = (size_t)(BK * 2);
    const size_t hstep = (size_t)HALF * K * 2;
    const size_t tstep = 2 * hstep;
    const unsigned ldsw = (unsigned)wid * 1024u;
    const int aoff = lds_byte(wr * 64 + fr, fq * 8), boff = lds_byte(wc * 32 + fr, fq * 8);
#define PG8_SA(b, h) (((b) * 2 + (h)) * HTB)
#define PG8_SB(b, h) ((4 + (b) * 2 + (h)) * HTB)
#define PG8_STAGE(bufoff, gbase, voff) do { _Pragma("unroll") for (int _i = 0; _i < 2; ++_i) \
        __builtin_amdgcn_global_load_lds((const unsigned*)((const char*)(gbase) + (voff)[_i]), (PG8_LAS unsigned*)(lds + (bufoff) + ldsw + _i * 8192), 16, 0, 0); } while (0)
#define PG8_LDA(dst, b, h) do { _Pragma("unroll") for (int m = 0; m < 4; ++m) _Pragma("unroll") for (int k = 0; k < 2; ++k) dst[m][k] = *(const PG8_LAS bf16x8*)(lds + PG8_SA(b, h) + aoff + m * 2048 + k * 1024); } while (0)
#define PG8_LDB(dst, b, h) do { _Pragma("unroll") for (int n = 0; n < 2; ++n) _Pragma("unroll") for (int k = 0; k < 2; ++k) dst[n][k] = *(const PG8_LAS bf16x8*)(lds + PG8_SB(b, h) + boff + n * 2048 + k * 1024); } while (0)
#define PG8_MMA(ai, bj, At, Bt) do { __builtin_amdgcn_s_setprio(1); _Pragma("unroll") for (int m = 0; m < 4; ++m) _Pragma("unroll") for (int n = 0; n < 2; ++n) _Pragma("unroll") for (int k = 0; k < 2; ++k) \
        acc[ai][bj][m][n] = __builtin_amdgcn_mfma_f32_16x16x32_bf16(Bt[n][k], At[m][k], acc[ai][bj][m][n], 0, 0, 0); __builtin_amdgcn_s_setprio(0); } while (0)
#define PG8_WAIT_V(n) asm volatile("s_waitcnt vmcnt(" #n ")" ::: "memory")
#define PG8_WAIT_L(n) asm volatile("s_waitcnt lgkmcnt(" #n ")" ::: "memory")
#define PG8_BAR __builtin_amdgcn_s_barrier()
#define PG8_SCHED __builtin_amdgcn_sched_barrier(0)
    Unit cur, nxt; int ui = 0;
    if (!S.next(0, cur)) return;
    f32x4 acc[2][2][4][2];
#pragma unroll
    for (int a = 0; a < 2; ++a)
#pragma unroll
        for (int b = 0; b < 2; ++b)
#pragma unroll
            for (int m = 0; m < 4; ++m)
#pragma unroll
                for (int n = 0; n < 2; ++n) acc[a][b][m][n] = (f32x4){0.f, 0.f, 0.f, 0.f};
    bf16x8 At[4][2], B0[2][2], B1[2][2];
    const char* cA = (const char*)g.A + (size_t)cur.pm * tstep; const char* cB = (const char*)g.Bt + (size_t)cur.pn * tstep;
    S.a_ready(cur);
    if constexpr (SP2) {
        PG8_STAGE(PG8_SB(0, 0), cB, voffB); PG8_STAGE(PG8_SB(0, 1), cB + hstep, voffB); PG8_STAGE(PG8_SA(0, 0), cA, voffA); PG8_STAGE(PG8_SA(0, 1), cA + hstep, voffA);
        if (wr == 1) PG8_BAR;
        PG8_WAIT_V(2); PG8_BAR;
        PG8_STAGE(PG8_SB(1, 0), cB + kstep, voffB); PG8_STAGE(PG8_SA(1, 0), cA + kstep, voffA); PG8_STAGE(PG8_SB(1, 1), cB + hstep + kstep, voffB);
        PG8_WAIT_V(6); PG8_BAR;
    } else {
        PG8_STAGE(PG8_SB(0, 0), cB, voffB); PG8_STAGE(PG8_SA(0, 0), cA, voffA); PG8_STAGE(PG8_SB(0, 1), cB + hstep, voffB); PG8_STAGE(PG8_SA(0, 1), cA + hstep, voffA);
        if (wr == 1) PG8_BAR;
        PG8_WAIT_V(4); PG8_BAR;
        PG8_STAGE(PG8_SB(1, 0), cB + kstep, voffB); PG8_STAGE(PG8_SA(1, 0), cA + kstep, voffA); PG8_STAGE(PG8_SB(1, 1), cB + hstep + kstep, voffB);
        PG8_WAIT_V(6); PG8_BAR;
    }
    for (;;) {
        const bool has_next = S.next(ui + 1, nxt);
        const char* nA = has_next ? (const char*)g.A + (size_t)nxt.pm * tstep : cA; const char* nB = has_next ? (const char*)g.Bt + (size_t)nxt.pn * tstep : cB;
        for (int t = 0; t < nt; t += 2) {
            const bool last = (t == nt - 2);
            const char* a1 = cA + (size_t)(t + 1) * kstep;
            const char* a2 = last ? nA : cA + (size_t)(t + 2) * kstep; const char* b2 = last ? nB : cB + (size_t)(t + 2) * kstep;
            const char* a3 = a2 + kstep; const char* b3 = b2 + kstep;
            if (last && has_next) S.a_ready(nxt);
            if constexpr (SP2) {
            PG8_LDB(B0, 0, 0); PG8_LDB(B1, 0, 1); PG8_SCHED; PG8_LDA(At, 0, 0); PG8_STAGE(PG8_SA(1, 1), a1 + hstep, voffA);
            PG8_WAIT_V(8); PG8_WAIT_L(0); PG8_BAR; PG8_MMA(0, 0, At, B0); PG8_MMA(0, 1, At, B1); PG8_BAR; PG8_SCHED;
            PG8_LDA(At, 0, 1); PG8_STAGE(PG8_SB(0, 0), b2, voffB); PG8_STAGE(PG8_SB(0, 1), b2 + hstep, voffB); PG8_STAGE(PG8_SA(0, 0), a2, voffA);
            PG8_WAIT_V(8); PG8_WAIT_L(0); PG8_BAR; PG8_MMA(1, 0, At, B0); PG8_MMA(1, 1, At, B1); PG8_BAR; PG8_SCHED;
            PG8_LDB(B0, 1, 0); PG8_LDB(B1, 1, 1); PG8_SCHED; PG8_LDA(At, 1, 0); PG8_STAGE(PG8_SA(0, 1), a2 + hstep, voffA);
            PG8_WAIT_V(8); PG8_WAIT_L(0); PG8_BAR; PG8_MMA(0, 0, At, B0); PG8_MMA(0, 1, At, B1); PG8_BAR; PG8_SCHED;
            PG8_LDA(At, 1, 1); PG8_STAGE(PG8_SB(1, 0), b3, voffB); PG8_STAGE(PG8_SB(1, 1), b3 + hstep, voffB); PG8_STAGE(PG8_SA(1, 0), a3, voffA);
            PG8_WAIT_V(8); PG8_WAIT_L(0); PG8_BAR; PG8_MMA(1, 0, At, B0); PG8_MMA(1, 1, At, B1); PG8_BAR; PG8_SCHED;
            } else {
            PG8_LDB(B0, 0, 0); PG8_SCHED; PG8_LDA(At, 0, 0); PG8_STAGE(PG8_SA(1, 1), a1 + hstep, voffA);
            PG8_WAIT_L(8); PG8_BAR; PG8_WAIT_L(0); PG8_MMA(0, 0, At, B0); PG8_BAR; PG8_SCHED;
            PG8_LDB(B1, 0, 1); PG8_STAGE(PG8_SB(0, 0), b2, voffB);
            PG8_BAR; PG8_WAIT_L(0); PG8_MMA(0, 1, At, B1); PG8_BAR;
            PG8_LDA(At, 0, 1); PG8_STAGE(PG8_SA(0, 0), a2, voffA);
            PG8_BAR; PG8_WAIT_L(0); PG8_MMA(1, 0, At, B0); PG8_BAR; PG8_SCHED;
            PG8_STAGE(PG8_SB(0, 1), b2 + hstep, voffB);
            PG8_WAIT_V(6); PG8_BAR; PG8_MMA(1, 1, At, B1); PG8_BAR;
            PG8_LDB(B0, 1, 0); PG8_SCHED; PG8_LDA(At, 1, 0); PG8_STAGE(PG8_SA(0, 1), a2 + hstep, voffA);
            PG8_WAIT_L(8); PG8_BAR; PG8_WAIT_L(0); PG8_MMA(0, 0, At, B0); PG8_BAR; PG8_SCHED;
            PG8_LDB(B1, 1, 1); PG8_STAGE(PG8_SB(1, 0), b3, voffB);
            PG8_BAR; PG8_WAIT_L(0); PG8_MMA(0, 1, At, B1); PG8_BAR;
            PG8_LDA(At, 1, 1); PG8_STAGE(PG8_SA(1, 0), a3, voffA);
            PG8_BAR; PG8_WAIT_L(0); PG8_MMA(1, 0, At, B0); PG8_BAR; PG8_SCHED;
            PG8_STAGE(PG8_SB(1, 1), b3 + hstep, voffB);
            PG8_WAIT_V(6); PG8_BAR; PG8_MMA(1, 1, At, B1); PG8_BAR;
            }
        }
        if constexpr (ALIGN_EPI) { if (wr == 0) PG8_BAR; }
        if constexpr (!Epi::AFTER_DRAIN) { E(acc, cur, wr, wc, fr, fq); S.done(cur); }
        if (!has_next) break;
#pragma unroll
        for (int a = 0; a < 2; ++a)
#pragma unroll
            for (int b = 0; b < 2; ++b)
#pragma unroll
                for (int m = 0; m < 4; ++m)
#pragma unroll
                    for (int n = 0; n < 2; ++n) acc[a][b][m][n] = (f32x4){0.f, 0.f, 0.f, 0.f};
        cur = nxt; cA = nA; cB = nB; ++ui;
        if constexpr (ALIGN_EPI) { if (wr == 1) PG8_BAR; }
    }
    PG8_WAIT_V(0);
    if constexpr (!ALIGN_EPI) { if (wr == 0) PG8_BAR; }
    PG8_BAR;
    if constexpr (Epi::AFTER_DRAIN) { E.fused(acc, cur, wr, wc, fr, fq, lds, wid, lane); S.done(cur); }
#undef PG8_SA
#undef PG8_SB
#undef PG8_STAGE
#undef PG8_LDA
#undef PG8_LDB
#undef PG8_MMA
#undef PG8_WAIT_V
#undef PG8_WAIT_L
#undef PG8_BAR
#undef PG8_SCHED
}
}

constexpr int NWAVES = 8;
constexpr int DM = 4096, BATCH = 4, SEQ = 4096, DEPTH = 4, HD = 128;
constexpr int M = BATCH * SEQ;
constexpr int NPROJ = 4 * DM;
constexpr int N_RET = 12, N_SB = 10, N_DIFF = 10;
constexpr int RET_W = N_RET * HD, SB_W = N_SB * HD, DIFF_W = N_DIFF * HD;
constexpr int C_RQ = 0, C_RK = RET_W, C_RV = 2 * RET_W, C_RG = 3 * RET_W;
constexpr int C_SQ = 4 * RET_W, C_SK = C_SQ + SB_W, C_SV = C_SQ + 2 * SB_W, C_SG = C_SQ + 3 * SB_W;
constexpr int C_DQ = 4 * RET_W + 4 * SB_W, C_DK = C_DQ + DIFF_W, C_DV = C_DQ + 2 * DIFF_W, C_DG = C_DQ + 3 * DIFF_W;
constexpr int MX_RET = 0, MX_SB = RET_W, MX_DIFF = RET_W + SB_W;
static_assert(C_DG + DIFF_W == NPROJ && MX_DIFF + DIFF_W == DM, "column map");
constexpr float LN_EPS = 1e-5f;
constexpr float LOG2E = 1.4426950408889634f, LN2 = 0.6931471805599453f;
constexpr float DEEPNORM_ALPHA = 1.681792830507429f;
__device__ const float RET_LOG_GAMMA[12] = {-3.174869716e-02f, -1.574835740e-02f, -7.843177766e-03f, -3.913899418e-03f, -1.955034910e-03f, -9.770396864e-04f, -4.884005175e-04f, -2.441704273e-04f, -1.220777631e-04f, -6.103701890e-05f, -3.051804379e-05f, -1.525890548e-05f};
__device__ const float ALIBI_SLOPE[10] = {5.000000000e-01f, 2.500000000e-01f, 1.250000000e-01f, 6.250000000e-02f, 3.125000000e-02f, 1.562500000e-02f, 7.812500000e-03f, 3.906250000e-03f, 7.071067691e-01f, 3.535533845e-01f};
__device__ const float LAMBDA_INIT[4] = {0.20000000000000007f, 0.35550906759096934f, 0.4707130183435842f, 0.5560582041556406f};

constexpr size_t MiB = 1u << 20;
constexpr size_t WS_CTL = 0, CTL_ZERO_BYTES = 1 * MiB;
constexpr size_t WS_WIN = 16 * MiB;
constexpr size_t WS_WOUT = WS_WIN + (size_t)DEPTH * NPROJ * DM * 2;
constexpr size_t WS_XB = WS_WOUT + (size_t)DEPTH * DM * DM * 2;
constexpr size_t WS_XH = WS_XB + (size_t)M * DM * 2;
constexpr size_t WS_PROJ = WS_XH + (size_t)M * DM * 4;
constexpr size_t WS_MIX = WS_PROJ + (size_t)M * NPROJ * 2;
constexpr size_t WS_H = WS_MIX + (size_t)M * DM * 2;
constexpr size_t WS_SLOTS = WS_H + (size_t)M * DM * 4;
constexpr size_t WS_END = WS_SLOTS + (size_t)M * 16 * 8;
constexpr int CW_BAR = 4096;
constexpr int CW_Q = 16384;
constexpr int CW_PRE = 49152;
constexpr int CW_LNC = 131072;
constexpr int CW_TMO = 8;
constexpr int CW_TMAX = 65536, TMAX_LAYER = BATCH * N_DIFF * 2 * 64;
constexpr int RS = 272;
constexpr int IMG64 = 64 * RS, IMG128 = 128 * RS;
constexpr int SCR_BYTES = 159744;
constexpr int MISC_OFF = SCR_BYTES;
constexpr int LDS_BYTES = SCR_BYTES + 1024;
static_assert(pg8::STAGE_BYTES + 12288 <= SCR_BYTES && LDS_BYTES <= 163840, "LDS map");

#define GAS __attribute__((address_space(1)))
#define LAS __attribute__((address_space(3)))
typedef unsigned short bf16;
typedef unsigned u32x4 __attribute__((ext_vector_type(4)));
typedef unsigned u32x2 __attribute__((ext_vector_type(2)));
typedef float f32x4 __attribute__((ext_vector_type(4)));
typedef short bf16x8 __attribute__((ext_vector_type(8)));
typedef short s16x4 __attribute__((ext_vector_type(4)));
typedef GAS unsigned gu32;
#define RLX_AGENT __ATOMIC_RELAXED, __HIP_MEMORY_SCOPE_AGENT
#define LDS_WAIT() asm volatile("s_waitcnt lgkmcnt(0)" ::: "memory")
#define VM_WAIT() asm volatile("s_waitcnt vmcnt(0)" ::: "memory")
__device__ __forceinline__ unsigned f2bf(float f) { unsigned u = __builtin_bit_cast(unsigned, f); return (u + 0x7fffu + ((u >> 16) & 1u)) >> 16; }
__device__ __forceinline__ unsigned pk2(float lo, float hi) { return f2bf(lo) | (f2bf(hi) << 16); }
__device__ __forceinline__ unsigned pkbf(float lo, float hi) { unsigned r; asm volatile("v_cvt_pk_bf16_f32 %0, %1, %2" : "=v"(r) : "v"(lo), "v"(hi)); return r; }
__device__ __forceinline__ float bf_lo(unsigned w) { return __uint_as_float(w << 16); }
__device__ __forceinline__ float bf_hi(unsigned w) { return __uint_as_float(w & 0xffff0000u); }
#define XB_TMO      128
#define XB_XCNT(j)  (256  + 64 * (j))
#define XB_XSUB(j)  (1280 + 64 * (j))
#define XB_XGEN(j)  (2304 + 64 * (j))
#define XB_TOP      3328
#define XB_TOPGEN   3392
#define XCD_BAR_WORDS 3456
#define XB_SPIN_CAP (1u << 18)

__device__ __forceinline__ unsigned xb_ld(unsigned* p)              { return __hip_atomic_load(p, __ATOMIC_RELAXED, __HIP_MEMORY_SCOPE_AGENT); }
__device__ __forceinline__ unsigned xb_add(unsigned* p, unsigned v) { return __hip_atomic_fetch_add(p, v, __ATOMIC_RELAXED, __HIP_MEMORY_SCOPE_AGENT); }
__device__ __forceinline__ unsigned xb_xcc_id() { return (unsigned)__builtin_amdgcn_s_getreg((3 << 11) | 20) & 0xFu; }
#define XB_SPIN(cond, bar) do { unsigned _sp = 0; while (cond) { __builtin_amdgcn_s_sleep(1); \
    if ((++_sp & 255u) == 0u) { if (xb_ld(&(bar)[XB_TMO])) break; if (_sp > XB_SPIN_CAP) { atomicAdd(&(bar)[XB_TMO], 1u); break; } } } } while (0)

struct XcdBarrier {
    unsigned wv;
    unsigned* bar; unsigned x;
    volatile LAS unsigned* st;
};

__device__ __forceinline__ bool xb_lane0() { int t; asm volatile("v_mbcnt_lo_u32_b32 %0, -1, 0\n\tv_mbcnt_hi_u32_b32 %0, -1, %0" : "=v"(t)); return t == 0; }
__device__ __forceinline__ XcdBarrier xcd_barrier_post(unsigned* bar, volatile LAS unsigned* st, unsigned wv) {
    XcdBarrier b; b.wv = wv; b.bar = bar; b.x = xb_xcc_id(); b.st = st;
    if (wv == 0u && xb_lane0()) (void)xb_add(&bar[XB_XCNT(b.x)], 1u);
    return b;
}
__device__ __forceinline__ void xcd_barrier_complete(unsigned* bar, unsigned x, unsigned& nloc, unsigned& nx) {
    const unsigned G = gridDim.x * gridDim.y * gridDim.z;
    unsigned sum, cnt, mine, sp = 0u;
    for (;;) {
        sum = 0u; cnt = 0u; mine = 0u;
#pragma unroll
        for (unsigned j = 0; j < 16; ++j) { const unsigned c = xb_ld(&bar[XB_XCNT(j)]); sum += c; cnt += (c > 0u) ? 1u : 0u; mine = (j == x) ? c : mine; }
        if (sum == G) break;
        __builtin_amdgcn_s_sleep(1);
        if ((++sp & 255u) == 0u) { if (xb_ld(&bar[XB_TMO])) break; if (sp > XB_SPIN_CAP) { atomicAdd(&bar[XB_TMO], 1u); break; } }
    }
    nloc = mine > 0u ? mine : 1u; nx = cnt > 0u ? cnt : 1u;
}

__device__ __forceinline__ void xcd_barrier(const XcdBarrier& b) {
    asm volatile("s_waitcnt vmcnt(0)" ::: "memory");
    __syncthreads();
    if (b.wv == 0u && xb_lane0()) {
        unsigned* bar = b.bar;
        __builtin_amdgcn_s_waitcnt(0);
        unsigned nloc = b.st[0], nx = b.st[1];
        if (nloc == 0u) { xcd_barrier_complete(bar, b.x, nloc, nx); b.st[0] = nloc; b.st[1] = nx; }
        const unsigned old = xb_add(&bar[XB_XSUB(b.x)], 1u);
        const unsigned gen = old / nloc;
        if (old + 1u == (gen + 1u) * nloc) {
            __builtin_amdgcn_fence(__ATOMIC_RELEASE, "agent");
            asm volatile("s_waitcnt vmcnt(0)" ::: "memory");
            const unsigned og = xb_add(&bar[XB_TOP], 1u);
            const unsigned tg = og / nx;
            if (og + 1u == (tg + 1u) * nx) xb_add(&bar[XB_TOPGEN], 1u);
            else XB_SPIN(xb_ld(&bar[XB_TOPGEN]) == tg, bar);
            __builtin_amdgcn_fence(__ATOMIC_ACQUIRE, "agent");
            xb_add(&bar[XB_XGEN(b.x)], 1u);
            asm volatile("s_waitcnt vmcnt(0)" ::: "memory");
        } else {
            XB_SPIN(xb_ld(&bar[XB_XGEN(b.x)]) == gen, bar);
            __builtin_amdgcn_fence(__ATOMIC_ACQUIRE, "agent");
            asm volatile("s_waitcnt vmcnt(0)" ::: "memory");
        }
    }
    __syncthreads();
}

struct Args { const float* in[11]; float* out; unsigned char* ws; };
typedef const __attribute__((address_space(4))) Args CArgs;
__device__ __forceinline__ CArgs* kargs() { CArgs* p = (CArgs*)__builtin_amdgcn_kernarg_segment_ptr(); asm volatile("" : "+s"(p)); return p; }
#define args (*kargs())
struct Frame {
    LAS unsigned char* lds;
    volatile LAS unsigned* MISC;
    int wave;
};
__device__ __forceinline__ int opaque_lane() { int t; asm volatile("v_mbcnt_lo_u32_b32 %0, -1, 0\n\tv_mbcnt_hi_u32_b32 %0, -1, %0" : "=v"(t)); return t; }
#define opaque_tid() (F.wave * 64 + opaque_lane())
#define A_X       (args.in[0])
#define A_WIN     (args.in[1])
#define A_WOUT    (args.in[2])
#define A_LNG     (args.in[3])
#define A_LNB     (args.in[4])
#define A_RETG    (args.in[5])
#define A_DIFFG   (args.in[6])
#define A_LQ1     (args.in[7])
#define A_LK1     (args.in[8])
#define A_LQ2     (args.in[9])
#define A_LK2     (args.in[10])
#define W_CTL     ((gu32*)(args.ws + WS_CTL))
#define W_WINT    ((bf16*)(args.ws + WS_WIN))
#define W_WOUTT   ((bf16*)(args.ws + WS_WOUT))
#define W_XB      ((bf16*)(args.ws + WS_XB))
#define W_XH      ((float*)(args.ws + WS_XH))
#define W_PROJ    ((bf16*)(args.ws + WS_PROJ))
#define W_MIX     ((bf16*)(args.ws + WS_MIX))
#define W_H       ((float*)(args.ws + WS_H))
template <int CTRL> __device__ __forceinline__ float dpp_mov(float x) { return __builtin_bit_cast(float, __builtin_amdgcn_mov_dpp(__builtin_bit_cast(int, x), CTRL, 0xf, 0xf, true)); }
__device__ __forceinline__ float xrow16_max(float x) {
    auto s = __builtin_amdgcn_permlane16_swap(__float_as_uint(x), __float_as_uint(x), false, false);
    x = fmaxf(__uint_as_float(s[0]), __uint_as_float(s[1]));
    auto t = __builtin_amdgcn_permlane32_swap(__float_as_uint(x), __float_as_uint(x), false, false);
    return fmaxf(__uint_as_float(t[0]), __uint_as_float(t[1]));
}
__device__ __forceinline__ float xrow16_sum(float x) {
    auto s = __builtin_amdgcn_permlane16_swap(__float_as_uint(x), __float_as_uint(x), false, false);
    x = __uint_as_float(s[0]) + __uint_as_float(s[1]);
    auto t = __builtin_amdgcn_permlane32_swap(__float_as_uint(x), __float_as_uint(x), false, false);
    return __uint_as_float(t[0]) + __uint_as_float(t[1]);
}
__device__ __forceinline__ float wave_sum(float v) {
    v += dpp_mov<0xB1>(v); v += dpp_mov<0x4E>(v); v += dpp_mov<0x141>(v); v += dpp_mov<0x140>(v);
    return xrow16_sum(v);
}
__device__ __forceinline__ f32x4 mfma16(bf16x8 a, bf16x8 b, f32x4 c) { return __builtin_amdgcn_mfma_f32_16x16x32_bf16(a, b, c, 0, 0, 0); }
__device__ __forceinline__ s16x4 tr_read(const LAS unsigned char* p) { return __builtin_amdgcn_ds_read_tr16_b64_v4i16((LAS s16x4*)p); }
__device__ __forceinline__ bf16x8 cat8(s16x4 lo, s16x4 hi) { return (bf16x8){lo[0], lo[1], lo[2], lo[3], hi[0], hi[1], hi[2], hi[3]}; }
__device__ __forceinline__ float silu_f(float x) { return x * __builtin_amdgcn_rcpf(1.0f + __builtin_amdgcn_exp2f(-x * LOG2E)); }

__device__ __forceinline__ void p0_transpose_item(const float* W, int K, int N, bf16* WT, LAS float* scr, int item, int lane) {
    const int nblk = N / 32, kb = item / nblk, nb = item % nblk, k0 = 64 * kb, n0 = 32 * nb;
#pragma unroll
    for (int i = 0; i < 32; ++i) { const int kk = 2 * i + (lane >> 5); scr[kk * 33 + (lane & 31)] = __builtin_nontemporal_load(W + (size_t)(k0 + kk) * N + n0 + (lane & 31)); }
    LDS_WAIT(); asm volatile("" ::: "memory");
    const int c = lane & 7;
#pragma unroll
    for (int j = 0; j < 4; ++j) { const int n = (lane >> 3) + 8 * j; const LAS float* s = scr + (8 * c) * 33 + n;
        u32x4 o; o.x = pk2(s[0 * 33], s[1 * 33]); o.y = pk2(s[2 * 33], s[3 * 33]); o.z = pk2(s[4 * 33], s[5 * 33]); o.w = pk2(s[6 * 33], s[7 * 33]);
        __builtin_nontemporal_store(o, (GAS u32x4*)(WT + (size_t)(n0 + n) * K + k0 + 8 * c)); }
    LDS_WAIT(); asm volatile("" ::: "memory");
}
constexpr int CV_I_IN = (DM / 64) * (NPROJ / 32), CV_I_OUT = (DM / 64) * (DM / 32), CV_ITEMS = CV_I_IN + CV_I_OUT;
__device__ __forceinline__ void convert_item(int layer, int it, LAS float* scr, int lane) {
    if (it < CV_I_IN) p0_transpose_item(A_WIN + (size_t)layer * DM * NPROJ, DM, NPROJ, W_WINT + (size_t)layer * NPROJ * DM, scr, it, lane);
    else p0_transpose_item(A_WOUT + (size_t)layer * DM * DM, DM, DM, W_WOUTT + (size_t)layer * DM * DM, scr, it - CV_I_IN, lane);
}
__device__ __forceinline__ void p0_prologue(Frame& F0) {
    struct { LAS unsigned char* lds; int tid, lane, wave; } F; F.lds = F0.lds; F.wave = F0.wave; F.lane = opaque_lane(); F.tid = F.wave * 64 + F.lane;
    LAS float* scr = (LAS float*)(F.lds + F.wave * 16384);
    const int gw = blockIdx.x * NWAVES + F.wave, NGW = gridDim.x * NWAVES;
    for (int it = gw; it < DEPTH * CV_ITEMS; it += NGW) convert_item(it / CV_ITEMS, it % CV_ITEMS, scr, F.lane);
    const size_t nthr = (size_t)gridDim.x * NWAVES * 64, t0 = (size_t)blockIdx.x * NWAVES * 64 + F.tid;
    for (size_t i = t0; i < (size_t)M * DM / 8; i += nthr) {
        const f32x4 a = *(const GAS f32x4*)(A_X + i * 8), b = *(const GAS f32x4*)(A_X + i * 8 + 4);
        u32x4 o; o.x = pk2(a.x, a.y); o.y = pk2(a.z, a.w); o.z = pk2(b.x, b.y); o.w = pk2(b.z, b.w);
        *(GAS u32x4*)(W_XB + i * 8) = o; }
}
constexpr int CV_UNIT = 32, CV_UNITS = CV_ITEMS / CV_UNIT;
static_assert(CV_ITEMS % CV_UNIT == 0, "conversion units");
__device__ __forceinline__ void convert_unit(Frame& F, int layer, int u) {
    const int lane = opaque_lane(); LAS float* scr = (LAS float*)(F.lds + F.wave * 16384);
    for (int j = 0; j < CV_UNIT / NWAVES; ++j) convert_item(layer, u * CV_UNIT + F.wave * (CV_UNIT / NWAVES) + j, scr, lane);
}

__device__ __forceinline__ int next_unit(Frame& F, gu32* head) {
    __syncthreads();
    if (F.wave == 0 && opaque_lane() == 0) F.MISC[4] = __hip_atomic_fetch_add(head, 1u, RLX_AGENT);
    __syncthreads();
    return __builtin_amdgcn_readfirstlane((int)F.MISC[4]);
}
__device__ const unsigned char DIFF_ORDER[160] = {244, 245, 246, 247, 228, 229, 230, 231, 212, 213, 214, 215, 196, 197, 198, 199, 180, 181, 182, 183, 164, 165, 166, 167, 148, 149, 150, 151, 132, 133, 134, 135, 116, 117, 118, 119, 100, 101, 102, 103, 84, 85, 86, 87, 68, 69, 70, 71, 52, 53, 54, 55, 36, 37, 38, 39, 20, 21, 22, 23, 4, 5, 6, 7, 243, 227, 211, 195, 179, 163, 147, 131, 115, 99, 83, 242, 226, 210, 194, 178, 162, 146, 130, 114, 98, 82, 66, 67, 50, 51, 241, 225, 209, 193, 177, 161, 145, 129, 113, 97, 81, 65, 49, 33, 34, 35, 249, 233, 217, 201, 185, 169, 153, 137, 121, 105, 89, 73, 57, 41, 240, 224, 208, 192, 176, 160, 144, 128, 112, 96, 80, 64, 48, 32, 16, 17, 18, 19, 25, 248, 232, 216, 200, 184, 168, 152, 136, 120, 104, 88, 72, 56, 40, 24, 0, 1, 2, 3, 8, 9};
__device__ __forceinline__ void knorm_prepass(Frame& F, int layer, int wave) {
    const int lane = opaque_lane(), gw = blockIdx.x * NWAVES + wave, NGW = BATCH * N_RET * NWAVES;
    gu32* tm = W_CTL + CW_TMAX + layer * TMAX_LAYER; gu32* cnt = W_CTL + CW_PRE + layer * 64;
    unsigned ndone = 0;
    for (int it = gw; it < BATCH * N_DIFF * 128; it += NGW) {
        const int t32 = it & 127, bh = it >> 7, b = bh / N_DIFF, h = bh % N_DIFF;
        const bf16* kp = W_PROJ + (size_t)(b * SEQ + 32 * t32) * NPROJ + C_DK + h * HD + 8 * (lane & 15);
        u32x4 w[8];
#pragma unroll
        for (int i = 0; i < 8; ++i) w[i] = *(const GAS u32x4*)(kp + (size_t)(4 * i + (lane >> 4)) * NPROJ);
        float mx = 0.f;
#pragma unroll
        for (int i = 0; i < 8; ++i) { float s = 0.f;
#pragma unroll
            for (int j = 0; j < 4; ++j) { const float lo = bf_lo(w[i][j]), hi = bf_hi(w[i][j]); s = fmaf(lo, lo, s); s = fmaf(hi, hi, s); }
            s += dpp_mov<0xB1>(s); s += dpp_mov<0x4E>(s); s += dpp_mov<0x141>(s);
            mx = fmaxf(mx, s); }
        mx = xrow16_max(mx);
        if ((lane & 55) == 0) __hip_atomic_fetch_max(tm + ((bh * 2 + (lane >> 3)) * 64 + (t32 >> 1)), __float_as_uint(mx), RLX_AGENT);
        ++ndone;
    }
    asm volatile("s_waitcnt vmcnt(0)" ::: "memory");
    if (lane == 0) __hip_atomic_fetch_add((LAS unsigned*)&F.MISC[6], ndone, __ATOMIC_RELAXED, __HIP_MEMORY_SCOPE_WORKGROUP);
    __syncthreads();
    if (wave == 0 && lane == 0) { __hip_atomic_fetch_add(cnt, F.MISC[6], RLX_AGENT); F.MISC[6] = 0u; }
}
template <int CTRL, int ROWMASK> __device__ __forceinline__ float dpp_upd0(float x) { return __builtin_bit_cast(float, __builtin_amdgcn_update_dpp(0, __builtin_bit_cast(int, x), CTRL, ROWMASK, 0xf, true)); }
__device__ __forceinline__ float wave_prefix_max(float v) {
    v = fmaxf(v, dpp_upd0<0x111, 0xf>(v)); v = fmaxf(v, dpp_upd0<0x112, 0xf>(v)); v = fmaxf(v, dpp_upd0<0x114, 0xf>(v)); v = fmaxf(v, dpp_upd0<0x118, 0xf>(v));
    v = fmaxf(v, dpp_upd0<0x142, 0xa>(v)); v = fmaxf(v, dpp_upd0<0x143, 0xc>(v));
    return v;
}

constexpr int KV_TILE_BYTES = 64 * 256;
__device__ __forceinline__ int swz_k(int row) { return row & 15; }
__device__ __forceinline__ int swz_v(int row) { return (row & 15) ^ ((row & 1) << 3); }
__device__ __forceinline__ void glds16(const void* gsrc, unsigned lds_dst) { unsigned keep;
    asm volatile("s_mov_b32 %0, m0\n\ts_mov_b32 m0, %2\n\ts_nop 0\n\tglobal_load_lds_dwordx4 %1, off\n\ts_mov_b32 m0, %0" : "=&s"(keep) : "v"(gsrc), "s"(lds_dst) : "memory"); }
__device__ __forceinline__ void glds16_so(const void* gbase, unsigned voff, unsigned lds_dst) { unsigned keep;
    asm volatile("s_mov_b32 %0, m0\n\ts_mov_b32 m0, %2\n\ts_nop 0\n\tglobal_load_lds_dwordx4 %1, %3\n\ts_mov_b32 m0, %0" : "=&s"(keep) : "v"(voff), "s"(lds_dst), "s"(gbase) : "memory"); }
__device__ __forceinline__ void kv_dma_offsets(unsigned (&dmo)[4], int wave, int lane) {
#pragma unroll
    for (int i = 0; i < 2; ++i) { const int row = 4 * (2 * wave + i) + (lane >> 4), slot = lane & 15;
        dmo[2 * i] = (unsigned)row * (NPROJ * 2) + 16 * (slot ^ swz_k(row)); dmo[2 * i + 1] = (unsigned)row * (NPROJ * 2) + 16 * (slot ^ swz_v(row)); }
}
__device__ __forceinline__ void kv_dma(LAS unsigned char* kbuf, LAS unsigned char* vbuf, const bf16* kp, const bf16* vp, int k0, int wave, const unsigned (&dmo)[4]) {
    const char* kb = (const char*)(kp + (size_t)k0 * NPROJ); const char* vb = (const char*)(vp + (size_t)k0 * NPROJ);
#pragma unroll
    for (int i = 0; i < 2; ++i) { const int pc = 2 * wave + i;
        glds16_so(kb, dmo[2 * i], (unsigned)(size_t)(kbuf + 1024 * pc));
        glds16_so(vb, dmo[2 * i + 1], (unsigned)(size_t)(vbuf + 1024 * pc)); }
}
__device__ __forceinline__ void k_dma(LAS unsigned char* kbuf, const bf16* kp, int k0, int wave, const unsigned (&dmo)[4]) {
    const char* kb = (const char*)(kp + (size_t)k0 * NPROJ);
    glds16_so(kb, dmo[0], (unsigned)(size_t)(kbuf + 1024 * (2 * wave))); glds16_so(kb, dmo[2], (unsigned)(size_t)(kbuf + 1024 * (2 * wave + 1))); }
__device__ __forceinline__ void v_dma(LAS unsigned char* vbuf, const bf16* vp, int k0, int wave, const unsigned (&dmo)[4]) {
    const char* vb = (const char*)(vp + (size_t)k0 * NPROJ);
    glds16_so(vb, dmo[1], (unsigned)(size_t)(vbuf + 1024 * (2 * wave))); glds16_so(vb, dmo[3], (unsigned)(size_t)(vbuf + 1024 * (2 * wave + 1))); }
constexpr float NEG_MASK = -1e30f;
constexpr float DIFF_THR = 6.0f;
#ifndef SCHED_FENCE
#define SCHED_FENCE() __builtin_amdgcn_sched_barrier(0)
#endif
__device__ __forceinline__ float max3_raw(float a, float b, float c) { float r; asm("v_max3_f32 %0, %1, %2, %3" : "=v"(r) : "v"(a), "v"(b), "v"(c)); return r; }
__device__ __forceinline__ float max2_raw(float a, float b) { float r; asm("v_max_f32_e32 %0, %1, %2" : "=v"(r) : "v"(a), "v"(b)); return r; }
__device__ __forceinline__ void diff_sm32(bool force, bool diag, f32x4 (&S)[2], f32x4 (&O)[8], float& m, float& l, bf16x8& pb, int kq  ) {
    if (diag) {
        int kql = kq; asm volatile("" : "+v"(kql));
#pragma unroll
        for (int a = 0; a < 2; ++a)
#pragma unroll
            for (int r = 0; r < 4; ++r) if (kql + 16 * a + r > 0) S[a][r] = NEG_MASK;
    }
    const float pl = max3_raw(max3_raw(max3_raw(S[0][0], S[0][1], S[0][2]), S[0][3], S[1][0]), max2_raw(S[1][1], S[1][2]), S[1][3]);
    if (force || !__all(pl <= DIFF_THR)) {
        const float pmax = xrow16_max(pl);
        float mn = fmaxf(pmax, 0.f);
        if (force) { const float lt = xrow16_sum(l); if (lt == 0.f) mn = pmax; }
        if (pmax < -1e29f) mn = 0.f;
        const float alpha = __builtin_amdgcn_exp2f(-mn);
#pragma unroll
        for (int c = 0; c < 8; ++c) O[c] = O[c] * alpha;
        l *= alpha; m += mn;
#pragma unroll
        for (int a = 0; a < 2; ++a) S[a] = S[a] - mn;
    }
    float ps = 0.f;
#pragma unroll
    for (int a = 0; a < 2; ++a)
#pragma unroll
        for (int r = 0; r < 4; ++r) { const float pv = __builtin_amdgcn_exp2f(S[a][r]); S[a][r] = pv; ps += pv; }
    l += ps;
    u32x4 w; w.x = pkbf(S[0][0], S[0][1]); w.y = pkbf(S[0][2], S[0][3]); w.z = pkbf(S[1][0], S[1][1]); w.w = pkbf(S[1][2], S[1][3]);
    pb = __builtin_bit_cast(bf16x8, w);
}
#ifndef DT2_KQ_EARLY
#define DT2_KQ_EARLY 0
#endif
#define DT2_LOADKQ(HH, X) do { _Pragma("unroll") for (int a = 0; a < 2; ++a) _Pragma("unroll") for (int s = 0; s < 2; ++s) { \
        kf[a][s] = *(const LAS bf16x8*)(kb + kr[X][s] + 256 * (32 * (HH) + 16 * a)); qf[a][s] = *(const LAS bf16x8*)(qb + kr[X][s] + 256 * (16 * a)); } } while (0)
#define DT2_LOADV(DST, HH, C0) do { _Pragma("unroll") for (int c = 0; c < 4; ++c) \
        DST[c] = cat8(tr_read((const LAS unsigned char*)(va[(C0) + c] + 256 * (32 * (HH)))), tr_read((const LAS unsigned char*)(va[(C0) + c] + 256 * (32 * (HH) + 16)))); } while (0)
__device__ __forceinline__ void diff_tile2(bool force, bool diag, f32x4 (&O)[2][2][8], float (&m)[2][2], float (&l)[2][2], const unsigned (&kr)[2][2], unsigned kb, unsigned qb, const unsigned (&va)[8], float slope2, int kq0  ) {
    bf16x8 kf[2][2], qf[2][2];
    DT2_LOADKQ(1, 0);
#pragma unroll
    for (int blk = 0; blk < 4; ++blk) {
        const int hh = 1 - (blk >> 1), x = blk & 1;
        bf16x8 vv[4];
        f32x4 S0[2], S1[2];
        const float b0 = slope2 * (float)(kq0 + 32 * hh) - m[x][0], b1 = slope2 * (float)(kq0 + 32 * hh - 16) - m[x][1];
#pragma unroll
        for (int a = 0; a < 2; ++a)
#pragma unroll
            for (int r = 0; r < 4; ++r) { S0[a][r] = fmaf(slope2, (float)(16 * a + r), b0); S1[a][r] = fmaf(slope2, (float)(16 * a + r), b1); }
        SCHED_FENCE();
#pragma unroll
        for (int a = 0; a < 2; ++a)
#pragma unroll
            for (int s = 0; s < 2; ++s) { S0[a] = mfma16(kf[a][s], qf[0][s], S0[a]); S1[a] = mfma16(kf[a][s], qf[1][s], S1[a]); }
        bf16x8 pb0, pb1;
        SCHED_FENCE();
        DT2_LOADV(vv, hh, 0);
        SCHED_FENCE();
        diff_sm32(force, diag, S0, O[x][0], m[x][0], l[x][0], pb0, kq0 + 32 * hh);
        diff_sm32(force, diag, S1, O[x][1], m[x][1], l[x][1], pb1, kq0 + 32 * hh - 16);
        SCHED_FENCE();
#pragma unroll
        for (int c = 0; c < 4; ++c) { O[x][0][c] = mfma16(vv[c], pb0, O[x][0][c]); O[x][1][c] = mfma16(vv[c], pb1, O[x][1][c]); }
        SCHED_FENCE();
        DT2_LOADV(vv, hh, 4);
        SCHED_FENCE();
#pragma unroll
        for (int c = 0; c < 4; ++c) { O[x][0][4 + c] = mfma16(vv[c], pb0, O[x][0][4 + c]); O[x][1][4 + c] = mfma16(vv[c], pb1, O[x][1][4 + c]); }
        SCHED_FENCE();
        if (blk == 0) DT2_LOADKQ(1, 1); else if (blk == 1) DT2_LOADKQ(0, 0); else if (blk == 2) DT2_LOADKQ(0, 1);
        SCHED_FENCE();
    }
}
#undef DT2_LOADKQ
#undef DT2_LOADV
constexpr int DQ_IMG = 0, DK_RING = 65536, DV_RING = DK_RING + 2 * KV_TILE_BYTES;
__device__ __forceinline__ void diff_unit2(Frame& F, int b, int h, int qb, int layer) {
    const int tid_ = opaque_tid(), lane = tid_ & 63;
    const int wave = F.wave, li = lane & 15, g = lane >> 4;
    const int q0 = 256 * qb, tq0 = q0 + 32 * wave + li;
    const bf16* base = W_PROJ + (size_t)(b * SEQ) * NPROJ;
    const bf16* qp = base + C_DQ + h * HD; const bf16* kp = base + C_DK + h * HD; const bf16* vp = base + C_DV + h * HD; const bf16* gp = base + C_DG + h * HD;
    const float slope2 = ALIBI_SLOPE[h] * LOG2E;
    LAS unsigned char* kring = F.lds + 65536; LAS unsigned char* vring = F.lds + 65536 + 3 * KV_TILE_BYTES; constexpr int DTAB = 65536 + 5 * KV_TILE_BYTES;
    const int jt0 = 4 * qb + 3;
#pragma unroll
    for (int i = 0; i < 8; ++i) { const int row = 32 * wave + 4 * i + (lane >> 4), slot = lane & 15;
        glds16(qp + (size_t)(q0 + row) * NPROJ + 8 * (slot ^ swz_k(row)), (unsigned)(size_t)(F.lds + DQ_IMG + 1024 * (8 * wave + i))); }
    unsigned dmo[4]; kv_dma_offsets(dmo, wave, lane);
    k_dma(kring, kp, 64 * jt0, wave, dmo); v_dma(vring, vp, 64 * jt0, wave, dmo); k_dma(kring + KV_TILE_BYTES, kp, 64 * (jt0 - 1), wave, dmo);
    f32x4 O[2][2][8]; float m[2][2], l[2][2];
#pragma unroll
    for (int x = 0; x < 2; ++x)
#pragma unroll
        for (int u = 0; u < 2; ++u) { m[x][u] = 0.f; l[x][u] = 0.f;
#pragma unroll
            for (int c = 0; c < 8; ++c) O[x][u][c] = (f32x4){0.f, 0.f, 0.f, 0.f}; }
    unsigned kr[2][2], va[8];
    {   const int q = li >> 2, p = lane & 3; const unsigned vb = (unsigned)(size_t)vring;
#pragma unroll
        for (int x = 0; x < 2; ++x)
#pragma unroll
            for (int s = 0; s < 2; ++s) kr[x][s] = 256 * li + 16 * ((8 * x + 4 * s + g) ^ swz_k(li));
#pragma unroll
        for (int c = 0; c < 8; ++c) va[c] = vb + 256 * (4 * g + q) + 16 * ((2 * c + (p >> 1)) ^ swz_v(4 * g + q)) + 8 * (p & 1); }
    const unsigned qbase = (unsigned)(size_t)(F.lds + DQ_IMG) + 256 * 32 * wave;
    LAS f32x4* qnp = (LAS f32x4*)(F.lds + DTAB) + tid_; LAS float* kprep = (LAS float*)(F.lds + DTAB + 8192 + 512 * wave);
    const bool canskip = ALIBI_SLOPE[h] * LOG2E * (float)SEQ > 200.0f;
    {   if (canskip) {
            gu32* cnt = W_CTL + CW_PRE + layer * 64; unsigned spins = 0;
            while (__builtin_amdgcn_readfirstlane(__hip_atomic_load(cnt, RLX_AGENT)) < (unsigned)(BATCH * N_DIFF * 128) && ++spins < (1u << 22)) __builtin_amdgcn_s_sleep(2);
            gu32* tm = W_CTL + CW_TMAX + layer * TMAX_LAYER + ((b * N_DIFF + h) * 2) * 64;
#pragma unroll
            for (int x = 0; x < 2; ++x) kprep[x * 64 + lane] = wave_prefix_max(sqrtf(__uint_as_float(__hip_atomic_load(tm + x * 64 + lane, RLX_AGENT))));
        }
        asm volatile("s_waitcnt vmcnt(0)" ::: "memory");
        f32x4 qv;
#pragma unroll
        for (int x = 0; x < 2; ++x)
#pragma unroll
            for (int u = 0; u < 2; ++u) { float s2 = 0.f;
#pragma unroll
                for (int s = 0; s < 2; ++s) { const u32x4 w = *(const LAS u32x4*)(qbase + kr[x][s] + 256 * (16 * u));
#pragma unroll
                    for (int j = 0; j < 4; ++j) { const float lo = bf_lo(w[j]), hi = bf_hi(w[j]); s2 = fmaf(lo, lo, s2); s2 = fmaf(hi, hi, s2); } }
                qv[2 * x + u] = sqrtf(xrow16_sum(s2)); }
        *qnp = qv;
    }
    int slot = 0, kslot = 0;
    bool first = true;
    for (int jt = jt0; jt >= 0; --jt) {
        if (jt >= 1) asm volatile("s_waitcnt vmcnt(2)\n\ts_barrier" ::: "memory"); else asm volatile("s_waitcnt vmcnt(0)\n\ts_barrier" ::: "memory");
        if (jt != jt0) {
            unsigned alld = 1u;
#pragma unroll
            for (int w = 0; w < 8; ++w) alld &= F.MISC[8 + 8 * (slot ^ 1) + w];
            if (__builtin_amdgcn_readfirstlane((int)alld)) break;
        }
        if (jt >= 1) v_dma(vring + (slot ^ 1) * KV_TILE_BYTES, vp, 64 * (jt - 1), wave, dmo);
        if (jt >= 2) k_dma(kring + (kslot == 0 ? 2 : kslot - 1) * KV_TILE_BYTES, kp, 64 * (jt - 2), wave, dmo);
        const int k0 = 64 * jt;
        if (k0 <= q0 + 32 * wave + 31) {
            const int kq0 = k0 + 4 * g - tq0;
            diff_tile2(first, k0 + 63 > q0 + 32 * wave, O, m, l, kr, (unsigned)(size_t)kring + kslot * KV_TILE_BYTES, qbase, va, slope2, kq0);
            first = false;
        }
        {
            bool wdone = false;
            if (canskip && !first && jt >= 1) {
                bool dn = true; const f32x4 qv = *qnp;
#pragma unroll
                for (int x = 0; x < 2; ++x) { const float kmx = kprep[x * 64 + jt - 1];
#pragma unroll
                    for (int u = 0; u < 2; ++u) dn = dn && (fmaf(qv[2 * x + u], kmx, slope2 * (float)(64 * jt - 1 - (tq0 + 16 * u))) - m[x][u] < -152.0f); }
                wdone = __all(dn);
            }
            if (lane == 0) F.MISC[8 + 8 * slot + wave] = wdone ? 1u : 0u;
        }
        {   const int dl = slot ? -KV_TILE_BYTES : KV_TILE_BYTES;
#pragma unroll
            for (int c = 0; c < 8; ++c) va[c] += dl; }
        slot ^= 1; kslot = kslot == 2 ? 0 : kslot + 1;
    }
    const float lam = __uint_as_float(F.MISC[5]);
    const float* gain = A_DIFFG + layer * DIFF_W + h * HD;
    int ge = g; asm volatile("" : "+v"(ge));
#pragma unroll
    for (int u = 0; u < 2; ++u) {
        const float l1 = xrow16_sum(l[0][u]), l2 = xrow16_sum(l[1][u]);
        const float c1 = 1.0f / l1, c2 = lam / l2;
        float ss = 0.f;
#pragma unroll
        for (int c = 0; c < 8; ++c)
#pragma unroll
            for (int r = 0; r < 4; ++r) { const float o = O[0][u][c][r] * c1 - O[1][u][c][r] * c2; O[0][u][c][r] = o; ss += o * o; }
        ss = xrow16_sum(ss);
        const float rstd = 1.0f / sqrtf(ss * (1.0f / HD) + LN_EPS) * (1.0f - LAMBDA_INIT[layer]);
        int tq = tq0 + 16 * u; asm volatile("" : "+v"(tq));
        const bf16* grow = gp + (size_t)tq * NPROJ;
        bf16* orow = W_MIX + (size_t)(b * SEQ + tq) * DM + MX_DIFF + h * HD;
#pragma unroll
        for (int c = 0; c < 8; ++c) { const int d = 16 * c + 4 * ge;
            const u32x2 gw = *(const GAS u32x2*)(grow + d); const f32x4 gn = *(const GAS f32x4*)(gain + d);
            const float y0 = O[0][u][c][0] * rstd * gn.x * silu_f(bf_lo(gw.x)), y1 = O[0][u][c][1] * rstd * gn.y * silu_f(bf_hi(gw.x));
            const float y2 = O[0][u][c][2] * rstd * gn.z * silu_f(bf_lo(gw.y)), y3 = O[0][u][c][3] * rstd * gn.w * silu_f(bf_hi(gw.y));
            u32x2 w; w.x = pkbf(y0, y1); w.y = pkbf(y2, y3); *(GAS u32x2*)(orow + d) = w;
            if (c & 1) asm volatile("" ::: "memory"); }
    }
    asm volatile("s_waitcnt vmcnt(0)" ::: "memory");
}

__device__ __forceinline__ float xor_partner(float own, unsigned s0, unsigned s1) { return __uint_as_float(s0 ^ s1 ^ __float_as_uint(own)); }
__device__ __forceinline__ void sb_group32(bool diag, f32x4 (&S)[2], float& R, bf16x8& pb, int kq  , int g) {
    float u[2][4], be[2][4];
#pragma unroll
    for (int a = 0; a < 2; ++a)
#pragma unroll
        for (int r = 0; r < 4; ++r) { const float e = __builtin_amdgcn_exp2f(S[a][r]); const float uu = __builtin_amdgcn_rcpf(1.0f + e); u[a][r] = uu; be[a][r] = e * uu; }
    if (diag) {
        int kql = kq; asm volatile("" : "+v"(kql));
#pragma unroll
        for (int a = 0; a < 2; ++a)
#pragma unroll
            for (int r = 0; r < 4; ++r) if (kql + 16 * a + r >= 0) { u[a][r] = 1.0f; be[a][r] = 0.f; }
    }
    float w[2][4], T[2];
#pragma unroll
    for (int a = 0; a < 2; ++a) { w[a][3] = 1.0f; w[a][2] = u[a][3]; w[a][1] = w[a][2] * u[a][2]; w[a][0] = w[a][1] * u[a][1]; T[a] = w[a][0] * u[a][0]; }
    float G[2], Tot[2];
#pragma unroll
    for (int a = 0; a < 2; ++a) {
        auto s = __builtin_amdgcn_permlane16_swap(__float_as_uint(T[a]), __float_as_uint(T[a]), false, false);
        const float pt = xor_partner(T[a], s[0], s[1]), pp = T[a] * pt;
        auto t = __builtin_amdgcn_permlane32_swap(__float_as_uint(pp), __float_as_uint(pp), false, false);
        const float po = xor_partner(pp, t[0], t[1]);
        G[a] = ((g & 1) ? 1.0f : pt) * ((g < 2) ? po : 1.0f); Tot[a] = pp * po; }
    const float c1 = R * G[1], c0 = R * Tot[1] * G[0];
#pragma unroll
    for (int r = 0; r < 4; ++r) { S[1][r] = be[1][r] * (c1 * w[1][r]); S[0][r] = be[0][r] * (c0 * w[0][r]); }
    R = R * Tot[1] * Tot[0];
    u32x4 pw; pw.x = pkbf(S[0][0], S[0][1]); pw.y = pkbf(S[0][2], S[0][3]); pw.z = pkbf(S[1][0], S[1][1]); pw.w = pkbf(S[1][2], S[1][3]);
    pb = __builtin_bit_cast(bf16x8, pw);
}
__device__ __forceinline__ void sb_unit2(Frame& F, int b, int h, int qb) {
    const int tid_ = opaque_tid(), lane = tid_ & 63;
    const int wave = F.wave, li = lane & 15, g = lane >> 4;
    const int q0 = 256 * qb, tq0 = q0 + 32 * wave + li;
    const bf16* base = W_PROJ + (size_t)(b * SEQ) * NPROJ;
    const bf16* qp = base + C_SQ + h * HD; const bf16* kp = base + C_SK + h * HD; const bf16* vp = base + C_SV + h * HD; const bf16* gp = base + C_SG + h * HD;
    LAS unsigned char* kring = F.lds + DK_RING; LAS unsigned char* vring = F.lds + DV_RING;
    const int jt0 = 4 * qb + 3;
#pragma unroll
    for (int i = 0; i < 8; ++i) { const int row = 32 * wave + 4 * i + (lane >> 4), slot = lane & 15;
        glds16(qp + (size_t)(q0 + row) * NPROJ + 8 * (slot ^ swz_k(row)), (unsigned)(size_t)(F.lds + DQ_IMG + 1024 * (8 * wave + i))); }
    unsigned dmo[4]; kv_dma_offsets(dmo, wave, lane);
    kv_dma(kring, vring, kp, vp, 64 * jt0, wave, dmo);
    f32x4 O[2][8]; float R[2] = {1.0f, 1.0f};
#pragma unroll
    for (int u = 0; u < 2; ++u)
#pragma unroll
        for (int c = 0; c < 8; ++c) O[u][c] = (f32x4){0.f, 0.f, 0.f, 0.f};
    unsigned kr[4], va[8];
    {   const int q = li >> 2, p = lane & 3; const unsigned vb = (unsigned)(size_t)vring;
#pragma unroll
        for (int s = 0; s < 4; ++s) kr[s] = 256 * li + 16 * ((4 * s + g) ^ swz_k(li));
#pragma unroll
        for (int c = 0; c < 8; ++c) va[c] = vb + 256 * (4 * g + q) + 16 * ((2 * c + (p >> 1)) ^ swz_v(4 * g + q)) + 8 * (p & 1); }
    const unsigned qbase = (unsigned)(size_t)(F.lds + DQ_IMG) + 256 * 32 * wave;
    asm volatile("s_waitcnt vmcnt(0)" ::: "memory");
    bf16x8 qf[2][4];
#pragma unroll
    for (int u = 0; u < 2; ++u)
#pragma unroll
        for (int s = 0; s < 4; ++s) qf[u][s] = *(const LAS bf16x8*)(qbase + kr[s] + 256 * (16 * u));
    int slot = 0; bool started = false;
    for (int jt = jt0; jt >= 0; --jt) {
        asm volatile("s_waitcnt vmcnt(0)\n\ts_barrier" ::: "memory");
        if (jt != jt0) {
            unsigned alld = 1u;
#pragma unroll
            for (int w = 0; w < 8; ++w) alld &= F.MISC[8 + 8 * (slot ^ 1) + w];
            if (__builtin_amdgcn_readfirstlane((int)alld)) break;
        }
        if (jt >= 1) kv_dma(kring + (slot ^ 1) * KV_TILE_BYTES, vring + (slot ^ 1) * KV_TILE_BYTES, kp, vp, 64 * (jt - 1), wave, dmo);
        const int k0 = 64 * jt;
        if (k0 <= q0 + 32 * wave + 30) {
            const bool diag = (k0 + 63 >= q0 + 32 * wave);
            const unsigned kb = (unsigned)(size_t)kring + slot * KV_TILE_BYTES;
            const int kq0 = k0 + 4 * g - tq0;
#pragma unroll
            for (int hh = 1; hh >= 0; --hh) {
                f32x4 S0[2], S1[2];
#pragma unroll
                for (int a = 0; a < 2; ++a) { S0[a] = (f32x4){0.f, 0.f, 0.f, 0.f}; S1[a] = (f32x4){0.f, 0.f, 0.f, 0.f};
#pragma unroll
                    for (int s = 0; s < 4; ++s) { const bf16x8 kf = *(const LAS bf16x8*)(kb + kr[s] + 256 * (32 * hh + 16 * a)); S0[a] = mfma16(kf, qf[0][s], S0[a]); S1[a] = mfma16(kf, qf[1][s], S1[a]); } }
                SCHED_FENCE();
                bf16x8 vv[4];
#pragma unroll
                for (int c = 0; c < 4; ++c) vv[c] = cat8(tr_read((const LAS unsigned char*)(va[c] + 256 * (32 * hh))), tr_read((const LAS unsigned char*)(va[c] + 256 * (32 * hh + 16))));
                SCHED_FENCE();
                bf16x8 pb0, pb1;
                sb_group32(diag, S0, R[0], pb0, kq0 + 32 * hh, g);
                sb_group32(diag, S1, R[1], pb1, kq0 + 32 * hh - 16, g);
                SCHED_FENCE();
#pragma unroll
                for (int c = 0; c < 4; ++c) { O[0][c] = mfma16(vv[c], pb0, O[0][c]); O[1][c] = mfma16(vv[c], pb1, O[1][c]); }
                SCHED_FENCE();
#pragma unroll
                for (int c = 0; c < 4; ++c) vv[c] = cat8(tr_read((const LAS unsigned char*)(va[4 + c] + 256 * (32 * hh))), tr_read((const LAS unsigned char*)(va[4 + c] + 256 * (32 * hh + 16))));
                SCHED_FENCE();
#pragma unroll
                for (int c = 0; c < 4; ++c) { O[0][4 + c] = mfma16(vv[c], pb0, O[0][4 + c]); O[1][4 + c] = mfma16(vv[c], pb1, O[1][4 + c]); }
                SCHED_FENCE();
            }
            started = true;
        }
        {   const bool wdone = started && __all(R[0] == 0.f && R[1] == 0.f);
            if (lane == 0) F.MISC[8 + 8 * slot + wave] = wdone ? 1u : 0u; }
        {   const int dl = slot ? -KV_TILE_BYTES : KV_TILE_BYTES;
#pragma unroll
            for (int c = 0; c < 8; ++c) va[c] += dl; }
        slot ^= 1;
    }
    int ge = g; asm volatile("" : "+v"(ge));
#pragma unroll
    for (int u = 0; u < 2; ++u) {
        int tq = tq0 + 16 * u; asm volatile("" : "+v"(tq));
        const bf16* grow = gp + (size_t)tq * NPROJ;
        bf16* orow = W_MIX + (size_t)(b * SEQ + tq) * DM + MX_SB + h * HD;
#pragma unroll
        for (int c = 0; c < 8; ++c) { const int d = 16 * c + 4 * ge;
            const u32x2 gw = *(const GAS u32x2*)(grow + d);
            const float y0 = O[u][c][0] * silu_f(bf_lo(gw.x)), y1 = O[u][c][1] * silu_f(bf_hi(gw.x)), y2 = O[u][c][2] * silu_f(bf_lo(gw.y)), y3 = O[u][c][3] * silu_f(bf_hi(gw.y));
            u32x2 w; w.x = pkbf(y0, y1); w.y = pkbf(y2, y3); *(GAS u32x2*)(orow + d) = w; }
    }
    asm volatile("s_waitcnt vmcnt(0)" ::: "memory");
}

constexpr int R_KIMG = 0, R_VIMG = IMG128, R_SIMG = 2 * IMG128, R_GTAB = 4 * IMG128;
__device__ __forceinline__ void ret_unit2(Frame& F, int b, int h, int layer) {
    const int tid = opaque_tid(), lane = tid & 63;
    int wave = F.wave; asm volatile("" : "+s"(wave));
    const int li = lane & 15, g = lane >> 4, q = li >> 2, p = lane & 3;
    const float lg2 = RET_LOG_GAMMA[h] * LOG2E;
    const float kscale = 0.08838834764831845f;
    const float cdecay = __builtin_amdgcn_exp2f(lg2 * 128.f);
    const bf16* base = W_PROJ + (size_t)(b * SEQ) * NPROJ;
    const bf16* qp = base + C_RQ + h * HD; const bf16* kp = base + C_RK + h * HD; const bf16* vp = base + C_RV + h * HD; const bf16* gp = base + C_RG + h * HD;
    float dl[4];
#pragma unroll
    for (int r = 0; r < 4; ++r) dl[r] = kscale * __builtin_amdgcn_exp2f(lg2 * (float)(li - 4 * g - r));
    const float qd = __builtin_amdgcn_exp2f(lg2 * (float)(16 * wave + li + 1));
    const unsigned lds0 = (unsigned)(size_t)F.lds;
    const unsigned a_row = lds0 + li * RS + 16 * g;
    const unsigned a_tra = lds0 + (4 * g + q) * RS + 8 * p;
    const unsigned a_trn = lds0 + (8 * g + q) * RS + 8 * p;
    LAS float* gtab = (LAS float*)(F.lds + R_GTAB);
    if (tid < HD) gtab[tid] = A_RETG[layer * RET_W + h * HD + tid];
    LAS float* kdt = gtab + 128; LAS float* g16 = gtab + 256;
    if (tid < 128) kdt[tid] = kscale * __builtin_amdgcn_exp2f(lg2 * (float)(127 - tid));
    if (tid < 8) g16[tid] = __builtin_amdgcn_exp2f(lg2 * (float)(16 * tid));
    u32x4 stK[4], stV[4];
#pragma unroll
    for (int i = 0; i < 4; ++i) { const int id = tid + 512 * i; const unsigned so = (unsigned)(id >> 4) * (NPROJ * 2) + 16 * (id & 15);
        stK[i] = *(const GAS u32x4*)((const char*)kp + so); stV[i] = *(const GAS u32x4*)((const char*)vp + so); }
    f32x4 ST[8];
#pragma unroll
    for (int d = 0; d < 8; ++d) ST[d] = (f32x4){0.f, 0.f, 0.f, 0.f};
    bf16x8 q0f, q1f, q2f, q3f;
    {   const size_t qrow = (size_t)(16 * wave + li) * NPROJ;
        q0f = *(const GAS bf16x8*)(qp + qrow + 8 * g); q1f = *(const GAS bf16x8*)(qp + qrow + 32 + 8 * g); q2f = *(const GAS bf16x8*)(qp + qrow + 64 + 8 * g); q3f = *(const GAS bf16x8*)(qp + qrow + 96 + 8 * g); }
#pragma unroll
    for (int i = 0; i < 4; ++i) { const int id = lane + 64 * i; *(LAS u32x4*)(lds0 + R_SIMG + (16 * wave + (id >> 4)) * RS + 16 * (id & 15)) = (u32x4){0u, 0u, 0u, 0u}; }
    asm volatile("" : "+v"(stK[0]), "+v"(stK[1]), "+v"(stK[2]), "+v"(stK[3]), "+v"(stV[0]), "+v"(stV[1]), "+v"(stV[2]), "+v"(stV[3]));
    for (int c = 0; c < SEQ / 128; ++c) {
        const int t0 = 128 * c;
        const int tl = opaque_tid(), li2 = tl & 15, g2 = (tl & 63) >> 4;
        asm volatile("s_barrier" ::: "memory");
#pragma unroll
        for (int i = 0; i < 4; ++i) { const int id = tl + 512 * i, row = id >> 4, sl = id & 15; *(LAS u32x4*)(lds0 + R_KIMG + row * RS + 16 * sl) = stK[i]; *(LAS u32x4*)(lds0 + R_VIMG + row * RS + 16 * sl) = stV[i]; }
        asm volatile("" ::: "memory");
        const size_t qrow = (size_t)(t0 + 16 * wave + li2) * NPROJ;
        const int tn = 128 * (c + 1);
        if (c + 1 < SEQ / 128) {
            const char* kn = (const char*)(kp + (size_t)tn * NPROJ); const char* vn = (const char*)(vp + (size_t)tn * NPROJ);
#pragma unroll
            for (int i = 0; i < 4; ++i) { const int id = tl + 512 * i; const unsigned so = (unsigned)(id >> 4) * (NPROJ * 2) + 16 * (id & 15); stK[i] = *(const GAS u32x4*)(kn + so); stV[i] = *(const GAS u32x4*)(vn + so); }
        }
        asm volatile("s_waitcnt lgkmcnt(0)\n\ts_barrier" ::: "memory");
        const int scur = R_SIMG + IMG128 * (c & 1), snxt = R_SIMG + IMG128 * ((c & 1) ^ 1);
#define R2_TRN(DST, IMG, KS, CT) DST = cat8(tr_read((const LAS unsigned char*)(a_trn + (IMG) + 32 * (KS) * RS + 32 * (CT))), tr_read((const LAS unsigned char*)(a_trn + (IMG) + 32 * (KS) * RS + 32 * (CT) + 4 * RS)))
#define R2_TRA(DST, IMG, KS, CT) DST = cat8(tr_read((const LAS unsigned char*)(a_tra + (IMG) + 32 * (KS) * RS + 32 * (CT))), tr_read((const LAS unsigned char*)(a_tra + (IMG) + 32 * (KS) * RS + 32 * (CT) + 16 * RS)))
#define R2_ROW(DST, IMG, RT, S4) DST = *(const LAS bf16x8*)(a_row + (IMG) + 16 * (RT) * RS + 64 * (S4))
#define R2_PIPE(NB, LOADF, MMAF) do { bf16x8 fa[4], fb[4]; LOADF(fa, 0); _Pragma("unroll") for (int bt = 0; bt < (NB); bt += 2) { \
            if (bt + 1 < (NB)) LOADF(fb, bt + 1); SCHED_FENCE(); MMAF(fa, bt); SCHED_FENCE(); \
            if (bt + 1 < (NB)) { if (bt + 2 < (NB)) LOADF(fa, bt + 2); SCHED_FENCE(); MMAF(fb, bt + 1); SCHED_FENCE(); } } } while (0)
        {   bf16x8 vfd[4];
            {   bf16x8 vn[4];
#pragma unroll
                for (int ks = 0; ks < 4; ++ks) R2_TRN(vn[ks], R_VIMG, ks, wave);
#pragma unroll
                for (int ks = 0; ks < 4; ++ks) { u32x4 w; const u32x4 vw = __builtin_bit_cast(u32x4, vn[ks]);
                    const f32x4 kd0 = *(const LAS f32x4*)(kdt + 32 * ks + 8 * g), kd1 = *(const LAS f32x4*)(kdt + 32 * ks + 8 * g + 4);
                    w[0] = pkbf(bf_lo(vw[0]) * kd0.x, bf_hi(vw[0]) * kd0.y); w[1] = pkbf(bf_lo(vw[1]) * kd0.z, bf_hi(vw[1]) * kd0.w);
                    w[2] = pkbf(bf_lo(vw[2]) * kd1.x, bf_hi(vw[2]) * kd1.y); w[3] = pkbf(bf_lo(vw[3]) * kd1.z, bf_hi(vw[3]) * kd1.w);
                    vfd[ks] = __builtin_bit_cast(bf16x8, w); } }
#pragma unroll
            for (int dt = 0; dt < 8; ++dt) ST[dt] = ST[dt] * cdecay;
            SCHED_FENCE();
#define R2_LD_ST(F, BT) do { _Pragma("unroll") for (int ks = 0; ks < 4; ++ks) R2_TRN(F[ks], R_KIMG, ks, (BT)); } while (0)
#define R2_MM_ST(F, BT) do { _Pragma("unroll") for (int ks = 0; ks < 4; ++ks) ST[(BT)] = mfma16(vfd[ks], F[ks], ST[(BT)]); } while (0)
            R2_PIPE(8, R2_LD_ST, R2_MM_ST);
#pragma unroll
            for (int dt = 0; dt < 8; ++dt)
#pragma unroll
                for (int r = 0; r < 4; ++r) *(LAS unsigned short*)(lds0 + (16 * wave + 4 * g2) * RS + 2 * li2 + snxt + r * RS + 32 * dt) = (unsigned short)(pkbf(ST[dt][r], 0.f) & 0xffffu);
        }
        SCHED_FENCE();
        f32x4 OUT[8];
#define R2_LD_CR(F, BT) do { _Pragma("unroll") for (int s = 0; s < 4; ++s) R2_ROW(F[s], scur, (BT), s); } while (0)
#define R2_MM_CR(F, BT) do { f32x4 acc = (f32x4){0.f, 0.f, 0.f, 0.f}; acc = mfma16(F[0], q0f, acc); acc = mfma16(F[1], q1f, acc); acc = mfma16(F[2], q2f, acc); acc = mfma16(F[3], q3f, acc); OUT[(BT)] = acc * qd; } while (0)
        R2_PIPE(8, R2_LD_CR, R2_MM_CR);
        SCHED_FENCE();
        bf16x8 pb[4];
        {   unsigned pk[8][2];
#define R2_LD_SC(F, BT) do { if ((BT) <= wave) { _Pragma("unroll") for (int s = 0; s < 4; ++s) R2_ROW(F[s], R_KIMG, (BT), s); } } while (0)
#define R2_MM_SC(F, BT) do { if ((BT) <= wave) { f32x4 S = (f32x4){0.f, 0.f, 0.f, 0.f}; S = mfma16(F[0], q0f, S); S = mfma16(F[1], q1f, S); S = mfma16(F[2], q2f, S); S = mfma16(F[3], q3f, S); \
                const float dtf = g16[wave - (BT)]; _Pragma("unroll") for (int r = 0; r < 4; ++r) { const float v = S[r] * (dl[r] * dtf); S[r] = ((BT) < wave || li - 4 * g - r >= 0) ? v : 0.f; } \
                pk[(BT)][0] = pkbf(S[0], S[1]); pk[(BT)][1] = pkbf(S[2], S[3]); } else { pk[(BT)][0] = 0u; pk[(BT)][1] = 0u; } } while (0)
            R2_PIPE(8, R2_LD_SC, R2_MM_SC);
#pragma unroll
            for (int ks = 0; ks < 4; ++ks) { u32x4 w; w.x = pk[2 * ks][0]; w.y = pk[2 * ks][1]; w.z = pk[2 * ks + 1][0]; w.w = pk[2 * ks + 1][1]; pb[ks] = __builtin_bit_cast(bf16x8, w); }
        }
        SCHED_FENCE();
        u32x2 gc[8];
#pragma unroll
        for (int et = 0; et < 8; ++et) gc[et] = *(const GAS u32x2*)(gp + qrow + 16 * et + 4 * g2);
        if (c + 1 < SEQ / 128) { const size_t qn = (size_t)(tn + 16 * wave + li2) * NPROJ;
            q0f = *(const GAS bf16x8*)(qp + qn + 8 * g2); q1f = *(const GAS bf16x8*)(qp + qn + 32 + 8 * g2); q2f = *(const GAS bf16x8*)(qp + qn + 64 + 8 * g2); q3f = *(const GAS bf16x8*)(qp + qn + 96 + 8 * g2); }
        SCHED_FENCE();
#define R2_LD_IN(F, BT) do { if (2 * ((BT) >> 1) <= wave) { _Pragma("unroll") for (int e4 = 0; e4 < 4; ++e4) R2_TRA(F[e4], R_VIMG, (BT) >> 1, 4 * ((BT) & 1) + e4); } } while (0)
#define R2_MM_IN(F, BT) do { if (2 * ((BT) >> 1) <= wave) { _Pragma("unroll") for (int e4 = 0; e4 < 4; ++e4) OUT[4 * ((BT) & 1) + e4] = mfma16(F[e4], pb[(BT) >> 1], OUT[4 * ((BT) & 1) + e4]); } } while (0)
        R2_PIPE(8, R2_LD_IN, R2_MM_IN);
#undef R2_LD_ST
#undef R2_MM_ST
#undef R2_LD_CR
#undef R2_MM_CR
#undef R2_LD_SC
#undef R2_MM_SC
#undef R2_LD_IN
#undef R2_MM_IN
#undef R2_PIPE
#undef R2_TRN
#undef R2_TRA
#undef R2_ROW
        SCHED_FENCE();
        {   float s1 = 0.f, s2 = 0.f;
#pragma unroll
            for (int et = 0; et < 8; ++et)
#pragma unroll
                for (int r = 0; r < 4; ++r) { s1 += OUT[et][r]; s2 = fmaf(OUT[et][r], OUT[et][r], s2); }
            s1 = xrow16_sum(s1); s2 = xrow16_sum(s2);
            const float mean = s1 * (1.0f / HD), var = fmaxf(s2 * (1.0f / HD) - mean * mean, 0.f), rstd = 1.0f / sqrtf(var + LN_EPS);
            asm volatile("" : "+v"(stK[0]), "+v"(stK[1]), "+v"(stK[2]), "+v"(stK[3]), "+v"(stV[0]), "+v"(stV[1]), "+v"(stV[2]), "+v"(stV[3]));
            bf16* orow = W_MIX + (size_t)(b * SEQ + t0 + 16 * wave + li2) * DM + MX_RET + h * HD + 4 * g2;
#pragma unroll
            for (int et = 0; et < 8; ++et) {
                const f32x4 gv = *(const LAS f32x4*)(gtab + 16 * et + 4 * g);
                const float y0 = (OUT[et][0] - mean) * rstd * gv.x * silu_f(bf_lo(gc[et].x)), y1 = (OUT[et][1] - mean) * rstd * gv.y * silu_f(bf_hi(gc[et].x));
                const float y2 = (OUT[et][2] - mean) * rstd * gv.z * silu_f(bf_lo(gc[et].y)), y3 = (OUT[et][3] - mean) * rstd * gv.w * silu_f(bf_hi(gc[et].y));
                u32x2 w; w.x = pkbf(y0, y1); w.y = pkbf(y2, y3); *(GAS u32x2*)(orow + 16 * et) = w; }
        }
    }
    asm volatile("s_waitcnt vmcnt(0) lgkmcnt(0)" ::: "memory");
}

__global__ void __launch_bounds__(NWAVES * 64, 2) mk_fwd(Args kernel_args  ) {
    extern __shared__ __attribute__((aligned(16))) unsigned char lds_raw[];
    Frame F;
    F.lds = (LAS unsigned char*)lds_raw;
    F.MISC = (volatile LAS unsigned*)(F.lds + MISC_OFF);
    F.wave = __builtin_amdgcn_readfirstlane((int)threadIdx.x >> 6);
    for (int u = F.wave * 64 + opaque_lane(); u < (LDS_BYTES - MISC_OFF) / 4; u += NWAVES * 64) F.MISC[u] = 0u;
    __syncthreads();
    XcdBarrier bar = xcd_barrier_post((unsigned*)(W_CTL + CW_BAR), F.MISC, (unsigned)F.wave);
#define GRID_BAR() do { XcdBarrier b_ = bar; asm volatile("" : "+s"(b_.bar), "+s"(b_.x)); xcd_barrier(b_); } while (0)

    p0_prologue(F);
    GRID_BAR();

    for (int layer = 0; layer < DEPTH; ++layer) {
        {   pg8::Gemm g{W_XB, W_WINT + (size_t)layer * NPROJ * DM, M, NPROJ, DM}; pg8::StaticOrder S; int c_ = (int)blockIdx.x; asm volatile("" : "+s"(c_)); S.init(M, NPROJ, (int)gridDim.x, c_);
            pg8::EpiBf16 E{W_PROJ, NPROJ, C_DQ / 256, (C_DQ + DIFF_W) / 256, 0.125f * LOG2E, C_SQ / 256, (C_SQ + SB_W) / 256, 0.08838834764831845f * LOG2E};
            pg8::gemm_phase<pg8::EpiBf16, pg8::StaticOrder, true, true>(F.lds, g, S, E, F.wave); }
        GRID_BAR();
        {   if (F.wave == 0) {
                const int ln = opaque_lane();
                const float a = A_LQ1[layer * 64 + ln] * A_LK1[layer * 64 + ln], c = A_LQ2[layer * 64 + ln] * A_LK2[layer * 64 + ln];
                const float lam = __expf(wave_sum(a)) - __expf(wave_sum(c)) + LAMBDA_INIT[layer];
                if (ln == 0) F.MISC[5] = __float_as_uint(lam); }
            gu32* qh = W_CTL + CW_Q + layer * 16 * 64;
            const int wg = (int)blockIdx.x;
            if (wg < BATCH * N_RET) { knorm_prepass(F, layer, F.wave); __syncthreads(); ret_unit2(F, wg / N_RET, wg % N_RET, layer); }
            {   constexpr int ND = BATCH * N_DIFF * (SEQ / 256), NSTAT = 256 - BATCH * N_RET;
                int u = wg >= BATCH * N_RET ? wg - BATCH * N_RET : NSTAT + next_unit(F, qh + 4 * 64);
                while (u < ND) { __syncthreads(); const int oc = DIFF_ORDER[u >> 2]; diff_unit2(F, u & 3, oc & 15, oc >> 4, layer); u = NSTAT + next_unit(F, qh + 4 * 64); } }
            {   constexpr int NSB = BATCH * N_SB * (SEQ / 256);
                int u = wg;
                while (u < NSB) { __syncthreads(); const int qb = SEQ / 256 - 1 - u / (BATCH * N_SB), bh = u % (BATCH * N_SB); sb_unit2(F, bh / N_SB, bh % N_SB, qb); u = 256 + next_unit(F, qh + 8 * 64); } }
        }
        GRID_BAR();
        {   pg8::Gemm g{W_MIX, W_WOUTT + (size_t)layer * DM * DM, M, DM, DM}; pg8::PanelOrder S; int c_ = (int)blockIdx.x; asm volatile("" : "+s"(c_)); S.init(M, c_);
            const float* xin = layer == 0 ? A_X : (const float*)((layer - 1) & 1 ? W_H : W_XH);
            float* xout = layer == DEPTH - 1 ? args.out : ((layer & 1) ? W_H : W_XH);
            pg8::EpiLnFused E{xin, xout, layer == DEPTH - 1 ? (bf16*)nullptr : W_XB, DM, DEEPNORM_ALPHA, A_LNG + layer * DM, A_LNB + layer * DM,
                              (unsigned long long*)(args.ws + WS_SLOTS), (unsigned*)(W_CTL + CW_LNC + layer * 64 * 64), (unsigned*)(W_CTL + CW_TMO), F.lds + 131072, F.wave};
            pg8::gemm_phase<pg8::EpiLnFused, pg8::PanelOrder, true, true>(F.lds, g, S, E, F.wave); }
        if (layer != DEPTH - 1) GRID_BAR();
    }
#undef GRID_BAR
}

extern "C" void kernel_launch(void* const* d_in, const int* in_sizes, int n_in, void* d_out, int out_size, void* d_ws, size_t ws_size, hipStream_t stream) {
    static int grid = 0;
    if (grid == 0) {
        if (n_in != 11 || in_sizes[0] != M * DM || out_size != M * DM || ws_size < WS_END) { fprintf(stderr, "kernel_launch: unexpected shapes (n_in %d, in0 %d, out %d, ws %zu); nothing launched\n", n_in, n_in > 0 ? in_sizes[0] : -1, out_size, ws_size); grid = -1; return; }
        int dev = 0, cus = 0, per_cu = 0;
        if (hipGetDevice(&dev) != hipSuccess || hipDeviceGetAttribute(&cus, hipDeviceAttributeMultiprocessorCount, dev) != hipSuccess) { grid = -1; return; }
        if (hipFuncSetAttribute((const void*)mk_fwd, hipFuncAttributeMaxDynamicSharedMemorySize, LDS_BYTES) != hipSuccess) { fprintf(stderr, "kernel_launch: hipFuncSetAttribute failed\n"); grid = -1; return; }
        if (hipOccupancyMaxActiveBlocksPerMultiprocessor(&per_cu, (const void*)mk_fwd, NWAVES * 64, LDS_BYTES) != hipSuccess || per_cu < 1) { fprintf(stderr, "kernel_launch: occupancy query reports %d workgroups per CU\n", per_cu); }
        (void)hipGetLastError();
        grid = cus;
        if (grid != 256) { fprintf(stderr, "kernel_launch: this build's fused output projection + LayerNorm needs exactly 256 workgroups (a 256-CU MI355X); found %d CUs; nothing launched\n", cus); grid = -1; return; }
    }
    if (grid < 0) return;
    if (hipMemsetAsync((char*)d_ws + WS_CTL, 0, CTL_ZERO_BYTES, stream) != hipSuccess) return;
    Args a{};
    for (int i = 0; i < 11; ++i) a.in[i] = (const float*)d_in[i];
    a.out = (float*)d_out; a.ws = (unsigned char*)d_ws;
    hipLaunchKernelGGL(mk_fwd, dim3(grid), dim3(NWAVES * 64), LDS_BYTES, stream, a);
}
```

```cpp
#include <hip/hip_runtime.h>
#include <cstdio>
#include <cstdint>
namespace pg8 {
#define PG8_LAS __attribute__((address_space(3)))
typedef unsigned short bf16_t;
typedef short bf16x8 __attribute__((ext_vector_type(8)));
typedef float f32x4 __attribute__((ext_vector_type(4)));
typedef unsigned u32x4 __attribute__((ext_vector_type(4)));
constexpr int BM = 256, BK = 64, HALF = 128, HTB = HALF * BK * 2  , STAGE_BYTES = 8 * HTB, NXCD = 8, WGM = 8;

__host__ __device__ __forceinline__ int lds_byte(int r, int c) { const int st = (r >> 4) * 2 + (c >> 5), rr = r & 15, cc = c & 31, ob = rr * 64 + cc * 2; return st * 1024 + (ob ^ (((ob >> 9) & 1) << 5)); }
__host__ __device__ __forceinline__ void stage_rc(int b, int& R, int& C) { const int st = b / 1024, sb = b % 1024, swz = sb ^ (((sb >> 9) & 1) << 5); R = (st >> 1) * 16 + swz / 64; C = (st & 1) * 32 + (swz % 64) / 2; }
__host__ __device__ __forceinline__ int perm32(int rho) { const int n = rho >> 4, i = rho & 15; return 8 * (i >> 2) + 4 * n + (i & 3); }

struct Unit { int pm, pn; };
struct Gemm { const bf16_t* A; const bf16_t* Bt; int M, N, K; };

struct StaticOrder {
    int nM, nN, nwg, G, c;
    __host__ __device__ void init(int M, int N, int G_, int c_) { nM = M / BM; nN = N / BM; nwg = nM * nN; G = G_; c = c_; }
    __host__ __device__ bool next(int i, Unit& u) const {
        const long L = (long)i * G + c; if (L >= nwg) return false;
        int wgid = (int)L; { const int q = nwg / NXCD, r = nwg % NXCD, xcd = wgid % NXCD, off = wgid / NXCD; wgid = (xcd < r ? xcd * (q + 1) : r * (q + 1) + (xcd - r) * q) + off; }
        const int nig = WGM * nN, gid = wgid / nig, fm = gid * WGM, gsz = (nM - fm) < WGM ? (nM - fm) : WGM;
        u.pm = fm + ((wgid % nig) % gsz); u.pn = (wgid % nig) / gsz; return true;
    }
    __device__ __forceinline__ void a_ready(const Unit&) const {}
    __device__ __forceinline__ void done(const Unit&) const {}
};
struct PanelOrder {
    int nM, c;
    __host__ __device__ void init(int M, int c_) { nM = M / BM; c = c_; }
    __host__ __device__ bool next(int i, Unit& u) const { if (16 * i >= nM) return false; const int x = c & 7, t = c >> 3; u.pm = 16 * i + 4 * (x >> 1) + (t >> 3); u.pn = 8 * (x & 1) + (t & 7); return true; }
    __device__ __forceinline__ void a_ready(const Unit&) const {}
    __device__ __forceinline__ void done(const Unit&) const {}
};
__device__ __forceinline__ unsigned cvt_pk_bf16(float lo, float hi) { unsigned r; asm volatile("v_cvt_pk_bf16_f32 %0, %1, %2" : "=v"(r) : "v"(lo), "v"(hi)); return r; }
struct EpiBf16 {
    static constexpr bool PERM = true, AFTER_DRAIN = false;
    bf16_t* O; int ldc; int sc_lo, sc_hi; float sc; int sd_lo, sd_hi; float sd;
    __device__ __forceinline__ void operator()(const f32x4 (&acc)[2][2][4][2], const Unit& u, int wr, int wc, int fr, int fq) const {
        const int row0 = u.pm * BM + wr * 64 + fr; const int col0 = u.pn * BM + wc * 32 + 8 * fq;
        const float s = (u.pn >= sc_lo && u.pn < sc_hi) ? sc : ((u.pn >= sd_lo && u.pn < sd_hi) ? sd : 1.0f);
#pragma unroll
        for (int ai = 0; ai < 2; ++ai)
#pragma unroll
            for (int m = 0; m < 4; ++m) { bf16_t* rowp = O + (size_t)(row0 + ai * HALF + m * 16) * ldc + col0;
#pragma unroll
                for (int bj = 0; bj < 2; ++bj) { const f32x4 v0 = acc[ai][bj][m][0] * s, v1 = acc[ai][bj][m][1] * s;
                    u32x4 w; w.x = cvt_pk_bf16(v0[0], v0[1]); w.y = cvt_pk_bf16(v0[2], v0[3]); w.z = cvt_pk_bf16(v1[0], v1[1]); w.w = cvt_pk_bf16(v1[2], v1[3]);
                    *(u32x4*)(rowp + bj * HALF) = w; } }
    }
};

__device__ __forceinline__ float xsum16(float x) {
    auto s = __builtin_amdgcn_permlane16_swap(__float_as_uint(x), __float_as_uint(x), false, false); x = __uint_as_float(s[0]) + __uint_as_float(s[1]);
    auto t = __builtin_amdgcn_permlane32_swap(__float_as_uint(x), __float_as_uint(x), false, false); return __uint_as_float(t[0]) + __uint_as_float(t[1]);
}
struct EpiLnFused {
    static constexpr bool PERM = false, AFTER_DRAIN = false;
    const float* X; float* XO; bf16_t* XBo; int ldc; float alpha; const float* gamma; const float* beta;
    unsigned long long* slots; unsigned* cnt; unsigned* tmo; PG8_LAS unsigned char* tab; int wave;
    __device__ __forceinline__ void operator()(f32x4 (&acc)[2][2][4][2], const Unit& u, int wr, int wc, int fr, int fq) const {
        typedef float f32x2v __attribute__((ext_vector_type(2)));
        const int row0 = u.pm * BM + wr * 64 + fr, col0 = u.pn * BM + wc * 32 + 4 * fq;
        PG8_LAS f32x2v* P = (PG8_LAS f32x2v*)tab;
        PG8_LAS f32x2v* S = (PG8_LAS f32x2v*)(tab + 8192);
        f32x4 xv[4][2][2];
        const unsigned ptab = (unsigned)(size_t)tab + (unsigned)((wr * 64 + fr) * 4 + wc) * 8u;
#define LNF_LDX(Q) do { const float* p_ = X + (size_t)(row0 + ((Q) >> 2) * HALF + ((Q) & 3) * 16) * ldc + col0; \
            asm volatile("global_load_dwordx4 %0, %4, off\n\tglobal_load_dwordx4 %1, %4, off offset:64\n\tglobal_load_dwordx4 %2, %4, off offset:512\n\tglobal_load_dwordx4 %3, %4, off offset:576" \
                         : "=&v"(xv[(Q) & 3][0][0]), "=&v"(xv[(Q) & 3][0][1]), "=&v"(xv[(Q) & 3][1][0]), "=&v"(xv[(Q) & 3][1][1]) : "v"(p_) : "memory"); } while (0)
#define LNF_WAIT(Q, N) asm volatile("s_waitcnt vmcnt(" #N ")" : "+v"(xv[(Q) & 3][0][0]), "+v"(xv[(Q) & 3][0][1]), "+v"(xv[(Q) & 3][1][0]), "+v"(xv[(Q) & 3][1][1]) :: "memory")
        static_assert(HALF == 128, "row offsets of the residual loads");
        LNF_LDX(0); LNF_LDX(1); LNF_LDX(2); LNF_LDX(3);
#pragma unroll
        for (int q = 0; q < 8; ++q) { const int ai = q >> 2, m = q & 3;
            if (q <= 4) LNF_WAIT(q, 12); else if (q == 5) LNF_WAIT(q, 8); else if (q == 6) LNF_WAIT(q, 4); else LNF_WAIT(q, 0);
            float s = 0.f, ss = 0.f;
#pragma unroll
            for (int bj = 0; bj < 2; ++bj)
#pragma unroll
                for (int n = 0; n < 2; ++n) { const f32x4 h = acc[ai][bj][m][n] + xv[q & 3][bj][n] * alpha; acc[ai][bj][m][n] = h;
                    s += (h[0] + h[1]) + (h[2] + h[3]); ss += (h[0] * h[0] + h[1] * h[1]) + (h[2] * h[2] + h[3] * h[3]); }
            if (q + 4 < 8) LNF_LDX(q + 4);
            s = xsum16(s); ss = xsum16(ss);
            if (fq == 0) { const f32x2v v_ = (f32x2v){s, ss}; asm volatile("ds_write_b64 %0, %1 offset:%2" :: "v"(ptab), "v"(v_), "n"((ai * HALF + m * 16) * 32) : "memory"); } }
#undef LNF_LDX
#undef LNF_WAIT
        asm volatile("s_waitcnt lgkmcnt(0)" ::: "memory"); __builtin_amdgcn_s_barrier(); asm volatile("" ::: "memory");
        const int lane = fr + 16 * fq, row = wave * 64 + lane;
        if (wave < 4) {
            const f32x2v a = P[row * 4 + 0], b = P[row * 4 + 1], c = P[row * 4 + 2], d = P[row * 4 + 3];
            const float s = (a.x + b.x) + (c.x + d.x), ss = (a.y + b.y) + (c.y + d.y);
            __hip_atomic_store(slots + ((size_t)(u.pm * BM + row) * 16 + u.pn), ((unsigned long long)__float_as_uint(ss) << 32) | __float_as_uint(s), __ATOMIC_RELAXED, __HIP_MEMORY_SCOPE_AGENT);
            asm volatile("s_waitcnt vmcnt(0)" ::: "memory");
        }
        __builtin_amdgcn_s_barrier(); asm volatile("" ::: "memory");
        if (wave == 0) {
            if (lane == 0) __hip_atomic_fetch_add(cnt + 64 * u.pm, 1u, __ATOMIC_RELAXED, __HIP_MEMORY_SCOPE_AGENT);
            unsigned spins = 0;
            while ((unsigned)__builtin_amdgcn_readfirstlane(__hip_atomic_load(cnt + 64 * u.pm, __ATOMIC_RELAXED, __HIP_MEMORY_SCOPE_AGENT)) < 16u) {
                if (++spins > (1u << 22)) { if (lane == 0) __hip_atomic_store(tmo, 1u, __ATOMIC_RELAXED, __HIP_MEMORY_SCOPE_AGENT); break; }
                __builtin_amdgcn_s_sleep(1); }
            __builtin_amdgcn_fence(__ATOMIC_ACQUIRE, "agent");
        }
        asm volatile("s_waitcnt vmcnt(0) lgkmcnt(0)" ::: "memory"); __builtin_amdgcn_s_barrier(); asm volatile("" ::: "memory");
        if (wave < 4) {
            const unsigned long long* sl = slots + (size_t)(u.pm * BM + row) * 16; float s = 0.f, ss = 0.f;
            f32x4 w[8];
            asm volatile("global_load_dwordx4 %0, %8, off sc1\n\tglobal_load_dwordx4 %1, %8, off offset:16 sc1\n\tglobal_load_dwordx4 %2, %8, off offset:32 sc1\n\tglobal_load_dwordx4 %3, %8, off offset:48 sc1\n\t"
                         "global_load_dwordx4 %4, %8, off offset:64 sc1\n\tglobal_load_dwordx4 %5, %8, off offset:80 sc1\n\tglobal_load_dwordx4 %6, %8, off offset:96 sc1\n\tglobal_load_dwordx4 %7, %8, off offset:112 sc1\n\t"
                         "s_waitcnt vmcnt(0)"
                         : "=&v"(w[0]), "=&v"(w[1]), "=&v"(w[2]), "=&v"(w[3]), "=&v"(w[4]), "=&v"(w[5]), "=&v"(w[6]), "=&v"(w[7]) : "v"(sl) : "memory");
#pragma unroll
            for (int t = 0; t < 8; ++t) { s += w[t][0] + w[t][2]; ss += w[t][1] + w[t][3]; }
            const float mean = s * (1.0f / 4096.0f), var = fmaxf(ss * (1.0f / 4096.0f) - mean * mean, 0.f);
            S[row] = (f32x2v){mean, 1.0f / sqrtf(var + 1e-5f)};
        }
        asm volatile("s_waitcnt lgkmcnt(0)" ::: "memory"); __builtin_amdgcn_s_barrier(); asm volatile("" ::: "memory");
        f32x4 gv[2][2], bv[2][2];
#pragma unroll
        for (int bj = 0; bj < 2; ++bj)
#pragma unroll
            for (int n = 0; n < 2; ++n) { gv[bj][n] = *(const f32x4*)(gamma + col0 + bj * HALF + n * 16); bv[bj][n] = *(const f32x4*)(beta + col0 + bj * HALF + n * 16); }
#pragma unroll
        for (int ai = 0; ai < 2; ++ai)
#pragma unroll
            for (int m = 0; m < 4; ++m) { const int r = ai * HALF + wr * 64 + m * 16 + fr; const f32x2v sr = S[r]; const size_t off = (size_t)(u.pm * BM + r) * ldc + col0;
#pragma unroll
                for (int bj = 0; bj < 2; ++bj)
#pragma unroll
                    for (int n = 0; n < 2; ++n) { const f32x4 y = ((acc[ai][bj][m][n] - sr.x) * sr.y) * gv[bj][n] + bv[bj][n];
                        *(f32x4*)(XO + off + bj * HALF + n * 16) = y;
                        if (XBo) { typedef unsigned u32x2v __attribute__((ext_vector_type(2))); u32x2v w; w.x = cvt_pk_bf16(y[0], y[1]); w.y = cvt_pk_bf16(y[2], y[3]); *(u32x2v*)(XBo + off + bj * HALF + n * 16) = w; } } }
    }
};

template <class Epi, class Sched, bool ALIGN_EPI = false, bool SP2 = false>
__device__ __forceinline__ void gemm_phase(PG8_LAS unsigned char* lds, const Gemm g, const Sched& S, const Epi& E, int wave_id  ) {
    int tid_; asm volatile("v_mbcnt_lo_u32_b32 %0, -1, 0\n\tv_mbcnt_hi_u32_b32 %0, -1, %0" : "=v"(tid_)); tid_ += 64 * wave_id;
    const int tid = tid_, wid = __builtin_amdgcn_readfirstlane(tid >> 6), lane = tid & 63, wr = wid >> 2, wc = wid & 3, fr = lane & 15, fq = lane >> 4;
    const int K = g.K, nt = K / BK;
    unsigned voffA[2], voffB[2];
#pragma unroll
    for (int i = 0; i < 2; ++i) { int R, C; stage_rc(tid * 16 + i * 8192, R, C); const int Rb = Epi::PERM ? ((R & ~31) + perm32(R & 31)) : R;
        voffA[i] = (unsigned)(R * K + C) * 2u; voffB[i] = (unsigned)(Rb * K + C) * 2u; }
    const size_t kstep = (size_t)(BK * 2);
    const size_t hstep = (size_t)HALF * K * 2;
    const size_t tstep = 2 * hstep;
    const unsigned ldsw = (unsigned)wid * 1024u;
    const int aoff = lds_byte(wr * 64 + fr, fq * 8), boff = lds_byte(wc * 32 + fr, fq * 8);
#define PG8_SA(b, h) (((b) * 2 + (h)) * HTB)
#define PG8_SB(b, h) ((4 + (b) * 2 + (h)) * HTB)
#define PG8_STAGE(bufoff, gbase, voff) do { _Pragma("unroll") for (int _i = 0; _i < 2; ++_i) \
        __builtin_amdgcn_global_load_lds((const unsigned*)((const char*)(gbase) + (voff)[_i]), (PG8_LAS unsigned*)(lds + (bufoff) + ldsw + _i * 8192), 16, 0, 0); } while (0)
#define PG8_LDA(dst, b, h) do { _Pragma("unroll") for (int m = 0; m < 4; ++m) _Pragma("unroll") for (int k = 0; k < 2; ++k) dst[m][k] = *(const PG8_LAS bf16x8*)(lds + PG8_SA(b, h) + aoff + m * 2048 + k * 1024); } while (0)
#define PG8_LDB(dst, b, h) do { _Pragma("unroll") for (int n = 0; n < 2; ++n) _Pragma("unroll") for (int k = 0; k < 2; ++k) dst[n][k] = *(const PG8_LAS bf16x8*)(lds + PG8_SB(b, h) + boff + n * 2048 + k * 1024); } while (0)
#define PG8_MMA(ai, bj, At, Bt) do { __builtin_amdgcn_s_setprio(1); _Pragma("unroll") for (int m = 0; m < 4; ++m) _Pragma("unroll") for (int n = 0; n < 2; ++n) _Pragma("unroll") for (int k = 0; k < 2; ++k) \
        acc[ai][bj][m][n] = __builtin_amdgcn_mfma_f32_16x16x32_bf16(Bt[n][k], At[m][k], acc[ai][bj][m][n], 0, 0, 0); __builtin_amdgcn_s_setprio(0); } while (0)
#define PG8_WAIT_V(n) asm volatile("s_waitcnt vmcnt(" #n ")" ::: "memory")
#define PG8_WAIT_L(n) asm volatile("s_waitcnt lgkmcnt(" #n ")" ::: "memory")
#define PG8_BAR __builtin_amdgcn_s_barrier()
#define PG8_SCHED __builtin_amdgcn_sched_barrier(0)
    Unit cur, nxt; int ui = 0;
    if (!S.next(0, cur)) return;
    f32x4 acc[2][2][4][2];
#pragma unroll
    for (int a = 0; a < 2; ++a)
#pragma unroll
        for (int b = 0; b < 2; ++b)
#pragma unroll
            for (int m = 0; m < 4; ++m)
#pragma unroll
                for (int n = 0; n < 2; ++n) acc[a][b][m][n] = (f32x4){0.f, 0.f, 0.f, 0.f};
    bf16x8 At[4][2], B0[2][2], B1[2][2];
    const char* cA = (const char*)g.A + (size_t)cur.pm * tstep; const char* cB = (const char*)g.Bt + (size_t)cur.pn * tstep;
    S.a_ready(cur);
    if constexpr (SP2) {
        PG8_STAGE(PG8_SB(0, 0), cB, voffB); PG8_STAGE(PG8_SB(0, 1), cB + hstep, voffB); PG8_STAGE(PG8_SA(0, 0), cA, voffA); PG8_STAGE(PG8_SA(0, 1), cA + hstep, voffA);
        if (wr == 1) PG8_BAR;
        PG8_WAIT_V(2); PG8_BAR;
        PG8_STAGE(PG8_SB(1, 0), cB + kstep, voffB); PG8_STAGE(PG8_SA(1, 0), cA + kstep, voffA); PG8_STAGE(PG8_SB(1, 1), cB + hstep + kstep, voffB);
        PG8_WAIT_V(6); PG8_BAR;
    } else {
        PG8_STAGE(PG8_SB(0, 0), cB, voffB); PG8_STAGE(PG8_SA(0, 0), cA, voffA); PG8_STAGE(PG8_SB(0, 1), cB + hstep, voffB); PG8_STAGE(PG8_SA(0, 1), cA + hstep, voffA);
        if (wr == 1) PG8_BAR;
        PG8_WAIT_V(4); PG8_BAR;
        PG8_STAGE(PG8_SB(1, 0), cB + kstep, voffB); PG8_STAGE(PG8_SA(1, 0), cA + kstep, voffA); PG8_STAGE(PG8_SB(1, 1), cB + hstep + kstep, voffB);
        PG8_WAIT_V(6); PG8_BAR;
    }
    for (;;) {
        const bool has_next = S.next(ui + 1, nxt);
        const char* nA = has_next ? (const char*)g.A + (size_t)nxt.pm * tstep : cA; const char* nB = has_next ? (const char*)g.Bt + (size_t)nxt.pn * tstep : cB;
        for (int t = 0; t < nt; t += 2) {
            const bool last = (t == nt - 2);
            const char* a1 = cA + (size_t)(t + 1) * kstep;
            const char* a2 = last ? nA : cA + (size_t)(t + 2) * kstep; const char* b2 = last ? nB : cB + (size_t)(t + 2) * kstep;
            const char* a3 = a2 + kstep; const char* b3 = b2 + kstep;
            if (last && has_next) S.a_ready(nxt);
            if constexpr (SP2) {
            PG8_LDB(B0, 0, 0); PG8_LDB(B1, 0, 1); PG8_SCHED; PG8_LDA(At, 0, 0); PG8_STAGE(PG8_SA(1, 1), a1 + hstep, voffA);
            PG8_WAIT_V(8); PG8_WAIT_L(0); PG8_BAR; PG8_MMA(0, 0, At, B0); PG8_MMA(0, 1, At, B1); PG8_BAR; PG8_SCHED;
            PG8_LDA(At, 0, 1); PG8_STAGE(PG8_SB(0, 0), b2, voffB); PG8_STAGE(PG8_SB(0, 1), b2 + hstep, voffB); PG8_STAGE(PG8_SA(0, 0), a2, voffA);
            PG8_WAIT_V(8); PG8_WAIT_L(0); PG8_BAR; PG8_MMA(1, 0, At, B0); PG8_MMA(1, 1, At, B1); PG8_BAR; PG8_SCHED;
            PG8_LDB(B0, 1, 0); PG8_LDB(B1, 1, 1); PG8_SCHED; PG8_LDA(At, 1, 0); PG8_STAGE(PG8_SA(0, 1), a2 + hstep, voffA);
            PG8_WAIT_V(8); PG8_WAIT_L(0); PG8_BAR; PG8_MMA(0, 0, At, B0); PG8_MMA(0, 1, At, B1); PG8_BAR; PG8_SCHED;
            PG8_LDA(At, 1, 1); PG8_STAGE(PG8_SB(1, 0), b3, voffB); PG8_STAGE(PG8_SB(1, 1), b3 + hstep, voffB); PG8_STAGE(PG8_SA(1, 0), a3, voffA);
            PG8_WAIT_V(8); PG8_WAIT_L(0); PG8_BAR; PG8_MMA(1, 0, At, B0); PG8_MMA(1, 1, At, B1); PG8_BAR; PG8_SCHED;
            } else {
            PG8_LDB(B0, 0, 0); PG8_SCHED; PG8_LDA(At, 0, 0); PG8_STAGE(PG8_SA(1, 1), a1 + hstep, voffA);
            PG8_WAIT_L(8); PG8_BAR; PG8_WAIT_L(0); PG8_MMA(0, 0, At, B0); PG8_BAR; PG8_SCHED;
            PG8_LDB(B1, 0, 1); PG8_STAGE(PG8_SB(0, 0), b2, voffB);
            PG8_BAR; PG8_WAIT_L(0); PG8_MMA(0, 1, At, B1); PG8_BAR;
            PG8_LDA(At, 0, 1); PG8_STAGE(PG8_SA(0, 0), a2, voffA);
            PG8_BAR; PG8_WAIT_L(0); PG8_MMA(1, 0, At, B0); PG8_BAR; PG8_SCHED;
            PG8_STAGE(PG8_SB(0, 1), b2 + hstep, voffB);
            PG8_WAIT_V(6); PG8_BAR; PG8_MMA(1, 1, At, B1); PG8_BAR;
            PG8_LDB(B0, 1, 0); PG8_SCHED; PG8_LDA(At, 1, 0); PG8_STAGE(PG8_SA(0, 1), a2 + hstep, voffA);
            PG8_WAIT_L(8); PG8_BAR; PG8_WAIT_L(0); PG8_MMA(0, 0, At, B0); PG8_BAR; PG8_SCHED;
            PG8_LDB(B1, 1, 1); PG8_STAGE(PG8_SB(1, 0), b3, voffB);
            PG8_BAR; PG8_WAIT_L(0); PG8_MMA(0, 1, At, B1); PG8_BAR;
            PG8_LDA(At, 1, 1); PG8_STAGE(PG8_SA(1, 0), a3, voffA);
            PG8_BAR; PG8_WAIT_L(0); PG8_MMA(1, 0, At, B0); PG8_BAR; PG8_SCHED;
            PG8_STAGE(PG8_SB(1, 1), b3 + hstep, voffB);
            PG8_WAIT_V(6); PG8_BAR; PG8_MMA(1, 1, At, B1); PG8_BAR;
            }
        }
        if constexpr (ALIGN_EPI) { if (wr == 0) PG8_BAR; }
        if constexpr (!Epi::AFTER_DRAIN) { E(acc, cur, wr, wc, fr, fq); S.done(cur); }
        if (!has_next) break;
#pragma unroll
        for (int a = 0; a < 2; ++a)
#pragma unroll
            for (int b = 0; b < 2; ++b)
#pragma unroll
                for (int m = 0; m < 4; ++m)
#pragma unroll
                    for (int n = 0; n < 2; ++n) acc[a][b][m][n] = (f32x4){0.f, 0.f, 0.f, 0.f};
        cur = nxt; cA = nA; cB = nB; ++ui;
        if constexpr (ALIGN_EPI) { if (wr == 1) PG8_BAR; }
    }
    PG8_WAIT_V(0);
    if constexpr (!ALIGN_EPI) { if (wr == 0) PG8_BAR; }
    PG8_BAR;
    if constexpr (Epi::AFTER_DRAIN) { E.fused(acc, cur, wr, wc, fr, fq, lds, wid, lane); S.done(cur); }
#undef PG8_SA
#undef PG8_SB
#undef PG8_STAGE
#undef PG8_LDA
#undef PG8_LDB
#undef PG8_MMA
#undef PG8_WAIT_V
#undef PG8_WAIT_L
#undef PG8_BAR
#undef PG8_SCHED
}
}

constexpr int NWAVES = 8;
constexpr int DM = 4096, BATCH = 4, SEQ = 4096, DEPTH = 4, HD = 128;
constexpr int M = BATCH * SEQ;
constexpr int NPROJ = 4 * DM;
constexpr int N_RET = 12, N_SB = 10, N_DIFF = 10;
constexpr int RET_W = N_RET * HD, SB_W = N_SB * HD, DIFF_W = N_DIFF * HD;
constexpr int C_RQ = 0, C_RK = RET_W, C_RV = 2 * RET_W, C_RG = 3 * RET_W;
constexpr int C_SQ = 4 * RET_W, C_SK = C_SQ + SB_W, C_SV = C_SQ + 2 * SB_W, C_SG = C_SQ + 3 * SB_W;
constexpr int C_DQ = 4 * RET_W + 4 * SB_W, C_DK = C_DQ + DIFF_W, C_DV = C_DQ + 2 * DIFF_W, C_DG = C_DQ + 3 * DIFF_W;
constexpr int MX_RET = 0, MX_SB = RET_W, MX_DIFF = RET_W + SB_W;
static_assert(C_DG + DIFF_W == NPROJ && MX_DIFF + DIFF_W == DM, "column map");
constexpr float LN_EPS = 1e-5f;
constexpr float LOG2E = 1.4426950408889634f, LN2 = 0.6931471805599453f;
constexpr float DEEPNORM_ALPHA = 1.681792830507429f;
__device__ const float RET_LOG_GAMMA[12] = {-3.174869716e-02f, -1.574835740e-02f, -7.843177766e-03f, -3.913899418e-03f, -1.955034910e-03f, -9.770396864e-04f, -4.884005175e-04f, -2.441704273e-04f, -1.220777631e-04f, -6.103701890e-05f, -3.051804379e-05f, -1.525890548e-05f};
__device__ const float ALIBI_SLOPE[10] = {5.000000000e-01f, 2.500000000e-01f, 1.250000000e-01f, 6.250000000e-02f, 3.125000000e-02f, 1.562500000e-02f, 7.812500000e-03f, 3.906250000e-03f, 7.071067691e-01f, 3.535533845e-01f};
__device__ const float LAMBDA_INIT[4] = {0.20000000000000007f, 0.35550906759096934f, 0.4707130183435842f, 0.5560582041556406f};

constexpr size_t MiB = 1u << 20;
constexpr size_t WS_CTL = 0, CTL_ZERO_BYTES = 1 * MiB;
constexpr size_t WS_WIN = 16 * MiB;
constexpr size_t WS_WOUT = WS_WIN + (size_t)DEPTH * NPROJ * DM * 2;
constexpr size_t WS_XB = WS_WOUT + (size_t)DEPTH * DM * DM * 2;
constexpr size_t WS_XH = WS_XB + (size_t)M * DM * 2;
constexpr size_t WS_PROJ = WS_XH + (size_t)M * DM * 4;
constexpr size_t WS_MIX = WS_PROJ + (size_t)M * NPROJ * 2;
constexpr size_t WS_H = WS_MIX + (size_t)M * DM * 2;
constexpr size_t WS_SLOTS = WS_H + (size_t)M * DM * 4;
constexpr size_t WS_END = WS_SLOTS + (size_t)M * 16 * 8;
constexpr int CW_BAR = 4096;
constexpr int CW_Q = 16384;
constexpr int CW_PRE = 49152;
constexpr int CW_LNC = 131072;
constexpr int CW_TMO = 8;
constexpr int CW_TMAX = 65536, TMAX_LAYER = BATCH * N_DIFF * 2 * 64;
constexpr int RS = 272;
constexpr int IMG64 = 64 * RS, IMG128 = 128 * RS;
constexpr int SCR_BYTES = 159744;
constexpr int MISC_OFF = SCR_BYTES;
constexpr int LDS_BYTES = SCR_BYTES + 1024;
static_assert(pg8::STAGE_BYTES + 12288 <= SCR_BYTES && LDS_BYTES <= 163840, "LDS map");

#define GAS __attribute__((address_space(1)))
#define LAS __attribute__((address_space(3)))
typedef unsigned short bf16;
typedef unsigned u32x4 __attribute__((ext_vector_type(4)));
typedef unsigned u32x2 __attribute__((ext_vector_type(2)));
typedef float f32x4 __attribute__((ext_vector_type(4)));
typedef short bf16x8 __attribute__((ext_vector_type(8)));
typedef short s16x4 __attribute__((ext_vector_type(4)));
typedef GAS unsigned gu32;
#define RLX_AGENT __ATOMIC_RELAXED, __HIP_MEMORY_SCOPE_AGENT
#define LDS_WAIT() asm volatile("s_waitcnt lgkmcnt(0)" ::: "memory")
#define VM_WAIT() asm volatile("s_waitcnt vmcnt(0)" ::: "memory")
__device__ __forceinline__ unsigned f2bf(float f) { unsigned u = __builtin_bit_cast(unsigned, f); return (u + 0x7fffu + ((u >> 16) & 1u)) >> 16; }
__device__ __forceinline__ unsigned pk2(float lo, float hi) { return f2bf(lo) | (f2bf(hi) << 16); }
__device__ __forceinline__ unsigned pkbf(float lo, float hi) { unsigned r; asm volatile("v_cvt_pk_bf16_f32 %0, %1, %2" : "=v"(r) : "v"(lo), "v"(hi)); return r; }
__device__ __forceinline__ float bf_lo(unsigned w) { return __uint_as_float(w << 16); }
__device__ __forceinline__ float bf_hi(unsigned w) { return __uint_as_float(w & 0xffff0000u); }
#define XB_TMO      128
#define XB_XCNT(j)  (256  + 64 * (j))
#define XB_XSUB(j)  (1280 + 64 * (j))
#define XB_XGEN(j)  (2304 + 64 * (j))
#define XB_TOP      3328
#define XB_TOPGEN   3392
#define XCD_BAR_WORDS 3456
#define XB_SPIN_CAP (1u << 18)

__device__ __forceinline__ unsigned xb_ld(unsigned* p)              { return __hip_atomic_load(p, __ATOMIC_RELAXED, __HIP_MEMORY_SCOPE_AGENT); }
__device__ __forceinline__ unsigned xb_add(unsigned* p, unsigned v) { return __hip_atomic_fetch_add(p, v, __ATOMIC_RELAXED, __HIP_MEMORY_SCOPE_AGENT); }
__device__ __forceinline__ unsigned xb_xcc_id() { return (unsigned)__builtin_amdgcn_s_getreg((3 << 11) | 20) & 0xFu; }
#define XB_SPIN(cond, bar) do { unsigned _sp = 0; while (cond) { __builtin_amdgcn_s_sleep(1); \
    if ((++_sp & 255u) == 0u) { if (xb_ld(&(bar)[XB_TMO])) break; if (_sp > XB_SPIN_CAP) { atomicAdd(&(bar)[XB_TMO], 1u); break; } } } } while (0)

struct XcdBarrier {
    unsigned wv;
    unsigned* bar; unsigned x;
    volatile LAS unsigned* st;
};

__device__ __forceinline__ bool xb_lane0() { int t; asm volatile("v_mbcnt_lo_u32_b32 %0, -1, 0\n\tv_mbcnt_hi_u32_b32 %0, -1, %0" : "=v"(t)); return t == 0; }
__device__ __forceinline__ XcdBarrier xcd_barrier_post(unsigned* bar, volatile LAS unsigned* st, unsigned wv) {
    XcdBarrier b; b.wv = wv; b.bar = bar; b.x = xb_xcc_id(); b.st = st;
    if (wv == 0u && xb_lane0()) (void)xb_add(&bar[XB_XCNT(b.x)], 1u);
    return b;
}
__device__ __forceinline__ void xcd_barrier_complete(unsigned* bar, unsigned x, unsigned& nloc, unsigned& nx) {
    const unsigned G = gridDim.x * gridDim.y * gridDim.z;
    unsigned sum, cnt, mine, sp = 0u;
    for (;;) {
        sum = 0u; cnt = 0u; mine = 0u;
#pragma unroll
        for (unsigned j = 0; j < 16; ++j) { const unsigned c = xb_ld(&bar[XB_XCNT(j)]); sum += c; cnt += (c > 0u) ? 1u : 0u; mine = (j == x) ? c : mine; }
        if (sum == G) break;
        __builtin_amdgcn_s_sleep(1);
        if ((++sp & 255u) == 0u) { if (xb_ld(&bar[XB_TMO])) break; if (sp > XB_SPIN_CAP) { atomicAdd(&bar[XB_TMO], 1u); break; } }
    }
    nloc = mine > 0u ? mine : 1u; nx = cnt > 0u ? cnt : 1u;
}

__device__ __forceinline__ void xcd_barrier(const XcdBarrier& b) {
    asm volatile("s_waitcnt vmcnt(0)" ::: "memory");
    __syncthreads();
    if (b.wv == 0u && xb_lane0()) {
        unsigned* bar = b.bar;
        __builtin_amdgcn_s_waitcnt(0);
        unsigned nloc = b.st[0], nx = b.st[1];
        if (nloc == 0u) { xcd_barrier_complete(bar, b.x, nloc, nx); b.st[0] = nloc; b.st[1] = nx; }
        const unsigned old = xb_add(&bar[XB_XSUB(b.x)], 1u);
        const unsigned gen = old / nloc;
        if (old + 1u == (gen + 1u) * nloc) {
            __builtin_amdgcn_fence(__ATOMIC_RELEASE, "agent");
            asm volatile("s_waitcnt vmcnt(0)" ::: "memory");
            const unsigned og = xb_add(&bar[XB_TOP], 1u);
            const unsigned tg = og / nx;
            if (og + 1u == (tg + 1u) * nx) xb_add(&bar[XB_TOPGEN], 1u);
            else XB_SPIN(xb_ld(&bar[XB_TOPGEN]) == tg, bar);
            __builtin_amdgcn_fence(__ATOMIC_ACQUIRE, "agent");
            xb_add(&bar[XB_XGEN(b.x)], 1u);
            asm volatile("s_waitcnt vmcnt(0)" ::: "memory");
        } else {
            XB_SPIN(xb_ld(&bar[XB_XGEN(b.x)]) == gen, bar);
            __builtin_amdgcn_fence(__ATOMIC_ACQUIRE, "agent");
            asm volatile("s_waitcnt vmcnt(0)" ::: "memory");
        }
    }
    __syncthreads();
}

struct Args { const float* in[11]; float* out; unsigned char* ws; };
typedef const __attribute__((address_space(4))) Args CArgs;
__device__ __forceinline__ CArgs* kargs() { CArgs* p = (CArgs*)__builtin_amdgcn_kernarg_segment_ptr(); asm volatile("" : "+s"(p)); return p; }
#define args (*kargs())
struct Frame {
    LAS unsigned char* lds;
    volatile LAS unsigned* MISC;
    int wave;
};
__device__ __forceinline__ int opaque_lane() { int t; asm volatile("v_mbcnt_lo_u32_b32 %0, -1, 0\n\tv_mbcnt_hi_u32_b32 %0, -1, %0" : "=v"(t)); return t; }
#define opaque_tid() (F.wave * 64 + opaque_lane())
#define A_X       (args.in[0])
#define A_WIN     (args.in[1])
#define A_WOUT    (args.in[2])
#define A_LNG     (args.in[3])
#define A_LNB     (args.in[4])
#define A_RETG    (args.in[5])
#define A_DIFFG   (args.in[6])
#define A_LQ1     (args.in[7])
#define A_LK1     (args.in[8])
#define A_LQ2     (args.in[9])
#define A_LK2     (args.in[10])
#define W_CTL     ((gu32*)(args.ws + WS_CTL))
#define W_WINT    ((bf16*)(args.ws + WS_WIN))
#define W_WOUTT   ((bf16*)(args.ws + WS_WOUT))
#define W_XB      ((bf16*)(args.ws + WS_XB))
#define W_XH      ((float*)(args.ws + WS_XH))
#define W_PROJ    ((bf16*)(args.ws + WS_PROJ))
#define W_MIX     ((bf16*)(args.ws + WS_MIX))
#define W_H       ((float*)(args.ws + WS_H))
template <int CTRL> __device__ __forceinline__ float dpp_mov(float x) { return __builtin_bit_cast(float, __builtin_amdgcn_mov_dpp(__builtin_bit_cast(int, x), CTRL, 0xf, 0xf, true)); }
__device__ __forceinline__ float xrow16_max(float x) {
    auto s = __builtin_amdgcn_permlane16_swap(__float_as_uint(x), __float_as_uint(x), false, false);
    x = fmaxf(__uint_as_float(s[0]), __uint_as_float(s[1]));
    auto t = __builtin_amdgcn_permlane32_swap(__float_as_uint(x), __float_as_uint(x), false, false);
    return fmaxf(__uint_as_float(t[0]), __uint_as_float(t[1]));
}
__device__ __forceinline__ float xrow16_sum(float x) {
    auto s = __builtin_amdgcn_permlane16_swap(__float_as_uint(x), __float_as_uint(x), false, false);
    x = __uint_as_float(s[0]) + __uint_as_float(s[1]);
    auto t = __builtin_amdgcn_permlane32_swap(__float_as_uint(x), __float_as_uint(x), false, false);
    return __uint_as_float(t[0]) + __uint_as_float(t[1]);
}
__device__ __forceinline__ float wave_sum(float v) {
    v += dpp_mov<0xB1>(v); v += dpp_mov<0x4E>(v); v += dpp_mov<0x141>(v); v += dpp_mov<0x140>(v);
    return xrow16_sum(v);
}
__device__ __forceinline__ f32x4 mfma16(bf16x8 a, bf16x8 b, f32x4 c) { return __builtin_amdgcn_mfma_f32_16x16x32_bf16(a, b, c, 0, 0, 0); }
__device__ __forceinline__ s16x4 tr_read(const LAS unsigned char* p) { return __builtin_amdgcn_ds_read_tr16_b64_v4i16((LAS s16x4*)p); }
__device__ __forceinline__ bf16x8 cat8(s16x4 lo, s16x4 hi) { return (bf16x8){lo[0], lo[1], lo[2], lo[3], hi[0], hi[1], hi[2], hi[3]}; }
__device__ __forceinline__ float silu_f(float x) { return x * __builtin_amdgcn_rcpf(1.0f + __builtin_amdgcn_exp2f(-x * LOG2E)); }

__device__ __forceinline__ void p0_transpose_item(const float* W, int K, int N, bf16* WT, LAS float* scr, int item, int lane) {
    const int nblk = N / 32, kb = item / nblk, nb = item % nblk, k0 = 64 * kb, n0 = 32 * nb;
#pragma unroll
    for (int i = 0; i < 32; ++i) { const int kk = 2 * i + (lane >> 5); scr[kk * 33 + (lane & 31)] = __builtin_nontemporal_load(W + (size_t)(k0 + kk) * N + n0 + (lane & 31)); }
    LDS_WAIT(); asm volatile("" ::: "memory");
    const int c = lane & 7;
#pragma unroll
    for (int j = 0; j < 4; ++j) { const int n = (lane >> 3) + 8 * j; const LAS float* s = scr + (8 * c) * 33 + n;
        u32x4 o; o.x = pk2(s[0 * 33], s[1 * 33]); o.y = pk2(s[2 * 33], s[3 * 33]); o.z = pk2(s[4 * 33], s[5 * 33]); o.w = pk2(s[6 * 33], s[7 * 33]);
        __builtin_nontemporal_store(o, (GAS u32x4*)(WT + (size_t)(n0 + n) * K + k0 + 8 * c)); }
    LDS_WAIT(); asm volatile("" ::: "memory");
}
constexpr int CV_I_IN = (DM / 64) * (NPROJ / 32), CV_I_OUT = (DM / 64) * (DM / 32), CV_ITEMS = CV_I_IN + CV_I_OUT;
__device__ __forceinline__ void convert_item(int layer, int it, LAS float* scr, int lane) {
    if (it < CV_I_IN) p0_transpose_item(A_WIN + (size_t)layer * DM * NPROJ, DM, NPROJ, W_WINT + (size_t)layer * NPROJ * DM, scr, it, lane);
    else p0_transpose_item(A_WOUT + (size_t)layer * DM * DM, DM, DM, W_WOUTT + (size_t)layer * DM * DM, scr, it - CV_I_IN, lane);
}
__device__ __forceinline__ void p0_prologue(Frame& F0) {
    struct { LAS unsigned char* lds; int tid, lane, wave; } F; F.lds = F0.lds; F.wave = F0.wave; F.lane = opaque_lane(); F.tid = F.wave * 64 + F.lane;
    LAS float* scr = (LAS float*)(F.lds + F.wave * 16384);
    const int gw = blockIdx.x * NWAVES + F.wave, NGW = gridDim.x * NWAVES;
    for (int it = gw; it < DEPTH * CV_ITEMS; it += NGW) convert_item(it / CV_ITEMS, it % CV_ITEMS, scr, F.lane);
    const size_t nthr = (size_t)gridDim.x * NWAVES * 64, t0 = (size_t)blockIdx.x * NWAVES * 64 + F.tid;
    for (size_t i = t0; i < (size_t)M * DM / 8; i += nthr) {
        const f32x4 a = *(const GAS f32x4*)(A_X + i * 8), b = *(const GAS f32x4*)(A_X + i * 8 + 4);
        u32x4 o; o.x = pk2(a.x, a.y); o.y = pk2(a.z, a.w); o.z = pk2(b.x, b.y); o.w = pk2(b.z, b.w);
        *(GAS u32x4*)(W_XB + i * 8) = o; }
}
constexpr int CV_UNIT = 32, CV_UNITS = CV_ITEMS / CV_UNIT;
static_assert(CV_ITEMS % CV_UNIT == 0, "conversion units");
__device__ __forceinline__ void convert_unit(Frame& F, int layer, int u) {
    const int lane = opaque_lane(); LAS float* scr = (LAS float*)(F.lds + F.wave * 16384);
    for (int j = 0; j < CV_UNIT / NWAVES; ++j) convert_item(layer, u * CV_UNIT + F.wave * (CV_UNIT / NWAVES) + j, scr, lane);
}

__device__ __forceinline__ int next_unit(Frame& F, gu32* head) {
    __syncthreads();
    if (F.wave == 0 && opaque_lane() == 0) F.MISC[4] = __hip_atomic_fetch_add(head, 1u, RLX_AGENT);
    __syncthreads();
    return __builtin_amdgcn_readfirstlane((int)F.MISC[4]);
}
__device__ const unsigned char DIFF_ORDER[160] = {244, 245, 246, 247, 228, 229, 230, 231, 212, 213, 214, 215, 196, 197, 198, 199, 180, 181, 182, 183, 164, 165, 166, 167, 148, 149, 150, 151, 132, 133, 134, 135, 116, 117, 118, 119, 100, 101, 102, 103, 84, 85, 86, 87, 68, 69, 70, 71, 52, 53, 54, 55, 36, 37, 38, 39, 20, 21, 22, 23, 4, 5, 6, 7, 243, 227, 211, 195, 179, 163, 147, 131, 115, 99, 83, 242, 226, 210, 194, 178, 162, 146, 130, 114, 98, 82, 66, 67, 50, 51, 241, 225, 209, 193, 177, 161, 145, 129, 113, 97, 81, 65, 49, 33, 34, 35, 249, 233, 217, 201, 185, 169, 153, 137, 121, 105, 89, 73, 57, 41, 240, 224, 208, 192, 176, 160, 144, 128, 112, 96, 80, 64, 48, 32, 16, 17, 18, 19, 25, 248, 232, 216, 200, 184, 168, 152, 136, 120, 104, 88, 72, 56, 40, 24, 0, 1, 2, 3, 8, 9};
__device__ __forceinline__ void knorm_prepass(Frame& F, int layer, int wave) {
    const int lane = opaque_lane(), gw = blockIdx.x * NWAVES + wave, NGW = BATCH * N_RET * NWAVES;
    gu32* tm = W_CTL + CW_TMAX + layer * TMAX_LAYER; gu32* cnt = W_CTL + CW_PRE + layer * 64;
    unsigned ndone = 0;
    for (int it = gw; it < BATCH * N_DIFF * 128; it += NGW) {
        const int t32 = it & 127, bh = it >> 7, b = bh / N_DIFF, h = bh % N_DIFF;
        const bf16* kp = W_PROJ + (size_t)(b * SEQ + 32 * t32) * NPROJ + C_DK + h * HD + 8 * (lane & 15);
        u32x4 w[8];
#pragma unroll
        for (int i = 0; i < 8; ++i) w[i] = *(const GAS u32x4*)(kp + (size_t)(4 * i + (lane >> 4)) * NPROJ);
        float mx = 0.f;
#pragma unroll
        for (int i = 0; i < 8; ++i) { float s = 0.f;
#pragma unroll
            for (int j = 0; j < 4; ++j) { const float lo = bf_lo(w[i][j]), hi = bf_hi(w[i][j]); s = fmaf(lo, lo, s); s = fmaf(hi, hi, s); }
            s += dpp_mov<0xB1>(s); s += dpp_mov<0x4E>(s); s += dpp_mov<0x141>(s);
            mx = fmaxf(mx, s); }
        mx = xrow16_max(mx);
        if ((lane & 55) == 0) __hip_atomic_fetch_max(tm + ((bh * 2 + (lane >> 3)) * 64 + (t32 >> 1)), __float_as_uint(mx), RLX_AGENT);
        ++ndone;
    }
    asm volatile("s_waitcnt vmcnt(0)" ::: "memory");
    if (lane == 0) __hip_atomic_fetch_add((LAS unsigned*)&F.MISC[6], ndone, __ATOMIC_RELAXED, __HIP_MEMORY_SCOPE_WORKGROUP);
    __syncthreads();
    if (wave == 0 && lane == 0) { __hip_atomic_fetch_add(cnt, F.MISC[6], RLX_AGENT); F.MISC[6] = 0u; }
}
template <int CTRL, int ROWMASK> __device__ __forceinline__ float dpp_upd0(float x) { return __builtin_bit_cast(float, __builtin_amdgcn_update_dpp(0, __builtin_bit_cast(int, x), CTRL, ROWMASK, 0xf, true)); }
__device__ __forceinline__ float wave_prefix_max(float v) {
    v = fmaxf(v, dpp_upd0<0x111, 0xf>(v)); v = fmaxf(v, dpp_upd0<0x112, 0xf>(v)); v = fmaxf(v, dpp_upd0<0x114, 0xf>(v)); v = fmaxf(v, dpp_upd0<0x118, 0xf>(v));
    v = fmaxf(v, dpp_upd0<0x142, 0xa>(v)); v = fmaxf(v, dpp_upd0<0x143, 0xc>(v));
    return v;
}

constexpr int KV_TILE_BYTES = 64 * 256;
__device__ __forceinline__ int swz_k(int row) { return row & 15; }
__device__ __forceinline__ int swz_v(int row) { return (row & 15) ^ ((row & 1) << 3); }
__device__ __forceinline__ void glds16(const void* gsrc, unsigned lds_dst) { unsigned keep;
    asm volatile("s_mov_b32 %0, m0\n\ts_mov_b32 m0, %2\n\ts_nop 0\n\tglobal_load_lds_dwordx4 %1, off\n\ts_mov_b32 m0, %0" : "=&s"(keep) : "v"(gsrc), "s"(lds_dst) : "memory"); }
__device__ __forceinline__ void glds16_so(const void* gbase, unsigned voff, unsigned lds_dst) { unsigned keep;
    asm volatile("s_mov_b32 %0, m0\n\ts_mov_b32 m0, %2\n\ts_nop 0\n\tglobal_load_lds_dwordx4 %1, %3\n\ts_mov_b32 m0, %0" : "=&s"(keep) : "v"(voff), "s"(lds_dst), "s"(gbase) : "memory"); }
__device__ __forceinline__ void kv_dma_offsets(unsigned (&dmo)[4], int wave, int lane) {
#pragma unroll
    for (int i = 0; i < 2; ++i) { const int row = 4 * (2 * wave + i) + (lane >> 4), slot = lane & 15;
        dmo[2 * i] = (unsigned)row * (NPROJ * 2) + 16 * (slot ^ swz_k(row)); dmo[2 * i + 1] = (unsigned)row * (NPROJ * 2) + 16 * (slot ^ swz_v(row)); }
}
__device__ __forceinline__ void kv_dma(LAS unsigned char* kbuf, LAS unsigned char* vbuf, const bf16* kp, const bf16* vp, int k0, int wave, const unsigned (&dmo)[4]) {
    const char* kb = (const char*)(kp + (size_t)k0 * NPROJ); const char* vb = (const char*)(vp + (size_t)k0 * NPROJ);
#pragma unroll
    for (int i = 0; i < 2; ++i) { const int pc = 2 * wave + i;
        glds16_so(kb, dmo[2 * i], (unsigned)(size_t)(kbuf + 1024 * pc));
        glds16_so(vb, dmo[2 * i + 1], (unsigned)(size_t)(vbuf + 1024 * pc)); }
}
__device__ __forceinline__ void k_dma(LAS unsigned char* kbuf, const bf16* kp, int k0, int wave, const unsigned (&dmo)[4]) {
    const char* kb = (const char*)(kp + (size_t)k0 * NPROJ);
    glds16_so(kb, dmo[0], (unsigned)(size_t)(kbuf + 1024 * (2 * wave))); glds16_so(kb, dmo[2], (unsigned)(size_t)(kbuf + 1024 * (2 * wave + 1))); }
__device__ __forceinline__ void v_dma(LAS unsigned char* vbuf, const bf16* vp, int k0, int wave, const unsigned (&dmo)[4]) {
    const char* vb = (const char*)(vp + (size_t)k0 * NPROJ);
    glds16_so(vb, dmo[1], (unsigned)(size_t)(vbuf + 1024 * (2 * wave))); glds16_so(vb, dmo[3], (unsigned)(size_t)(vbuf + 1024 * (2 * wave + 1))); }
constexpr float NEG_MASK = -1e30f;
constexpr float DIFF_THR = 6.0f;
#ifndef SCHED_FENCE
#define SCHED_FENCE() __builtin_amdgcn_sched_barrier(0)
#endif
__device__ __forceinline__ float max3_raw(float a, float b, float c) { float r; asm("v_max3_f32 %0, %1, %2, %3" : "=v"(r) : "v"(a), "v"(b), "v"(c)); return r; }
__device__ __forceinline__ float max2_raw(float a, float b) { float r; asm("v_max_f32_e32 %0, %1, %2" : "=v"(r) : "v"(a), "v"(b)); return r; }
__device__ __forceinline__ void diff_sm32(bool force, bool diag, f32x4 (&S)[2], f32x4 (&O)[8], float& m, float& l, bf16x8& pb, int kq  ) {
    if (diag) {
        int kql = kq; asm volatile("" : "+v"(kql));
#pragma unroll
        for (int a = 0; a < 2; ++a)
#pragma unroll
            for (int r = 0; r < 4; ++r) if (kql + 16 * a + r > 0) S[a][r] = NEG_MASK;
    }
    const float pl = max3_raw(max3_raw(max3_raw(S[0][0], S[0][1], S[0][2]), S[0][3], S[1][0]), max2_raw(S[1][1], S[1][2]), S[1][3]);
    if (force || !__all(pl <= DIFF_THR)) {
        const float pmax = xrow16_max(pl);
        float mn = fmaxf(pmax, 0.f);
        if (force) { const float lt = xrow16_sum(l); if (lt == 0.f) mn = pmax; }
        if (pmax < -1e29f) mn = 0.f;
        const float alpha = __builtin_amdgcn_exp2f(-mn);
#pragma unroll
        for (int c = 0; c < 8; ++c) O[c] = O[c] * alpha;
        l *= alpha; m += mn;
#pragma unroll
        for (int a = 0; a < 2; ++a) S[a] = S[a] - mn;
    }
    float ps = 0.f;
#pragma unroll
    for (int a = 0; a < 2; ++a)
#pragma unroll
        for (int r = 0; r < 4; ++r) { const float pv = __builtin_amdgcn_exp2f(S[a][r]); S[a][r] = pv; ps += pv; }
    l += ps;
    u32x4 w; w.x = pkbf(S[0][0], S[0][1]); w.y = pkbf(S[0][2], S[0][3]); w.z = pkbf(S[1][0], S[1][1]); w.w = pkbf(S[1][2], S[1][3]);
    pb = __builtin_bit_cast(bf16x8, w);
}
#ifndef DT2_KQ_EARLY
#define DT2_KQ_EARLY 0
#endif
#define DT2_LOADKQ(HH, X) do { _Pragma("unroll") for (int a = 0; a < 2; ++a) _Pragma("unroll") for (int s = 0; s < 2; ++s) { \
        kf[a][s] = *(const LAS bf16x8*)(kb + kr[X][s] + 256 * (32 * (HH) + 16 * a)); qf[a][s] = *(const LAS bf16x8*)(qb + kr[X][s] + 256 * (16 * a)); } } while (0)
#define DT2_LOADV(DST, HH, C0) do { _Pragma("unroll") for (int c = 0; c < 4; ++c) \
        DST[c] = cat8(tr_read((const LAS unsigned char*)(va[(C0) + c] + 256 * (32 * (HH)))), tr_read((const LAS unsigned char*)(va[(C0) + c] + 256 * (32 * (HH) + 16)))); } while (0)
__device__ __forceinline__ void diff_tile2(bool force, bool diag, f32x4 (&O)[2][2][8], float (&m)[2][2], float (&l)[2][2], const unsigned (&kr)[2][2], unsigned kb, unsigned qb, const unsigned (&va)[8], float slope2, int kq0  ) {
    bf16x8 kf[2][2], qf[2][2];
    DT2_LOADKQ(1, 0);
#pragma unroll
    for (int blk = 0; blk < 4; ++blk) {
        const int hh = 1 - (blk >> 1), x = blk & 1;
        bf16x8 vv[4];
        f32x4 S0[2], S1[2];
        const float b0 = slope2 * (float)(kq0 + 32 * hh) - m[x][0], b1 = slope2 * (float)(kq0 + 32 * hh - 16) - m[x][1];
#pragma unroll
        for (int a = 0; a < 2; ++a)
#pragma unroll
            for (int r = 0; r < 4; ++r) { S0[a][r] = fmaf(slope2, (float)(16 * a + r), b0); S1[a][r] = fmaf(slope2, (float)(16 * a + r), b1); }
        SCHED_FENCE();
#pragma unroll
        for (int a = 0; a < 2; ++a)
#pragma unroll
            for (int s = 0; s < 2; ++s) { S0[a] = mfma16(kf[a][s], qf[0][s], S0[a]); S1[a] = mfma16(kf[a][s], qf[1][s], S1[a]); }
        bf16x8 pb0, pb1;
        SCHED_FENCE();
        DT2_LOADV(vv, hh, 0);
        SCHED_FENCE();
        diff_sm32(force, diag, S0, O[x][0], m[x][0], l[x][0], pb0, kq0 + 32 * hh);
        diff_sm32(force, diag, S1, O[x][1], m[x][1], l[x][1], pb1, kq0 + 32 * hh - 16);
        SCHED_FENCE();
#pragma unroll
        for (int c = 0; c < 4; ++c) { O[x][0][c] = mfma16(vv[c], pb0, O[x][0][c]); O[x][1][c] = mfma16(vv[c], pb1, O[x][1][c]); }
        SCHED_FENCE();
        DT2_LOADV(vv, hh, 4);
        SCHED_FENCE();
#pragma unroll
        for (int c = 0; c < 4; ++c) { O[x][0][4 + c] = mfma16(vv[c], pb0, O[x][0][4 + c]); O[x][1][4 + c] = mfma16(vv[c], pb1, O[x][1][4 + c]); }
        SCHED_FENCE();
        if (blk == 0) DT2_LOADKQ(1, 1); else if (blk == 1) DT2_LOADKQ(0, 0); else if (blk == 2) DT2_LOADKQ(0, 1);
        SCHED_FENCE();
    }
}
#undef DT2_LOADKQ
#undef DT2_LOADV
constexpr int DQ_IMG = 0, DK_RING = 65536, DV_RING = DK_RING + 2 * KV_TILE_BYTES;
__device__ __forceinline__ void diff_unit2(Frame& F, int b, int h, int qb, int layer) {
    const int tid_ = opaque_tid(), lane = tid_ & 63;
    const int wave = F.wave, li = lane & 15, g = lane >> 4;
    const int q0 = 256 * qb, tq0 = q0 + 32 * wave + li;
    const bf16* base = W_PROJ + (size_t)(b * SEQ) * NPROJ;
    const bf16* qp = base + C_DQ + h * HD; const bf16* kp = base + C_DK + h * HD; const bf16* vp = base + C_DV + h * HD; const bf16* gp = base + C_DG + h * HD;
    const float slope2 = ALIBI_SLOPE[h] * LOG2E;
    LAS unsigned char* kring = F.lds + 65536; LAS unsigned char* vring = F.lds + 65536 + 3 * KV_TILE_BYTES; constexpr int DTAB = 65536 + 5 * KV_TILE_BYTES;
    const int jt0 = 4 * qb + 3;
#pragma unroll
    for (int i = 0; i < 8; ++i) { const int row = 32 * wave + 4 * i + (lane >> 4), slot = lane & 15;
        glds16(qp + (size_t)(q0 + row) * NPROJ + 8 * (slot ^ swz_k(row)), (unsigned)(size_t)(F.lds + DQ_IMG + 1024 * (8 * wave + i))); }
    unsigned dmo[4]; kv_dma_offsets(dmo, wave, lane);
    k_dma(kring, kp, 64 * jt0, wave, dmo); v_dma(vring, vp, 64 * jt0, wave, dmo); k_dma(kring + KV_TILE_BYTES, kp, 64 * (jt0 - 1), wave, dmo);
    f32x4 O[2][2][8]; float m[2][2], l[2][2];
#pragma unroll
    for (int x = 0; x < 2; ++x)
#pragma unroll
        for (int u = 0; u < 2; ++u) { m[x][u] = 0.f; l[x][u] = 0.f;
#pragma unroll
            for (int c = 0; c < 8; ++c) O[x][u][c] = (f32x4){0.f, 0.f, 0.f, 0.f}; }
    unsigned kr[2][2], va[8];
    {   const int q = li >> 2, p = lane & 3; const unsigned vb = (unsigned)(size_t)vring;
#pragma unroll
        for (int x = 0; x < 2; ++x)
#pragma unroll
            for (int s = 0; s < 2; ++s) kr[x][s] = 256 * li + 16 * ((8 * x + 4 * s + g) ^ swz_k(li));
#pragma unroll
        for (int c = 0; c < 8; ++c) va[c] = vb + 256 * (4 * g + q) + 16 * ((2 * c + (p >> 1)) ^ swz_v(4 * g + q)) + 8 * (p & 1); }
    const unsigned qbase = (unsigned)(size_t)(F.lds + DQ_IMG) + 256 * 32 * wave;
    LAS f32x4* qnp = (LAS f32x4*)(F.lds + DTAB) + tid_; LAS float* kprep = (LAS float*)(F.lds + DTAB + 8192 + 512 * wave);
    const bool canskip = ALIBI_SLOPE[h] * LOG2E * (float)SEQ > 200.0f;
    {   if (canskip) {
            gu32* cnt = W_CTL + CW_PRE + layer * 64; unsigned spins = 0;
            while (__builtin_amdgcn_readfirstlane(__hip_atomic_load(cnt, RLX_AGENT)) < (unsigned)(BATCH * N_DIFF * 128) && ++spins < (1u << 22)) __builtin_amdgcn_s_sleep(2);
            gu32* tm = W_CTL + CW_TMAX + layer * TMAX_LAYER + ((b * N_DIFF + h) * 2) * 64;
#pragma unroll
            for (int x = 0; x < 2; ++x) kprep[x * 64 + lane] = wave_prefix_max(sqrtf(__uint_as_float(__hip_atomic_load(tm + x * 64 + lane, RLX_AGENT))));
        }
        asm volatile("s_waitcnt vmcnt(0)" ::: "memory");
        f32x4 qv;
#pragma unroll
        for (int x = 0; x < 2; ++x)
#pragma unroll
            for (int u = 0; u < 2; ++u) { float s2 = 0.f;
#pragma unroll
                for (int s = 0; s < 2; ++s) { const u32x4 w = *(const LAS u32x4*)(qbase + kr[x][s] + 256 * (16 * u));
#pragma unroll
                    for (int j = 0; j < 4; ++j) { const float lo = bf_lo(w[j]), hi = bf_hi(w[j]); s2 = fmaf(lo, lo, s2); s2 = fmaf(hi, hi, s2); } }
                qv[2 * x + u] = sqrtf(xrow16_sum(s2)); }
        *qnp = qv;
    }
    int slot = 0, kslot = 0;
    bool first = true;
    for (int jt = jt0; jt >= 0; --jt) {
        if (jt >= 1) asm volatile("s_waitcnt vmcnt(2)\n\ts_barrier" ::: "memory"); else asm volatile("s_waitcnt vmcnt(0)\n\ts_barrier" ::: "memory");
        if (jt != jt0) {
            unsigned alld = 1u;
#pragma unroll
            for (int w = 0; w < 8; ++w) alld &= F.MISC[8 + 8 * (slot ^ 1) + w];
            if (__builtin_amdgcn_readfirstlane((int)alld)) break;
        }
        if (jt >= 1) v_dma(vring + (slot ^ 1) * KV_TILE_BYTES, vp, 64 * (jt - 1), wave, dmo);
        if (jt >= 2) k_dma(kring + (kslot == 0 ? 2 : kslot - 1) * KV_TILE_BYTES, kp, 64 * (jt - 2), wave, dmo);
        const int k0 = 64 * jt;
        if (k0 <= q0 + 32 * wave + 31) {
            const int kq0 = k0 + 4 * g - tq0;
            diff_tile2(first, k0 + 63 > q0 + 32 * wave, O, m, l, kr, (unsigned)(size_t)kring + kslot * KV_TILE_BYTES, qbase, va, slope2, kq0);
            first = false;
        }
        {
            bool wdone = false;
            if (canskip && !first && jt >= 1) {
                bool dn = true; const f32x4 qv = *qnp;
#pragma unroll
                for (int x = 0; x < 2; ++x) { const float kmx = kprep[x * 64 + jt - 1];
#pragma unroll
                    for (int u = 0; u < 2; ++u) dn = dn && (fmaf(qv[2 * x + u], kmx, slope2 * (float)(64 * jt - 1 - (tq0 + 16 * u))) - m[x][u] < -152.0f); }
                wdone = __all(dn);
            }
            if (lane == 0) F.MISC[8 + 8 * slot + wave] = wdone ? 1u : 0u;
        }
        {   const int dl = slot ? -KV_TILE_BYTES : KV_TILE_BYTES;
#pragma unroll
            for (int c = 0; c < 8; ++c) va[c] += dl; }
        slot ^= 1; kslot = kslot == 2 ? 0 : kslot + 1;
    }
    const float lam = __uint_as_float(F.MISC[5]);
    const float* gain = A_DIFFG + layer * DIFF_W + h * HD;
    int ge = g; asm volatile("" : "+v"(ge));
#pragma unroll
    for (int u = 0; u < 2; ++u) {
        const float l1 = xrow16_sum(l[0][u]), l2 = xrow16_sum(l[1][u]);
        const float c1 = 1.0f / l1, c2 = lam / l2;
        float ss = 0.f;
#pragma unroll
        for (int c = 0; c < 8; ++c)
#pragma unroll
            for (int r = 0; r < 4; ++r) { const float o = O[0][u][c][r] * c1 - O[1][u][c][r] * c2; O[0][u][c][r] = o; ss += o * o; }
        ss = xrow16_sum(ss);
        const float rstd = 1.0f / sqrtf(ss * (1.0f / HD) + LN_EPS) * (1.0f - LAMBDA_INIT[layer]);
        int tq = tq0 + 16 * u; asm volatile("" : "+v"(tq));
        const bf16* grow = gp + (size_t)tq * NPROJ;
        bf16* orow = W_MIX + (size_t)(b * SEQ + tq) * DM + MX_DIFF + h * HD;
#pragma unroll
        for (int c = 0; c < 8; ++c) { const int d = 16 * c + 4 * ge;
            const u32x2 gw = *(const GAS u32x2*)(grow + d); const f32x4 gn = *(const GAS f32x4*)(gain + d);
            const float y0 = O[0][u][c][0] * rstd * gn.x * silu_f(bf_lo(gw.x)), y1 = O[0][u][c][1] * rstd * gn.y * silu_f(bf_hi(gw.x));
            const float y2 = O[0][u][c][2] * rstd * gn.z * silu_f(bf_lo(gw.y)), y3 = O[0][u][c][3] * rstd * gn.w * silu_f(bf_hi(gw.y));
            u32x2 w; w.x = pkbf(y0, y1); w.y = pkbf(y2, y3); *(GAS u32x2*)(orow + d) = w;
            if (c & 1) asm volatile("" ::: "memory"); }
    }
    asm volatile("s_waitcnt vmcnt(0)" ::: "memory");
}

__device__ __forceinline__ float xor_partner(float own, unsigned s0, unsigned s1) { return __uint_as_float(s0 ^ s1 ^ __float_as_uint(own)); }
__device__ __forceinline__ void sb_group32(bool diag, f32x4 (&S)[2], float& R, bf16x8& pb, int kq  , int g) {
    float u[2][4], be[2][4];
#pragma unroll
    for (int a = 0; a < 2; ++a)
#pragma unroll
        for (int r = 0; r < 4; ++r) { const float e = __builtin_amdgcn_exp2f(S[a][r]); const float uu = __builtin_amdgcn_rcpf(1.0f + e); u[a][r] = uu; be[a][r] = e * uu; }
    if (diag) {
        int kql = kq; asm volatile("" : "+v"(kql));
#pragma unroll
        for (int a = 0; a < 2; ++a)
#pragma unroll
            for (int r = 0; r < 4; ++r) if (kql + 16 * a + r >= 0) { u[a][r] = 1.0f; be[a][r] = 0.f; }
    }
    float w[2][4], T[2];
#pragma unroll
    for (int a = 0; a < 2; ++a) { w[a][3] = 1.0f; w[a][2] = u[a][3]; w[a][1] = w[a][2] * u[a][2]; w[a][0] = w[a][1] * u[a][1]; T[a] = w[a][0] * u[a][0]; }
    float G[2], Tot[2];
#pragma unroll
    for (int a = 0; a < 2; ++a) {
        auto s = __builtin_amdgcn_permlane16_swap(__float_as_uint(T[a]), __float_as_uint(T[a]), false, false);
        const float pt = xor_partner(T[a], s[0], s[1]), pp = T[a] * pt;
        auto t = __builtin_amdgcn_permlane32_swap(__float_as_uint(pp), __float_as_uint(pp), false, false);
        const float po = xor_partner(pp, t[0], t[1]);
        G[a] = ((g & 1) ? 1.0f : pt) * ((g < 2) ? po : 1.0f); Tot[a] = pp * po; }
    const float c1 = R * G[1], c0 = R * Tot[1] * G[0];
#pragma unroll
    for (int r = 0; r < 4; ++r) { S[1][r] = be[1][r] * (c1 * w[1][r]); S[0][r] = be[0][r] * (c0 * w[0][r]); }
    R = R * Tot[1] * Tot[0];
    u32x4 pw; pw.x = pkbf(S[0][0], S[0][1]); pw.y = pkbf(S[0][2], S[0][3]); pw.z = pkbf(S[1][0], S[1][1]); pw.w = pkbf(S[1][2], S[1][3]);
    pb = __builtin_bit_cast(bf16x8, pw);
}
__device__ __forceinline__ void sb_unit2(Frame& F, int b, int h, int qb) {
    const int tid_ = opaque_tid(), lane = tid_ & 63;
    const int wave = F.wave, li = lane & 15, g = lane >> 4;
    const int q0 = 256 * qb, tq0 = q0 + 32 * wave + li;
    const bf16* base = W_PROJ + (size_t)(b * SEQ) * NPROJ;
    const bf16* qp = base + C_SQ + h * HD; const bf16* kp = base + C_SK + h * HD; const bf16* vp = base + C_SV + h * HD; const bf16* gp = base + C_SG + h * HD;
    LAS unsigned char* kring = F.lds + DK_RING; LAS unsigned char* vring = F.lds + DV_RING;
    const int jt0 = 4 * qb + 3;
#pragma unroll
    for (int i = 0; i < 8; ++i) { const int row = 32 * wave + 4 * i + (lane >> 4), slot = lane & 15;
        glds16(qp + (size_t)(q0 + row) * NPROJ + 8 * (slot ^ swz_k(row)), (unsigned)(size_t)(F.lds + DQ_IMG + 1024 * (8 * wave + i))); }
    unsigned dmo[4]; kv_dma_offsets(dmo, wave, lane);
    kv_dma(kring, vring, kp, vp, 64 * jt0, wave, dmo);
    f32x4 O[2][8]; float R[2] = {1.0f, 1.0f};
#pragma unroll
    for (int u = 0; u < 2; ++u)
#pragma unroll
        for (int c = 0; c < 8; ++c) O[u][c] = (f32x4){0.f, 0.f, 0.f, 0.f};
    unsigned kr[4], va[8];
    {   const int q = li >> 2, p = lane & 3; const unsigned vb = (unsigned)(size_t)vring;
#pragma unroll
        for (int s = 0; s < 4; ++s) kr[s] = 256 * li + 16 * ((4 * s + g) ^ swz_k(li));
#pragma unroll
        for (int c = 0; c < 8; ++c) va[c] = vb + 256 * (4 * g + q) + 16 * ((2 * c + (p >> 1)) ^ swz_v(4 * g + q)) + 8 * (p & 1); }
    const unsigned qbase = (unsigned)(size_t)(F.lds + DQ_IMG) + 256 * 32 * wave;
    asm volatile("s_waitcnt vmcnt(0)" ::: "memory");
    bf16x8 qf[2][4];
#pragma unroll
    for (int u = 0; u < 2; ++u)
#pragma unroll
        for (int s = 0; s < 4; ++s) qf[u][s] = *(const LAS bf16x8*)(qbase + kr[s] + 256 * (16 * u));
    int slot = 0; bool started = false;
    for (int jt = jt0; jt >= 0; --jt) {
        asm volatile("s_waitcnt vmcnt(0)\n\ts_barrier" ::: "memory");
        if (jt != jt0) {
            unsigned alld = 1u;
#pragma unroll
            for (int w = 0; w < 8; ++w) alld &= F.MISC[8 + 8 * (slot ^ 1) + w];
            if (__builtin_amdgcn_readfirstlane((int)alld)) break;
        }
        if (jt >= 1) kv_dma(kring + (slot ^ 1) * KV_TILE_BYTES, vring + (slot ^ 1) * KV_TILE_BYTES, kp, vp, 64 * (jt - 1), wave, dmo);
        const int k0 = 64 * jt;
        if (k0 <= q0 + 32 * wave + 30) {
            const bool diag = (k0 + 63 >= q0 + 32 * wave);
            const unsigned kb = (unsigned)(size_t)kring + slot * KV_TILE_BYTES;
            const int kq0 = k0 + 4 * g - tq0;
#pragma unroll
            for (int hh = 1; hh >= 0; --hh) {
                f32x4 S0[2], S1[2];
#pragma unroll
                for (int a = 0; a < 2; ++a) { S0[a] = (f32x4){0.f, 0.f, 0.f, 0.f}; S1[a] = (f32x4){0.f, 0.f, 0.f, 0.f};
#pragma unroll
                    for (int s = 0; s < 4; ++s) { const bf16x8 kf = *(const LAS bf16x8*)(kb + kr[s] + 256 * (32 * hh + 16 * a)); S0[a] = mfma16(kf, qf[0][s], S0[a]); S1[a] = mfma16(kf, qf[1][s], S1[a]); } }
                SCHED_FENCE();
                bf16x8 vv[4];
#pragma unroll
                for (int c = 0; c < 4; ++c) vv[c] = cat8(tr_read((const LAS unsigned char*)(va[c] + 256 * (32 * hh))), tr_read((const LAS unsigned char*)(va[c] + 256 * (32 * hh + 16))));
                SCHED_FENCE();
                bf16x8 pb0, pb1;
                sb_group32(diag, S0, R[0], pb0, kq0 + 32 * hh, g);
                sb_group32(diag, S1, R[1], pb1, kq0 + 32 * hh - 16, g);
                SCHED_FENCE();
#pragma unroll
                for (int c = 0; c < 4; ++c) { O[0][c] = mfma16(vv[c], pb0, O[0][c]); O[1][c] = mfma16(vv[c], pb1, O[1][c]); }
                SCHED_FENCE();
#pragma unroll
                for (int c = 0; c < 4; ++c) vv[c] = cat8(tr_read((const LAS unsigned char*)(va[4 + c] + 256 * (32 * hh))), tr_read((const LAS unsigned char*)(va[4 + c] + 256 * (32 * hh + 16))));
                SCHED_FENCE();
#pragma unroll
                for (int c = 0; c < 4; ++c) { O[0][4 + c] = mfma16(vv[c], pb0, O[0][4 + c]); O[1][4 + c] = mfma16(vv[c], pb1, O[1][4 + c]); }
                SCHED_FENCE();
            }
            started = true;
        }
        {   const bool wdone = started && __all(R[0] == 0.f && R[1] == 0.f);
            if (lane == 0) F.MISC[8 + 8 * slot + wave] = wdone ? 1u : 0u; }
        {   const int dl = slot ? -KV_TILE_BYTES : KV_TILE_BYTES;
#pragma unroll
            for (int c = 0; c < 8; ++c) va[c] += dl; }
        slot ^= 1;
    }
    int ge = g; asm volatile("" : "+v"(ge));
#pragma unroll
    for (int u = 0; u < 2; ++u) {
        int tq = tq0 + 16 * u; asm volatile("" : "+v"(tq));
        const bf16* grow = gp + (size_t)tq * NPROJ;
        bf16* orow = W_MIX + (size_t)(b * SEQ + tq) * DM + MX_SB + h * HD;
#pragma unroll
        for (int c = 0; c < 8; ++c) { const int d = 16 * c + 4 * ge;
            const u32x2 gw = *(const GAS u32x2*)(grow + d);
            const float y0 = O[u][c][0] * silu_f(bf_lo(gw.x)), y1 = O[u][c][1] * silu_f(bf_hi(gw.x)), y2 = O[u][c][2] * silu_f(bf_lo(gw.y)), y3 = O[u][c][3] * silu_f(bf_hi(gw.y));
            u32x2 w; w.x = pkbf(y0, y1); w.y = pkbf(y2, y3); *(GAS u32x2*)(orow + d) = w; }
    }
    asm volatile("s_waitcnt vmcnt(0)" ::: "memory");
}

constexpr int R_KIMG = 0, R_VIMG = IMG128, R_SIMG = 2 * IMG128, R_GTAB = 4 * IMG128;
__device__ __forceinline__ void ret_unit2(Frame& F, int b, int h, int layer) {
    const int tid = opaque_tid(), lane = tid & 63;
    int wave = F.wave; asm volatile("" : "+s"(wave));
    const int li = lane & 15, g = lane >> 4, q = li >> 2, p = lane & 3;
    const float lg2 = RET_LOG_GAMMA[h] * LOG2E;
    const float kscale = 0.08838834764831845f;
    const float cdecay = __builtin_amdgcn_exp2f(lg2 * 128.f);
    const bf16* base = W_PROJ + (size_t)(b * SEQ) * NPROJ;
    const bf16* qp = base + C_RQ + h * HD; const bf16* kp = base + C_RK + h * HD; const bf16* vp = base + C_RV + h * HD; const bf16* gp = base + C_RG + h * HD;
    float dl[4];
#pragma unroll
    for (int r = 0; r < 4; ++r) dl[r] = kscale * __builtin_amdgcn_exp2f(lg2 * (float)(li - 4 * g - r));
    const float qd = __builtin_amdgcn_exp2f(lg2 * (float)(16 * wave + li + 1));
    const unsigned lds0 = (unsigned)(size_t)F.lds;
    const unsigned a_row = lds0 + li * RS + 16 * g;
    const unsigned a_tra = lds0 + (4 * g + q) * RS + 8 * p;
    const unsigned a_trn = lds0 + (8 * g + q) * RS + 8 * p;
    LAS float* gtab = (LAS float*)(F.lds + R_GTAB);
    if (tid < HD) gtab[tid] = A_RETG[layer * RET_W + h * HD + tid];
    LAS float* kdt = gtab + 128; LAS float* g16 = gtab + 256;
    if (tid < 128) kdt[tid] = kscale * __builtin_amdgcn_exp2f(lg2 * (float)(127 - tid));
    if (tid < 8) g16[tid] = __builtin_amdgcn_exp2f(lg2 * (float)(16 * tid));
    u32x4 stK[4], stV[4];
#pragma unroll
    for (int i = 0; i < 4; ++i) { const int id = tid + 512 * i; const unsigned so = (unsigned)(id >> 4) * (NPROJ * 2) + 16 * (id & 15);
        stK[i] = *(const GAS u32x4*)((const char*)kp + so); stV[i] = *(const GAS u32x4*)((const char*)vp + so); }
    f32x4 ST[8];
#pragma unroll
    for (int d = 0; d < 8; ++d) ST[d] = (f32x4){0.f, 0.f, 0.f, 0.f};
    bf16x8 q0f, q1f, q2f, q3f;
    {   const size_t qrow = (size_t)(16 * wave + li) * NPROJ;
        q0f = *(const GAS bf16x8*)(qp + qrow + 8 * g); q1f = *(const GAS bf16x8*)(qp + qrow + 32 + 8 * g); q2f = *(const GAS bf16x8*)(qp + qrow + 64 + 8 * g); q3f = *(const GAS bf16x8*)(qp + qrow + 96 + 8 * g); }
#pragma unroll
    for (int i = 0; i < 4; ++i) { const int id = lane + 64 * i; *(LAS u32x4*)(lds0 + R_SIMG + (16 * wave + (id >> 4)) * RS + 16 * (id & 15)) = (u32x4){0u, 0u, 0u, 0u}; }
    asm volatile("" : "+v"(stK[0]), "+v"(stK[1]), "+v"(stK[2]), "+v"(stK[3]), "+v"(stV[0]), "+v"(stV[1]), "+v"(stV[2]), "+v"(stV[3]));
    for (int c = 0; c < SEQ / 128; ++c) {
        const int t0 = 128 * c;
        const int tl = opaque_tid(), li2 = tl & 15, g2 = (tl & 63) >> 4;
        asm volatile("s_barrier" ::: "memory");
#pragma unroll
        for (int i = 0; i < 4; ++i) { const int id = tl + 512 * i, row = id >> 4, sl = id & 15; *(LAS u32x4*)(lds0 + R_KIMG + row * RS + 16 * sl) = stK[i]; *(LAS u32x4*)(lds0 + R_VIMG + row * RS + 16 * sl) = stV[i]; }
        asm volatile("" ::: "memory");
        const size_t qrow = (size_t)(t0 + 16 * wave + li2) * NPROJ;
        const int tn = 128 * (c + 1);
        if (c + 1 < SEQ / 128) {
            const char* kn = (const char*)(kp + (size_t)tn * NPROJ); const char* vn = (const char*)(vp + (size_t)tn * NPROJ);
#pragma unroll
            for (int i = 0; i < 4; ++i) { const int id = tl + 512 * i; const unsigned so = (unsigned)(id >> 4) * (NPROJ * 2) + 16 * (id & 15); stK[i] = *(const GAS u32x4*)(kn + so); stV[i] = *(const GAS u32x4*)(vn + so); }
        }
        asm volatile("s_waitcnt lgkmcnt(0)\n\ts_barrier" ::: "memory");
        const int scur = R_SIMG + IMG128 * (c & 1), snxt = R_SIMG + IMG128 * ((c & 1) ^ 1);
#define R2_TRN(DST, IMG, KS, CT) DST = cat8(tr_read((const LAS unsigned char*)(a_trn + (IMG) + 32 * (KS) * RS + 32 * (CT))), tr_read((const LAS unsigned char*)(a_trn + (IMG) + 32 * (KS) * RS + 32 * (CT) + 4 * RS)))
#define R2_TRA(DST, IMG, KS, CT) DST = cat8(tr_read((const LAS unsigned char*)(a_tra + (IMG) + 32 * (KS) * RS + 32 * (CT))), tr_read((const LAS unsigned char*)(a_tra + (IMG) + 32 * (KS) * RS + 32 * (CT) + 16 * RS)))
#define R2_ROW(DST, IMG, RT, S4) DST = *(const LAS bf16x8*)(a_row + (IMG) + 16 * (RT) * RS + 64 * (S4))
#define R2_PIPE(NB, LOADF, MMAF) do { bf16x8 fa[4], fb[4]; LOADF(fa, 0); _Pragma("unroll") for (int bt = 0; bt < (NB); bt += 2) { \
            if (bt + 1 < (NB)) LOADF(fb, bt + 1); SCHED_FENCE(); MMAF(fa, bt); SCHED_FENCE(); \
            if (bt + 1 < (NB)) { if (bt + 2 < (NB)) LOADF(fa, bt + 2); SCHED_FENCE(); MMAF(fb, bt + 1); SCHED_FENCE(); } } } while (0)
        {   bf16x8 vfd[4];
            {   bf16x8 vn[4];
#pragma unroll
                for (int ks = 0; ks < 4; ++ks) R2_TRN(vn[ks], R_VIMG, ks, wave);
#pragma unroll
                for (int ks = 0; ks < 4; ++ks) { u32x4 w; const u32x4 vw = __builtin_bit_cast(u32x4, vn[ks]);
                    const f32x4 kd0 = *(const LAS f32x4*)(kdt + 32 * ks + 8 * g), kd1 = *(const LAS f32x4*)(kdt + 32 * ks + 8 * g + 4);
                    w[0] = pkbf(bf_lo(vw[0]) * kd0.x, bf_hi(vw[0]) * kd0.y); w[1] = pkbf(bf_lo(vw[1]) * kd0.z, bf_hi(vw[1]) * kd0.w);
                    w[2] = pkbf(bf_lo(vw[2]) * kd1.x, bf_hi(vw[2]) * kd1.y); w[3] = pkbf(bf_lo(vw[3]) * kd1.z, bf_hi(vw[3]) * kd1.w);
                    vfd[ks] = __builtin_bit_cast(bf16x8, w); } }
#pragma unroll
            for (int dt = 0; dt < 8; ++dt) ST[dt] = ST[dt] * cdecay;
            SCHED_FENCE();
#define R2_LD_ST(F, BT) do { _Pragma("unroll") for (int ks = 0; ks < 4; ++ks) R2_TRN(F[ks], R_KIMG, ks, (BT)); } while (0)
#define R2_MM_ST(F, BT) do { _Pragma("unroll") for (int ks = 0; ks < 4; ++ks) ST[(BT)] = mfma16(vfd[ks], F[ks], ST[(BT)]); } while (0)
            R2_PIPE(8, R2_LD_ST, R2_MM_ST);
#pragma unroll
            for (int dt = 0; dt < 8; ++dt)
#pragma unroll
                for (int r = 0; r < 4; ++r) *(LAS unsigned short*)(lds0 + (16 * wave + 4 * g2) * RS + 2 * li2 + snxt + r * RS + 32 * dt) = (unsigned short)(pkbf(ST[dt][r], 0.f) & 0xffffu);
        }
        SCHED_FENCE();
        f32x4 OUT[8];
#define R2_LD_CR(F, BT) do { _Pragma("unroll") for (int s = 0; s < 4; ++s) R2_ROW(F[s], scur, (BT), s); } while (0)
#define R2_MM_CR(F, BT) do { f32x4 acc = (f32x4){0.f, 0.f, 0.f, 0.f}; acc = mfma16(F[0], q0f, acc); acc = mfma16(F[1], q1f, acc); acc = mfma16(F[2], q2f, acc); acc = mfma16(F[3], q3f, acc); OUT[(BT)] = acc * qd; } while (0)
        R2_PIPE(8, R2_LD_CR, R2_MM_CR);
        SCHED_FENCE();
        bf16x8 pb[4];
        {   unsigned pk[8][2];
#define R2_LD_SC(F, BT) do { if ((BT) <= wave) { _Pragma("unroll") for (int s = 0; s < 4; ++s) R2_ROW(F[s], R_KIMG, (BT), s); } } while (0)
#define R2_MM_SC(F, BT) do { if ((BT) <= wave) { f32x4 S = (f32x4){0.f, 0.f, 0.f, 0.f}; S = mfma16(F[0], q0f, S); S = mfma16(F[1], q1f, S); S = mfma16(F[2], q2f, S); S = mfma16(F[3], q3f, S); \
                const float dtf = g16[wave - (BT)]; _Pragma("unroll") for (int r = 0; r < 4; ++r) { const float v = S[r] * (dl[r] * dtf); S[r] = ((BT) < wave || li - 4 * g - r >= 0) ? v : 0.f; } \
                pk[(BT)][0] = pkbf(S[0], S[1]); pk[(BT)][1] = pkbf(S[2], S[3]); } else { pk[(BT)][0] = 0u; pk[(BT)][1] = 0u; } } while (0)
            R2_PIPE(8, R2_LD_SC, R2_MM_SC);
#pragma unroll
            for (int ks = 0; ks < 4; ++ks) { u32x4 w; w.x = pk[2 * ks][0]; w.y = pk[2 * ks][1]; w.z = pk[2 * ks + 1][0]; w.w = pk[2 * ks + 1][1]; pb[ks] = __builtin_bit_cast(bf16x8, w); }
        }
        SCHED_FENCE();
        u32x2 gc[8];
#pragma unroll
        for (int et = 0; et < 8; ++et) gc[et] = *(const GAS u32x2*)(gp + qrow + 16 * et + 4 * g2);
        if (c + 1 < SEQ / 128) { const size_t qn = (size_t)(tn + 16 * wave + li2) * NPROJ;
            q0f = *(const GAS bf16x8*)(qp + qn + 8 * g2); q1f = *(const GAS bf16x8*)(qp + qn + 32 + 8 * g2); q2f = *(const GAS bf16x8*)(qp + qn + 64 + 8 * g2); q3f = *(const GAS bf16x8*)(qp + qn + 96 + 8 * g2); }
        SCHED_FENCE();
#define R2_LD_IN(F, BT) do { if (2 * ((BT) >> 1) <= wave) { _Pragma("unroll") for (int e4 = 0; e4 < 4; ++e4) R2_TRA(F[e4], R_VIMG, (BT) >> 1, 4 * ((BT) & 1) + e4); } } while (0)
#define R2_MM_IN(F, BT) do { if (2 * ((BT) >> 1) <= wave) { _Pragma("unroll") for (int e4 = 0; e4 < 4; ++e4) OUT[4 * ((BT) & 1) + e4] = mfma16(F[e4], pb[(BT) >> 1], OUT[4 * ((BT) & 1) + e4]); } } while (0)
        R2_PIPE(8, R2_LD_IN, R2_MM_IN);
#undef R2_LD_ST
#undef R2_MM_ST
#undef R2_LD_CR
#undef R2_MM_CR
#undef R2_LD_SC
#undef R2_MM_SC
#undef R2_LD_IN
#undef R2_MM_IN
#undef R2_PIPE
#undef R2_TRN
#undef R2_TRA
#undef R2_ROW
        SCHED_FENCE();
        {   float s1 = 0.f, s2 = 0.f;
#pragma unroll
            for (int et = 0; et < 8; ++et)
#pragma unroll
                for (int r = 0; r < 4; ++r) { s1 += OUT[et][r]; s2 = fmaf(OUT[et][r], OUT[et][r], s2); }
            s1 = xrow16_sum(s1); s2 = xrow16_sum(s2);
            const float mean = s1 * (1.0f / HD), var = fmaxf(s2 * (1.0f / HD) - mean * mean, 0.f), rstd = 1.0f / sqrtf(var + LN_EPS);
            asm volatile("" : "+v"(stK[0]), "+v"(stK[1]), "+v"(stK[2]), "+v"(stK[3]), "+v"(stV[0]), "+v"(stV[1]), "+v"(stV[2]), "+v"(stV[3]));
            bf16* orow = W_MIX + (size_t)(b * SEQ + t0 + 16 * wave + li2) * DM + MX_RET + h * HD + 4 * g2;
#pragma unroll
            for (int et = 0; et < 8; ++et) {
                const f32x4 gv = *(const LAS f32x4*)(gtab + 16 * et + 4 * g);
                const float y0 = (OUT[et][0] - mean) * rstd * gv.x * silu_f(bf_lo(gc[et].x)), y1 = (OUT[et][1] - mean) * rstd * gv.y * silu_f(bf_hi(gc[et].x));
                const float y2 = (OUT[et][2] - mean) * rstd * gv.z * silu_f(bf_lo(gc[et].y)), y3 = (OUT[et][3] - mean) * rstd * gv.w * silu_f(bf_hi(gc[et].y));
                u32x2 w; w.x = pkbf(y0, y1); w.y = pkbf(y2, y3); *(GAS u32x2*)(orow + 16 * et) = w; }
        }
    }
    asm volatile("s_waitcnt vmcnt(0) lgkmcnt(0)" ::: "memory");
}

__global__ void __launch_bounds__(NWAVES * 64, 2) mk_fwd(Args kernel_args  ) {
    extern __shared__ __attribute__((aligned(16))) unsigned char lds_raw[];
    Frame F;
    F.lds = (LAS unsigned char*)lds_raw;
    F.MISC = (volatile LAS unsigned*)(F.lds + MISC_OFF);
    F.wave = __builtin_amdgcn_readfirstlane((int)threadIdx.x >> 6);
    for (int u = F.wave * 64 + opaque_lane(); u < (LDS_BYTES - MISC_OFF) / 4; u += NWAVES * 64) F.MISC[u] = 0u;
    __syncthreads();
    XcdBarrier bar = xcd_barrier_post((unsigned*)(W_CTL + CW_BAR), F.MISC, (unsigned)F.wave);
#define GRID_BAR() do { XcdBarrier b_ = bar; asm volatile("" : "+s"(b_.bar), "+s"(b_.x)); xcd_barrier(b_); } while (0)

    p0_prologue(F);
    GRID_BAR();

    for (int layer = 0; layer < DEPTH; ++layer) {
        {   pg8::Gemm g{W_XB, W_WINT + (size_t)layer * NPROJ * DM, M, NPROJ, DM}; pg8::StaticOrder S; int c_ = (int)blockIdx.x; asm volatile("" : "+s"(c_)); S.init(M, NPROJ, (int)gridDim.x, c_);
            pg8::EpiBf16 E{W_PROJ, NPROJ, C_DQ / 256, (C_DQ + DIFF_W) / 256, 0.125f * LOG2E, C_SQ / 256, (C_SQ + SB_W) / 256, 0.08838834764831845f * LOG2E};
            pg8::gemm_phase<pg8::EpiBf16, pg8::StaticOrder, true, true>(F.lds, g, S, E, F.wave); }
        GRID_BAR();
        {   if (F.wave == 0) {
                const int ln = opaque_lane();
                const float a = A_LQ1[layer * 64 + ln] * A_LK1[layer * 64 + ln], c = A_LQ2[layer * 64 + ln] * A_LK2[layer * 64 + ln];
                const float lam = __expf(wave_sum(a)) - __expf(wave_sum(c)) + LAMBDA_INIT[layer];
                if (ln == 0) F.MISC[5] = __float_as_uint(lam); }
            gu32* qh = W_CTL + CW_Q + layer * 16 * 64;
            const int wg = (int)blockIdx.x;
            if (wg < BATCH * N_RET) { knorm_prepass(F, layer, F.wave); __syncthreads(); ret_unit2(F, wg / N_RET, wg % N_RET, layer); }
            {   constexpr int ND = BATCH * N_DIFF * (SEQ / 256), NSTAT = 256 - BATCH * N_RET;
                int u = wg >= BATCH * N_RET ? wg - BATCH * N_RET : NSTAT + next_unit(F, qh + 4 * 64);
                while (u < ND) { __syncthreads(); const int oc = DIFF_ORDER[u >> 2]; diff_unit2(F, u & 3, oc & 15, oc >> 4, layer); u = NSTAT + next_unit(F, qh + 4 * 64); } }
            {   constexpr int NSB = BATCH * N_SB * (SEQ / 256);
                int u = next_unit(F, qh + 8 * 64);
                while (u < NSB) { __syncthreads(); const int qb = SEQ / 256 - 1 - u / (BATCH * N_SB), bh = u % (BATCH * N_SB); sb_unit2(F, bh / N_SB, bh % N_SB, qb); u = next_unit(F, qh + 8 * 64); } }
        }
        GRID_BAR();
        {   pg8::Gemm g{W_MIX, W_WOUTT + (size_t)layer * DM * DM, M, DM, DM}; pg8::PanelOrder S; int c_ = (int)blockIdx.x; asm volatile("" : "+s"(c_)); S.init(M, c_);
            const float* xin = layer == 0 ? A_X : (const float*)((layer - 1) & 1 ? W_H : W_XH);
            float* xout = layer == DEPTH - 1 ? args.out : ((layer & 1) ? W_H : W_XH);
            pg8::EpiLnFused E{xin, xout, layer == DEPTH - 1 ? (bf16*)nullptr : W_XB, DM, DEEPNORM_ALPHA, A_LNG + layer * DM, A_LNB + layer * DM,
                              (unsigned long long*)(args.ws + WS_SLOTS), (unsigned*)(W_CTL + CW_LNC + layer * 64 * 64), (unsigned*)(W_CTL + CW_TMO), F.lds + 131072, F.wave};
            pg8::gemm_phase<pg8::EpiLnFused, pg8::PanelOrder, true, true>(F.lds, g, S, E, F.wave); }
        if (layer != DEPTH - 1) GRID_BAR();
    }
#undef GRID_BAR
}

extern "C" void kernel_launch(void* const* d_in, const int* in_sizes, int n_in, void* d_out, int out_size, void* d_ws, size_t ws_size, hipStream_t stream) {
    static int grid = 0;
    if (grid == 0) {
        if (n_in != 11 || in_sizes[0] != M * DM || out_size != M * DM || ws_size < WS_END) { fprintf(stderr, "kernel_launch: unexpected shapes (n_in %d, in0 %d, out %d, ws %zu); nothing launched\n", n_in, n_in > 0 ? in_sizes[0] : -1, out_size, ws_size); grid = -1; return; }
        int dev = 0, cus = 0, per_cu = 0;
        if (hipGetDevice(&dev) != hipSuccess || hipDeviceGetAttribute(&cus, hipDeviceAttributeMultiprocessorCount, dev) != hipSuccess) { grid = -1; return; }
        if (hipFuncSetAttribute((const void*)mk_fwd, hipFuncAttributeMaxDynamicSharedMemorySize, LDS_BYTES) != hipSuccess) { fprintf(stderr, "kernel_launch: hipFuncSetAttribute failed\n"); grid = -1; return; }
        if (hipOccupancyMaxActiveBlocksPerMultiprocessor(&per_cu, (const void*)mk_fwd, NWAVES * 64, LDS_BYTES) != hipSuccess || per_cu < 1) { fprintf(stderr, "kernel_launch: occupancy query reports %d workgroups per CU\n", per_cu); }
        (void)hipGetLastError();
        grid = cus;
        if (grid != 256) { fprintf(stderr, "kernel_launch: this build's fused output projection + LayerNorm needs exactly 256 workgroups (a 256-CU MI355X); found %d CUs; nothing launched\n", cus); grid = -1; return; }
    }
    if (grid < 0) return;
    if (hipMemsetAsync((char*)d_ws + WS_CTL, 0, CTL_ZERO_BYTES, stream) != hipSuccess) return;
    Args a{};
    for (int i = 0; i < 11; ++i) a.in[i] = (const float*)d_in[i];
    a.out = (float*)d_out; a.ws = (unsigned char*)d_ws;
    hipLaunchKernelGGL(mk_fwd, dim3(grid), dim3(NWAVES * 64), LDS_BYTES, stream, a);
}
```

```cpp
#include <hip/hip_runtime.h>
#include <cstdio>
#include <cstdint>
namespace pg8 {
#define PG8_LAS __attribute__((address_space(3)))
typedef unsigned short bf16_t;
typedef short bf16x8 __attribute__((ext_vector_type(8)));
typedef float f32x4 __attribute__((ext_vector_type(4)));
typedef unsigned u32x4 __attribute__((ext_vector_type(4)));
constexpr int BM = 256, BK = 64, HALF = 128, HTB = HALF * BK * 2  , STAGE_BYTES = 8 * HTB, NXCD = 8, WGM = 8;

__host__ __device__ __forceinline__ int lds_byte(int r, int c) { const int st = (r >> 4) * 2 + (c >> 5), rr = r & 15, cc = c & 31, ob = rr * 64 + cc * 2; return st * 1024 + (ob ^ (((ob >> 9) & 1) << 5)); }
__host__ __device__ __forceinline__ void stage_rc(int b, int& R, int& C) { const int st = b / 1024, sb = b % 1024, swz = sb ^ (((sb >> 9) & 1) << 5); R = (st >> 1) * 16 + swz / 64; C = (st & 1) * 32 + (swz % 64) / 2; }
__host__ __device__ __forceinline__ int perm32(int rho) { const int n = rho >> 4, i = rho & 15; return 8 * (i >> 2) + 4 * n + (i & 3); }

struct Unit { int pm, pn; };
struct Gemm { const bf16_t* A; const bf16_t* Bt; int M, N, K; };

struct StaticOrder {
    int nM, nN, nwg, G, c;
    __host__ __device__ void init(int M, int N, int G_, int c_) { nM = M / BM; nN = N / BM; nwg = nM * nN; G = G_; c = c_; }
    __host__ __device__ bool next(int i, Unit& u) const {
        const long L = (long)i * G + c; if (L >= nwg) return false;
        int wgid = (int)L; { const int q = nwg / NXCD, r = nwg % NXCD, xcd = wgid % NXCD, off = wgid / NXCD; wgid = (xcd < r ? xcd * (q + 1) : r * (q + 1) + (xcd - r) * q) + off; }
        const int nig = WGM * nN, gid = wgid / nig, fm = gid * WGM, gsz = (nM - fm) < WGM ? (nM - fm) : WGM;
        u.pm = fm + ((wgid % nig) % gsz); u.pn = (wgid % nig) / gsz; return true;
    }
    __device__ __forceinline__ void a_ready(const Unit&) const {}
    __device__ __forceinline__ void done(const Unit&) const {}
};
struct PanelOrder {
    int nM, c;
    __host__ __device__ void init(int M, int c_) { nM = M / BM; c = c_; }
    __host__ __device__ bool next(int i, Unit& u) const { if (16 * i >= nM) return false; const int x = c & 7, t = c >> 3; u.pm = 16 * i + 4 * (x >> 1) + (t >> 3); u.pn = 8 * (x & 1) + (t & 7); return true; }
    __device__ __forceinline__ void a_ready(const Unit&) const {}
    __device__ __forceinline__ void done(const Unit&) const {}
};
__device__ __forceinline__ unsigned cvt_pk_bf16(float lo, float hi) { unsigned r; asm volatile("v_cvt_pk_bf16_f32 %0, %1, %2" : "=v"(r) : "v"(lo), "v"(hi)); return r; }
struct EpiBf16 {
    static constexpr bool PERM = true, AFTER_DRAIN = false;
    bf16_t* O; int ldc; int sc_lo, sc_hi; float sc; int sd_lo, sd_hi; float sd;
    __device__ __forceinline__ void operator()(const f32x4 (&acc)[2][2][4][2], const Unit& u, int wr, int wc, int fr, int fq) const {
        const int row0 = u.pm * BM + wr * 64 + fr; const int col0 = u.pn * BM + wc * 32 + 8 * fq;
        const float s = (u.pn >= sc_lo && u.pn < sc_hi) ? sc : ((u.pn >= sd_lo && u.pn < sd_hi) ? sd : 1.0f);
#pragma unroll
        for (int ai = 0; ai < 2; ++ai)
#pragma unroll
            for (int m = 0; m < 4; ++m) { bf16_t* rowp = O + (size_t)(row0 + ai * HALF + m * 16) * ldc + col0;
#pragma unroll
                for (int bj = 0; bj < 2; ++bj) { const f32x4 v0 = acc[ai][bj][m][0] * s, v1 = acc[ai][bj][m][1] * s;
                    u32x4 w; w.x = cvt_pk_bf16(v0[0], v0[1]); w.y = cvt_pk_bf16(v0[2], v0[3]); w.z = cvt_pk_bf16(v1[0], v1[1]); w.w = cvt_pk_bf16(v1[2], v1[3]);
                    *(u32x4*)(rowp + bj * HALF) = w; } }
    }
};

__device__ __forceinline__ float xsum16(float x) {
    auto s = __builtin_amdgcn_permlane16_swap(__float_as_uint(x), __float_as_uint(x), false, false); x = __uint_as_float(s[0]) + __uint_as_float(s[1]);
    auto t = __builtin_amdgcn_permlane32_swap(__float_as_uint(x), __float_as_uint(x), false, false); return __uint_as_float(t[0]) + __uint_as_float(t[1]);
}
struct EpiLnFused {
    static constexpr bool PERM = false, AFTER_DRAIN = false;
    static constexpr int ldc = 4096; static constexpr float alpha = 1.681792830507429f;
    const float* X; float* XO; bf16_t* XBo; const float* gamma; const float* beta;
    unsigned long long* slots; unsigned flag  ; PG8_LAS unsigned char* tab; int wave;
    __device__ __forceinline__ void operator()(f32x4 (&acc)[2][2][4][2], const Unit& u, int wr, int wc, int fr_, int fq_) const {
        typedef float f32x2v __attribute__((ext_vector_type(2)));
        int fr = fr_, fq = fq_; asm volatile("" : "+v"(fr), "+v"(fq));
        const int row0 = u.pm * BM + wr * 64 + fr, col0 = u.pn * BM + wc * 32 + 4 * fq;
        PG8_LAS f32x2v* P = (PG8_LAS f32x2v*)tab;
        PG8_LAS f32x2v* S = (PG8_LAS f32x2v*)(tab + 8192);
        f32x4 xv[4][2][2];
        const unsigned ptab = (unsigned)(size_t)tab + (unsigned)((wr * 64 + fr) * 4 + wc) * 8u;
#define LNF_LDX(Q) do { const float* p_ = X + (size_t)(row0 + ((Q) >> 2) * HALF + ((Q) & 3) * 16) * ldc + col0; \
            asm volatile("global_load_dwordx4 %0, %4, off\n\tglobal_load_dwordx4 %1, %4, off offset:64\n\tglobal_load_dwordx4 %2, %4, off offset:512\n\tglobal_load_dwordx4 %3, %4, off offset:576" \
                         : "=&v"(xv[(Q) & 3][0][0]), "=&v"(xv[(Q) & 3][0][1]), "=&v"(xv[(Q) & 3][1][0]), "=&v"(xv[(Q) & 3][1][1]) : "v"(p_) : "memory"); } while (0)
#define LNF_WAIT(Q, N) asm volatile("s_waitcnt vmcnt(" #N ")" : "+v"(xv[(Q) & 3][0][0]), "+v"(xv[(Q) & 3][0][1]), "+v"(xv[(Q) & 3][1][0]), "+v"(xv[(Q) & 3][1][1]) :: "memory")
        static_assert(HALF == 128, "row offsets of the residual loads");
        LNF_LDX(0); LNF_LDX(1); LNF_LDX(2); LNF_LDX(3);
#pragma unroll
        for (int q = 0; q < 8; ++q) { const int ai = q >> 2, m = q & 3;
            if (q <= 4) LNF_WAIT(q, 12); else if (q == 5) LNF_WAIT(q, 8); else if (q == 6) LNF_WAIT(q, 4); else LNF_WAIT(q, 0);
            float s = 0.f, ss = 0.f;
#pragma unroll
            for (int bj = 0; bj < 2; ++bj)
#pragma unroll
                for (int n = 0; n < 2; ++n) { const f32x4 h = acc[ai][bj][m][n] + xv[q & 3][bj][n] * alpha; acc[ai][bj][m][n] = h;
                    s += (h[0] + h[1]) + (h[2] + h[3]); ss += (h[0] * h[0] + h[1] * h[1]) + (h[2] * h[2] + h[3] * h[3]); }
            if (q + 4 < 8) LNF_LDX(q + 4);
            s = xsum16(s); ss = xsum16(ss);
            if (fq == 0) { const f32x2v v_ = (f32x2v){s, ss}; asm volatile("ds_write_b64 %0, %1 offset:%2" :: "v"(ptab), "v"(v_), "n"((ai * HALF + m * 16) * 32) : "memory"); } }
#undef LNF_LDX
#undef LNF_WAIT
        asm volatile("s_waitcnt lgkmcnt(0)" ::: "memory"); __builtin_amdgcn_s_barrier(); asm volatile("" ::: "memory");
        const int lane = fr + 16 * fq, row = wave * 64 + lane;
        if (wave < 4) {
            {   const f32x2v a = P[row * 4 + 0], b = P[row * 4 + 1], c = P[row * 4 + 2], d = P[row * 4 + 3];
                const float s = (a.x + b.x) + (c.x + d.x), ss = (a.y + b.y) + (c.y + d.y);
                __hip_atomic_store(slots + ((size_t)(u.pm * BM + row) * 16 + u.pn), ((unsigned long long)((__float_as_uint(ss) & 0x7fffffffu) | flag) << 32) | __float_as_uint(s), __ATOMIC_RELAXED, __HIP_MEMORY_SCOPE_AGENT); }
            const unsigned long long* sl = slots + (size_t)(u.pm * BM + row) * 16; float s = 0.f, ss = 0.f;
            f32x4 w[8]; unsigned spins = 0;
            __builtin_amdgcn_s_sleep(48);
            for (;;) {
                asm volatile("global_load_dwordx4 %0, %8, off sc1\n\tglobal_load_dwordx4 %1, %8, off offset:16 sc1\n\tglobal_load_dwordx4 %2, %8, off offset:32 sc1\n\tglobal_load_dwordx4 %3, %8, off offset:48 sc1\n\t"
                             "global_load_dwordx4 %4, %8, off offset:64 sc1\n\tglobal_load_dwordx4 %5, %8, off offset:80 sc1\n\tglobal_load_dwordx4 %6, %8, off offset:96 sc1\n\tglobal_load_dwordx4 %7, %8, off offset:112 sc1\n\t"
                             "s_waitcnt vmcnt(0)"
                             : "=&v"(w[0]), "=&v"(w[1]), "=&v"(w[2]), "=&v"(w[3]), "=&v"(w[4]), "=&v"(w[5]), "=&v"(w[6]), "=&v"(w[7]) : "v"(sl) : "memory");
                unsigned bad = 0u;
#pragma unroll
                for (int t = 0; t < 8; ++t) bad |= (__float_as_uint(w[t][1]) ^ flag) | (__float_as_uint(w[t][3]) ^ flag);
                if (__all((bad & 0x80000000u) == 0u)) break;
                if (++spins > (1u << 21)) break;
                __builtin_amdgcn_s_sleep(12); }
#pragma unroll
            for (int t = 0; t < 8; ++t) { s += w[t][0] + w[t][2]; ss += __uint_as_float(__float_as_uint(w[t][1]) & 0x7fffffffu) + __uint_as_float(__float_as_uint(w[t][3]) & 0x7fffffffu); }
            const float mean = s * (1.0f / 4096.0f), var = fmaxf(ss * (1.0f / 4096.0f) - mean * mean, 0.f);
            S[row] = (f32x2v){mean, 1.0f / sqrtf(var + 1e-5f)};
        }
        asm volatile("s_waitcnt lgkmcnt(0)" ::: "memory"); __builtin_amdgcn_s_barrier(); asm volatile("" ::: "memory");
        f32x4 gv[2][2], bv[2][2];
#pragma unroll
        for (int bj = 0; bj < 2; ++bj)
#pragma unroll
            for (int n = 0; n < 2; ++n) { gv[bj][n] = *(const f32x4*)(gamma + col0 + bj * HALF + n * 16); bv[bj][n] = *(const f32x4*)(beta + col0 + bj * HALF + n * 16); }
#pragma unroll
        for (int ai = 0; ai < 2; ++ai)
#pragma unroll
            for (int m = 0; m < 4; ++m) { const int r = ai * HALF + wr * 64 + m * 16 + fr; const f32x2v sr = S[r]; const size_t off = (size_t)(u.pm * BM + r) * ldc + col0;
#pragma unroll
                for (int bj = 0; bj < 2; ++bj)
#pragma unroll
                    for (int n = 0; n < 2; ++n) { const f32x4 y = ((acc[ai][bj][m][n] - sr.x) * sr.y) * gv[bj][n] + bv[bj][n];
                        *(f32x4*)(XO + off + bj * HALF + n * 16) = y;
                        if (XBo) { typedef unsigned u32x2v __attribute__((ext_vector_type(2))); u32x2v w; w.x = cvt_pk_bf16(y[0], y[1]); w.y = cvt_pk_bf16(y[2], y[3]); *(u32x2v*)(XBo + off + bj * HALF + n * 16) = w; } } }
    }
};

template <class Epi, class Sched, bool ALIGN_EPI = false, bool SP2 = false>
__device__ __forceinline__ void gemm_phase(PG8_LAS unsigned char* lds, const Gemm g, const Sched& S, const Epi& E, int wave_id  ) {
    int tid_; asm volatile("v_mbcnt_lo_u32_b32 %0, -1, 0\n\tv_mbcnt_hi_u32_b32 %0, -1, %0" : "=v"(tid_)); tid_ += 64 * wave_id;
    const int tid = tid_, wid = __builtin_amdgcn_readfirstlane(tid >> 6), lane = tid & 63, wr = wid >> 2, wc = wid & 3, fr = lane & 15, fq = lane >> 4;
    const int K = g.K, nt = K / BK;
    unsigned voffA[2], voffB[2];
#pragma unroll
    for (int i = 0; i < 2; ++i) { int R, C; stage_rc(tid * 16 + i * 8192, R, C); const int Rb = Epi::PERM ? ((R & ~31) + perm32(R & 31)) : R;
        voffA[i] = (unsigned)(R * K + C) * 2u; voffB[i] = (unsigned)(Rb * K + C) * 2u; }
    const size_t kstep = (size_t)(BK * 2);
    const size_t hstep = (size_t)HALF * K * 2;
    const size_t tstep = 2 * hstep;
    const unsigned ldsw = (unsigned)wid * 1024u;
    const int aoff = lds_byte(wr * 64 + fr, fq * 8), boff = lds_byte(wc * 32 + fr, fq * 8);
#define PG8_SA(b, h) (((b) * 2 + (h)) * HTB)
#define PG8_SB(b, h) ((4 + (b) * 2 + (h)) * HTB)
#define PG8_STAGE(bufoff, gbase, voff) do { _Pragma("unroll") for (int _i = 0; _i < 2; ++_i) \
        __builtin_amdgcn_global_load_lds((const unsigned*)((const char*)(gbase) + (voff)[_i]), (PG8_LAS unsigned*)(lds + (bufoff) + ldsw + _i * 8192), 16, 0, 0); } while (0)
#define PG8_LDA(dst, b, h) do { _Pragma("unroll") for (int m = 0; m < 4; ++m) _Pragma("unroll") for (int k = 0; k < 2; ++k) dst[m][k] = *(const PG8_LAS bf16x8*)(lds + PG8_SA(b, h) + aoff + m * 2048 + k * 1024); } while (0)
#define PG8_LDB(dst, b, h) do { _Pragma("unroll") for (int n = 0; n < 2; ++n) _Pragma("unroll") for (int k = 0; k < 2; ++k) dst[n][k] = *(const PG8_LAS bf16x8*)(lds + PG8_SB(b, h) + boff + n * 2048 + k * 1024); } while (0)
#define PG8_MMA(ai, bj, At, Bt) do { __builtin_amdgcn_s_setprio(1); _Pragma("unroll") for (int m = 0; m < 4; ++m) _Pragma("unroll") for (int n = 0; n < 2; ++n) _Pragma("unroll") for (int k = 0; k < 2; ++k) \
        acc[ai][bj][m][n] = __builtin_amdgcn_mfma_f32_16x16x32_bf16(Bt[n][k], At[m][k], acc[ai][bj][m][n], 0, 0, 0); __builtin_amdgcn_s_setprio(0); } while (0)
#define PG8_WAIT_V(n) asm volatile("s_waitcnt vmcnt(" #n ")" ::: "memory")
#define PG8_WAIT_L(n) asm volatile("s_waitcnt lgkmcnt(" #n ")" ::: "memory")
#define PG8_BAR __builtin_amdgcn_s_barrier()
#define PG8_SCHED __builtin_amdgcn_sched_barrier(0)
    Unit cur, nxt; int ui = 0;
    if (!S.next(0, cur)) return;
    f32x4 acc[2][2][4][2];
#pragma unroll
    for (int a = 0; a < 2; ++a)
#pragma unroll
        for (int b = 0; b < 2; ++b)
#pragma unroll
            for (int m = 0; m < 4; ++m)
#pragma unroll
                for (int n = 0; n < 2; ++n) acc[a][b][m][n] = (f32x4){0.f, 0.f, 0.f, 0.f};
    bf16x8 At[4][2], B0[2][2], B1[2][2];
    const char* cA = (const char*)g.A + (size_t)cur.pm * tstep; const char* cB = (const char*)g.Bt + (size_t)cur.pn * tstep;
    S.a_ready(cur);
    if constexpr (SP2) {
        PG8_STAGE(PG8_SB(0, 0), cB, voffB); PG8_STAGE(PG8_SB(0, 1), cB + hstep, voffB); PG8_STAGE(PG8_SA(0, 0), cA, voffA); PG8_STAGE(PG8_SA(0, 1), cA + hstep, voffA);
        if (wr == 1) PG8_BAR;
        PG8_WAIT_V(2); PG8_BAR;
        PG8_STAGE(PG8_SB(1, 0), cB + kstep, voffB); PG8_STAGE(PG8_SA(1, 0), cA + kstep, voffA); PG8_STAGE(PG8_SB(1, 1), cB + hstep + kstep, voffB);
        PG8_WAIT_V(6); PG8_BAR;
    } else {
        PG8_STAGE(PG8_SB(0, 0), cB, voffB); PG8_STAGE(PG8_SA(0, 0), cA, voffA); PG8_STAGE(PG8_SB(0, 1), cB + hstep, voffB); PG8_STAGE(PG8_SA(0, 1), cA + hstep, voffA);
        if (wr == 1) PG8_BAR;
        PG8_WAIT_V(4); PG8_BAR;
        PG8_STAGE(PG8_SB(1, 0), cB + kstep, voffB); PG8_STAGE(PG8_SA(1, 0), cA + kstep, voffA); PG8_STAGE(PG8_SB(1, 1), cB + hstep + kstep, voffB);
        PG8_WAIT_V(6); PG8_BAR;
    }
    for (;;) {
        const bool has_next = S.next(ui + 1, nxt);
        const char* nA = has_next ? (const char*)g.A + (size_t)nxt.pm * tstep : cA; const char* nB = has_next ? (const char*)g.Bt + (size_t)nxt.pn * tstep : cB;
        for (int t = 0; t < nt; t += 2) {
            const bool last = (t == nt - 2);
            const char* a1 = cA + (size_t)(t + 1) * kstep;
            const char* a2 = last ? nA : cA + (size_t)(t + 2) * kstep; const char* b2 = last ? nB : cB + (size_t)(t + 2) * kstep;
            const char* a3 = a2 + kstep; const char* b3 = b2 + kstep;
            if (last && has_next) S.a_ready(nxt);
            if constexpr (SP2) {
            PG8_LDB(B0, 0, 0); PG8_LDB(B1, 0, 1); PG8_SCHED; PG8_LDA(At, 0, 0); PG8_STAGE(PG8_SA(1, 1), a1 + hstep, voffA);
            PG8_WAIT_V(8); PG8_WAIT_L(0); PG8_BAR; PG8_MMA(0, 0, At, B0); PG8_MMA(0, 1, At, B1); PG8_BAR; PG8_SCHED;
            PG8_LDA(At, 0, 1); PG8_STAGE(PG8_SB(0, 0), b2, voffB); PG8_STAGE(PG8_SB(0, 1), b2 + hstep, voffB); PG8_STAGE(PG8_SA(0, 0), a2, voffA);
            PG8_WAIT_V(8); PG8_WAIT_L(0); PG8_BAR; PG8_MMA(1, 0, At, B0); PG8_MMA(1, 1, At, B1); PG8_BAR; PG8_SCHED;
            PG8_LDB(B0, 1, 0); PG8_LDB(B1, 1, 1); PG8_SCHED; PG8_LDA(At, 1, 0); PG8_STAGE(PG8_SA(0, 1), a2 + hstep, voffA);
            PG8_WAIT_V(8); PG8_WAIT_L(0); PG8_BAR; PG8_MMA(0, 0, At, B0); PG8_MMA(0, 1, At, B1); PG8_BAR; PG8_SCHED;
            PG8_LDA(At, 1, 1); PG8_STAGE(PG8_SB(1, 0), b3, voffB); PG8_STAGE(PG8_SB(1, 1), b3 + hstep, voffB); PG8_STAGE(PG8_SA(1, 0), a3, voffA);
            PG8_WAIT_V(8); PG8_WAIT_L(0); PG8_BAR; PG8_MMA(1, 0, At, B0); PG8_MMA(1, 1, At, B1); PG8_BAR; PG8_SCHED;
            } else {
            PG8_LDB(B0, 0, 0); PG8_SCHED; PG8_LDA(At, 0, 0); PG8_STAGE(PG8_SA(1, 1), a1 + hstep, voffA);
            PG8_WAIT_L(8); PG8_BAR; PG8_WAIT_L(0); PG8_MMA(0, 0, At, B0); PG8_BAR; PG8_SCHED;
            PG8_LDB(B1, 0, 1); PG8_STAGE(PG8_SB(0, 0), b2, voffB);
            PG8_BAR; PG8_WAIT_L(0); PG8_MMA(0, 1, At, B1); PG8_BAR;
            PG8_LDA(At, 0, 1); PG8_STAGE(PG8_SA(0, 0), a2, voffA);
            PG8_BAR; PG8_WAIT_L(0); PG8_MMA(1, 0, At, B0); PG8_BAR; PG8_SCHED;
            PG8_STAGE(PG8_SB(0, 1), b2 + hstep, voffB);
            PG8_WAIT_V(6); PG8_BAR; PG8_MMA(1, 1, At, B1); PG8_BAR;
            PG8_LDB(B0, 1, 0); PG8_SCHED; PG8_LDA(At, 1, 0); PG8_STAGE(PG8_SA(0, 1), a2 + hstep, voffA);
            PG8_WAIT_L(8); PG8_BAR; PG8_WAIT_L(0); PG8_MMA(0, 0, At, B0); PG8_BAR; PG8_SCHED;
            PG8_LDB(B1, 1, 1); PG8_STAGE(PG8_SB(1, 0), b3, voffB);
            PG8_BAR; PG8_WAIT_L(0); PG8_MMA(0, 1, At, B1); PG8_BAR;
            PG8_LDA(At, 1, 1); PG8_STAGE(PG8_SA(1, 0), a3, voffA);
            PG8_BAR; PG8_WAIT_L(0); PG8_MMA(1, 0, At, B0); PG8_BAR; PG8_SCHED;
            PG8_STAGE(PG8_SB(1, 1), b3 + hstep, voffB);
            PG8_WAIT_V(6); PG8_BAR; PG8_MMA(1, 1, At, B1); PG8_BAR;
            }
        }
        if constexpr (ALIGN_EPI) { if (wr == 0) PG8_BAR; }
        if constexpr (!Epi::AFTER_DRAIN) { E(acc, cur, wr, wc, fr, fq); S.done(cur); }
        if (!has_next) break;
#pragma unroll
        for (int a = 0; a < 2; ++a)
#pragma unroll
            for (int b = 0; b < 2; ++b)
#pragma unroll
                for (int m = 0; m < 4; ++m)
#pragma unroll
                    for (int n = 0; n < 2; ++n) acc[a][b][m][n] = (f32x4){0.f, 0.f, 0.f, 0.f};
        cur = nxt; cA = nA; cB = nB; ++ui;
        if constexpr (ALIGN_EPI) { if (wr == 1) PG8_BAR; }
    }
    PG8_WAIT_V(0);
    if constexpr (!ALIGN_EPI) { if (wr == 0) PG8_BAR; }
    PG8_BAR;
    if constexpr (Epi::AFTER_DRAIN) { E.fused(acc, cur, wr, wc, fr, fq, lds, wid, lane); S.done(cur); }
#undef PG8_SA
#undef PG8_SB
#undef PG8_STAGE
#undef PG8_LDA
#undef PG8_LDB
#undef PG8_MMA
#undef PG8_WAIT_V
#undef PG8_WAIT_L
#undef PG8_BAR
#undef PG8_SCHED
}
}

constexpr int NWAVES = 8;
constexpr int DM = 4096, BATCH = 4, SEQ = 4096, DEPTH = 4, HD = 128;
constexpr int M = BATCH * SEQ;
constexpr int NPROJ = 4 * DM;
constexpr int N_RET = 12, N_SB = 10, N_DIFF = 10;
constexpr int RET_W = N_RET * HD, SB_W = N_SB * HD, DIFF_W = N_DIFF * HD;
constexpr int C_RQ = 0, C_RK = RET_W, C_RV = 2 * RET_W, C_RG = 3 * RET_W;
constexpr int C_SQ = 4 * RET_W, C_SK = C_SQ + SB_W, C_SV = C_SQ + 2 * SB_W, C_SG = C_SQ + 3 * SB_W;
constexpr int C_DQ = 4 * RET_W + 4 * SB_W, C_DK = C_DQ + DIFF_W, C_DV = C_DQ + 2 * DIFF_W, C_DG = C_DQ + 3 * DIFF_W;
constexpr int MX_RET = 0, MX_SB = RET_W, MX_DIFF = RET_W + SB_W;
static_assert(C_DG + DIFF_W == NPROJ && MX_DIFF + DIFF_W == DM, "column map");
constexpr float LN_EPS = 1e-5f;
constexpr float LOG2E = 1.4426950408889634f, LN2 = 0.6931471805599453f;
constexpr float DEEPNORM_ALPHA = 1.681792830507429f;
__device__ const float RET_LOG_GAMMA[12] = {-3.174869716e-02f, -1.574835740e-02f, -7.843177766e-03f, -3.913899418e-03f, -1.955034910e-03f, -9.770396864e-04f, -4.884005175e-04f, -2.441704273e-04f, -1.220777631e-04f, -6.103701890e-05f, -3.051804379e-05f, -1.525890548e-05f};
__device__ const float ALIBI_SLOPE[10] = {5.000000000e-01f, 2.500000000e-01f, 1.250000000e-01f, 6.250000000e-02f, 3.125000000e-02f, 1.562500000e-02f, 7.812500000e-03f, 3.906250000e-03f, 7.071067691e-01f, 3.535533845e-01f};
__device__ const float LAMBDA_INIT[4] = {0.20000000000000007f, 0.35550906759096934f, 0.4707130183435842f, 0.5560582041556406f};

constexpr size_t MiB = 1u << 20;
constexpr size_t WS_CTL = 0, CTL_ZERO_BYTES = 4 * MiB;
constexpr size_t WS_WIN = 16 * MiB;
constexpr size_t WS_WOUT = WS_WIN + (size_t)DEPTH * NPROJ * DM * 2;
constexpr size_t WS_XB = WS_WOUT + (size_t)DEPTH * DM * DM * 2;
constexpr size_t WS_XH = WS_XB + (size_t)M * DM * 2;
constexpr size_t WS_PROJ = WS_XH + (size_t)M * DM * 4;
constexpr size_t WS_MIX = WS_PROJ + (size_t)M * NPROJ * 2;
constexpr size_t WS_H = WS_MIX + (size_t)M * DM * 2;
constexpr size_t WS_SLOTS = 2 * MiB;
constexpr size_t WS_END = WS_H + (size_t)M * DM * 4;
static_assert(WS_SLOTS + (size_t)M * 16 * 8 <= CTL_ZERO_BYTES && CTL_ZERO_BYTES <= WS_WIN, "slots inside the memset");
constexpr int CW_BAR = 4096;
constexpr int CW_Q = 16384;
constexpr int CW_PRE = 49152;
constexpr int CW_LNC = 131072;
constexpr int CW_TMO = 8;
constexpr int CW_TMAX = 65536, TMAX_LAYER = BATCH * N_DIFF * 2 * 64;
constexpr int RS = 272;
constexpr int IMG64 = 64 * RS, IMG128 = 128 * RS;
constexpr int SCR_BYTES = 159744;
constexpr int MISC_OFF = SCR_BYTES;
constexpr int LDS_BYTES = SCR_BYTES + 1024;
static_assert(pg8::STAGE_BYTES + 12288 <= SCR_BYTES && LDS_BYTES <= 163840, "LDS map");

#define GAS __attribute__((address_space(1)))
#define LAS __attribute__((address_space(3)))
typedef unsigned short bf16;
typedef unsigned u32x4 __attribute__((ext_vector_type(4)));
typedef unsigned u32x2 __attribute__((ext_vector_type(2)));
typedef float f32x4 __attribute__((ext_vector_type(4)));
typedef short bf16x8 __attribute__((ext_vector_type(8)));
typedef short s16x4 __attribute__((ext_vector_type(4)));
typedef GAS unsigned gu32;
#define RLX_AGENT __ATOMIC_RELAXED, __HIP_MEMORY_SCOPE_AGENT
#define LDS_WAIT() asm volatile("s_waitcnt lgkmcnt(0)" ::: "memory")
#define VM_WAIT() asm volatile("s_waitcnt vmcnt(0)" ::: "memory")
__device__ __forceinline__ unsigned f2bf(float f) { unsigned u = __builtin_bit_cast(unsigned, f); return (u + 0x7fffu + ((u >> 16) & 1u)) >> 16; }
__device__ __forceinline__ unsigned pk2(float lo, float hi) { return f2bf(lo) | (f2bf(hi) << 16); }
__device__ __forceinline__ unsigned pkbf(float lo, float hi) { unsigned r; asm volatile("v_cvt_pk_bf16_f32 %0, %1, %2" : "=v"(r) : "v"(lo), "v"(hi)); return r; }
__device__ __forceinline__ float bf_lo(unsigned w) { return __uint_as_float(w << 16); }
__device__ __forceinline__ float bf_hi(unsigned w) { return __uint_as_float(w & 0xffff0000u); }
#define XB_TMO      128
#define XB_XCNT(j)  (256  + 64 * (j))
#define XB_XSUB(j)  (1280 + 64 * (j))
#define XB_XGEN(j)  (2304 + 64 * (j))
#define XB_TOP      3328
#define XB_TOPGEN   3392
#define XCD_BAR_WORDS 3456
#define XB_SPIN_CAP (1u << 18)

__device__ __forceinline__ unsigned xb_ld(unsigned* p)              { return __hip_atomic_load(p, __ATOMIC_RELAXED, __HIP_MEMORY_SCOPE_AGENT); }
__device__ __forceinline__ unsigned xb_add(unsigned* p, unsigned v) { return __hip_atomic_fetch_add(p, v, __ATOMIC_RELAXED, __HIP_MEMORY_SCOPE_AGENT); }
__device__ __forceinline__ unsigned xb_xcc_id() { return (unsigned)__builtin_amdgcn_s_getreg((3 << 11) | 20) & 0xFu; }
#define XB_SPIN(cond, bar) do { unsigned _sp = 0; while (cond) { __builtin_amdgcn_s_sleep(1); \
    if ((++_sp & 255u) == 0u) { if (xb_ld(&(bar)[XB_TMO])) break; if (_sp > XB_SPIN_CAP) { atomicAdd(&(bar)[XB_TMO], 1u); break; } } } } while (0)

struct XcdBarrier {
    unsigned wv;
    unsigned* bar; unsigned x;
    volatile LAS unsigned* st;
};

__device__ __forceinline__ bool xb_lane0() { int t; asm volatile("v_mbcnt_lo_u32_b32 %0, -1, 0\n\tv_mbcnt_hi_u32_b32 %0, -1, %0" : "=v"(t)); return t == 0; }
__device__ __forceinline__ XcdBarrier xcd_barrier_post(unsigned* bar, volatile LAS unsigned* st, unsigned wv) {
    XcdBarrier b; b.wv = wv; b.bar = bar; b.x = xb_xcc_id(); b.st = st;
    if (wv == 0u && xb_lane0()) (void)xb_add(&bar[XB_XCNT(b.x)], 1u);
    return b;
}
__device__ __forceinline__ void xcd_barrier_complete(unsigned* bar, unsigned x, unsigned& nloc, unsigned& nx) {
    const unsigned G = gridDim.x * gridDim.y * gridDim.z;
    unsigned sum, cnt, mine, sp = 0u;
    for (;;) {
        sum = 0u; cnt = 0u; mine = 0u;
#pragma unroll
        for (unsigned j = 0; j < 16; ++j) { const unsigned c = xb_ld(&bar[XB_XCNT(j)]); sum += c; cnt += (c > 0u) ? 1u : 0u; mine = (j == x) ? c : mine; }
        if (sum == G) break;
        __builtin_amdgcn_s_sleep(1);
        if ((++sp & 255u) == 0u) { if (xb_ld(&bar[XB_TMO])) break; if (sp > XB_SPIN_CAP) { atomicAdd(&bar[XB_TMO], 1u); break; } }
    }
    nloc = mine > 0u ? mine : 1u; nx = cnt > 0u ? cnt : 1u;
}

__device__ __forceinline__ void xcd_barrier(const XcdBarrier& b) {
    asm volatile("s_waitcnt vmcnt(0)" ::: "memory");
    __syncthreads();
    if (b.wv == 0u && xb_lane0()) {
        unsigned* bar = b.bar;
        __builtin_amdgcn_s_waitcnt(0);
        unsigned nloc = b.st[0], nx = b.st[1];
        if (nloc == 0u) { xcd_barrier_complete(bar, b.x, nloc, nx); b.st[0] = nloc; b.st[1] = nx; }
        const unsigned old = xb_add(&bar[XB_XSUB(b.x)], 1u);
        const unsigned gen = old / nloc;
        if (old + 1u == (gen + 1u) * nloc) {
            __builtin_amdgcn_fence(__ATOMIC_RELEASE, "agent");
            asm volatile("s_waitcnt vmcnt(0)" ::: "memory");
            const unsigned og = xb_add(&bar[XB_TOP], 1u);
            const unsigned tg = og / nx;
            if (og + 1u == (tg + 1u) * nx) xb_add(&bar[XB_TOPGEN], 1u);
            else XB_SPIN(xb_ld(&bar[XB_TOPGEN]) == tg, bar);
            __builtin_amdgcn_fence(__ATOMIC_ACQUIRE, "agent");
            xb_add(&bar[XB_XGEN(b.x)], 1u);
            asm volatile("s_waitcnt vmcnt(0)" ::: "memory");
        } else {
            XB_SPIN(xb_ld(&bar[XB_XGEN(b.x)]) == gen, bar);
            __builtin_amdgcn_fence(__ATOMIC_ACQUIRE, "agent");
            asm volatile("s_waitcnt vmcnt(0)" ::: "memory");
        }
    }
    __syncthreads();
}

struct Args { const float* in[11]; float* out; unsigned char* ws; };
typedef const __attribute__((address_space(4))) Args CArgs;
__device__ __forceinline__ CArgs* kargs() { CArgs* p = (CArgs*)__builtin_amdgcn_kernarg_segment_ptr(); asm volatile("" : "+s"(p)); return p; }
#define args (*kargs())
struct Frame {
    LAS unsigned char* lds;
    volatile LAS unsigned* MISC;
    int wave;
};
__device__ __forceinline__ int opaque_lane() { int t; asm volatile("v_mbcnt_lo_u32_b32 %0, -1, 0\n\tv_mbcnt_hi_u32_b32 %0, -1, %0" : "=v"(t)); return t; }
#define opaque_tid() (F.wave * 64 + opaque_lane())
#define A_X       (args.in[0])
#define A_WIN     (args.in[1])
#define A_WOUT    (args.in[2])
#define A_LNG     (args.in[3])
#define A_LNB     (args.in[4])
#define A_RETG    (args.in[5])
#define A_DIFFG   (args.in[6])
#define A_LQ1     (args.in[7])
#define A_LK1     (args.in[8])
#define A_LQ2     (args.in[9])
#define A_LK2     (args.in[10])
#define W_CTL     ((gu32*)(args.ws + WS_CTL))
#define W_WINT    ((bf16*)(args.ws + WS_WIN))
#define W_WOUTT   ((bf16*)(args.ws + WS_WOUT))
#define W_XB      ((bf16*)(args.ws + WS_XB))
#define W_XH      ((float*)(args.ws + WS_XH))
#define W_PROJ    ((bf16*)(args.ws + WS_PROJ))
#define W_MIX     ((bf16*)(args.ws + WS_MIX))
#define W_H       ((float*)(args.ws + WS_H))
template <int CTRL> __device__ __forceinline__ float dpp_mov(float x) { return __builtin_bit_cast(float, __builtin_amdgcn_mov_dpp(__builtin_bit_cast(int, x), CTRL, 0xf, 0xf, true)); }
__device__ __forceinline__ float xrow16_max(float x) {
    auto s = __builtin_amdgcn_permlane16_swap(__float_as_uint(x), __float_as_uint(x), false, false);
    x = fmaxf(__uint_as_float(s[0]), __uint_as_float(s[1]));
    auto t = __builtin_amdgcn_permlane32_swap(__float_as_uint(x), __float_as_uint(x), false, false);
    return fmaxf(__uint_as_float(t[0]), __uint_as_float(t[1]));
}
__device__ __forceinline__ float xrow16_sum(float x) {
    auto s = __builtin_amdgcn_permlane16_swap(__float_as_uint(x), __float_as_uint(x), false, false);
    x = __uint_as_float(s[0]) + __uint_as_float(s[1]);
    auto t = __builtin_amdgcn_permlane32_swap(__float_as_uint(x), __float_as_uint(x), false, false);
    return __uint_as_float(t[0]) + __uint_as_float(t[1]);
}
__device__ __forceinline__ float wave_sum(float v) {
    v += dpp_mov<0xB1>(v); v += dpp_mov<0x4E>(v); v += dpp_mov<0x141>(v); v += dpp_mov<0x140>(v);
    return xrow16_sum(v);
}
__device__ __forceinline__ f32x4 mfma16(bf16x8 a, bf16x8 b, f32x4 c) { return __builtin_amdgcn_mfma_f32_16x16x32_bf16(a, b, c, 0, 0, 0); }
__device__ __forceinline__ s16x4 tr_read(const LAS unsigned char* p) { return __builtin_amdgcn_ds_read_tr16_b64_v4i16((LAS s16x4*)p); }
__device__ __forceinline__ bf16x8 cat8(s16x4 lo, s16x4 hi) { return (bf16x8){lo[0], lo[1], lo[2], lo[3], hi[0], hi[1], hi[2], hi[3]}; }
__device__ __forceinline__ float silu_f(float x) { return x * __builtin_amdgcn_rcpf(1.0f + __builtin_amdgcn_exp2f(-x * LOG2E)); }

__device__ __forceinline__ void p0_transpose_item(const float* W, int K, int N, bf16* WT, LAS float* scr, int item, int lane) {
    const int nblk = N / 32, kb = item / nblk, nb = item % nblk, k0 = 64 * kb, n0 = 32 * nb;
#pragma unroll
    for (int i = 0; i < 32; ++i) { const int kk = 2 * i + (lane >> 5); scr[kk * 33 + (lane & 31)] = __builtin_nontemporal_load(W + (size_t)(k0 + kk) * N + n0 + (lane & 31)); }
    LDS_WAIT(); asm volatile("" ::: "memory");
    const int c = lane & 7;
#pragma unroll
    for (int j = 0; j < 4; ++j) { const int n = (lane >> 3) + 8 * j; const LAS float* s = scr + (8 * c) * 33 + n;
        u32x4 o; o.x = pk2(s[0 * 33], s[1 * 33]); o.y = pk2(s[2 * 33], s[3 * 33]); o.z = pk2(s[4 * 33], s[5 * 33]); o.w = pk2(s[6 * 33], s[7 * 33]);
        __builtin_nontemporal_store(o, (GAS u32x4*)(WT + (size_t)(n0 + n) * K + k0 + 8 * c)); }
    LDS_WAIT(); asm volatile("" ::: "memory");
}
constexpr int CV_I_IN = (DM / 64) * (NPROJ / 32), CV_I_OUT = (DM / 64) * (DM / 32), CV_ITEMS = CV_I_IN + CV_I_OUT;
__device__ __forceinline__ void convert_item(int layer, int it, LAS float* scr, int lane) {
    if (it < CV_I_IN) p0_transpose_item(A_WIN + (size_t)layer * DM * NPROJ, DM, NPROJ, W_WINT + (size_t)layer * NPROJ * DM, scr, it, lane);
    else p0_transpose_item(A_WOUT + (size_t)layer * DM * DM, DM, DM, W_WOUTT + (size_t)layer * DM * DM, scr, it - CV_I_IN, lane);
}
__device__ __forceinline__ void p0_prologue(Frame& F0) {
    struct { LAS unsigned char* lds; int tid, lane, wave; } F; F.lds = F0.lds; F.wave = F0.wave; F.lane = opaque_lane(); F.tid = F.wave * 64 + F.lane;
    LAS float* scr = (LAS float*)(F.lds + F.wave * 16384);
    const int gw = blockIdx.x * NWAVES + F.wave, NGW = gridDim.x * NWAVES;
    for (int it = gw; it < DEPTH * CV_ITEMS; it += NGW) convert_item(it / CV_ITEMS, it % CV_ITEMS, scr, F.lane);
    const size_t nthr = (size_t)gridDim.x * NWAVES * 64, t0 = (size_t)blockIdx.x * NWAVES * 64 + F.tid;
    for (size_t i = t0; i < (size_t)M * DM / 8; i += nthr) {
        const f32x4 a = *(const GAS f32x4*)(A_X + i * 8), b = *(const GAS f32x4*)(A_X + i * 8 + 4);
        u32x4 o; o.x = pk2(a.x, a.y); o.y = pk2(a.z, a.w); o.z = pk2(b.x, b.y); o.w = pk2(b.z, b.w);
        *(GAS u32x4*)(W_XB + i * 8) = o; }
}
constexpr int CV_UNIT = 32, CV_UNITS = CV_ITEMS / CV_UNIT;
static_assert(CV_ITEMS % CV_UNIT == 0, "conversion units");
__device__ __forceinline__ void convert_unit(Frame& F, int layer, int u) {
    const int lane = opaque_lane(); LAS float* scr = (LAS float*)(F.lds + F.wave * 16384);
    for (int j = 0; j < CV_UNIT / NWAVES; ++j) convert_item(layer, u * CV_UNIT + F.wave * (CV_UNIT / NWAVES) + j, scr, lane);
}

__device__ __forceinline__ int next_unit(Frame& F, gu32* head) {
    __syncthreads();
    if (F.wave == 0 && opaque_lane() == 0) F.MISC[4] = __hip_atomic_fetch_add(head, 1u, RLX_AGENT);
    __syncthreads();
    return __builtin_amdgcn_readfirstlane((int)F.MISC[4]);
}
__device__ const unsigned char DIFF_ORDER[160] = {244, 245, 246, 247, 228, 229, 230, 231, 212, 213, 214, 215, 196, 197, 198, 199, 180, 181, 182, 183, 164, 165, 166, 167, 148, 149, 150, 151, 132, 133, 134, 135, 116, 117, 118, 119, 100, 101, 102, 103, 84, 85, 86, 87, 68, 69, 70, 71, 52, 53, 54, 55, 36, 37, 38, 39, 20, 21, 22, 23, 4, 5, 6, 7, 243, 227, 211, 195, 179, 163, 147, 131, 115, 99, 83, 242, 226, 210, 194, 178, 162, 146, 130, 114, 98, 82, 66, 67, 50, 51, 241, 225, 209, 193, 177, 161, 145, 129, 113, 97, 81, 65, 49, 33, 34, 35, 249, 233, 217, 201, 185, 169, 153, 137, 121, 105, 89, 73, 57, 41, 240, 224, 208, 192, 176, 160, 144, 128, 112, 96, 80, 64, 48, 32, 16, 17, 18, 19, 25, 248, 232, 216, 200, 184, 168, 152, 136, 120, 104, 88, 72, 56, 40, 24, 0, 1, 2, 3, 8, 9};
__device__ __forceinline__ void knorm_prepass(Frame& F, int layer, int wave) {
    const int lane = opaque_lane(), gw = blockIdx.x * NWAVES + wave, NGW = BATCH * N_RET * NWAVES;
    gu32* tm = W_CTL + CW_TMAX + layer * TMAX_LAYER; gu32* cnt = W_CTL + CW_PRE + layer * 64;
    unsigned ndone = 0;
    for (int it = gw; it < BATCH * N_DIFF * 128; it += NGW) {
        const int t32 = it & 127, bh = it >> 7, b = bh / N_DIFF, h = bh % N_DIFF;
        const bf16* kp = W_PROJ + (size_t)(b * SEQ + 32 * t32) * NPROJ + C_DK + h * HD + 8 * (lane & 15);
        u32x4 w[8];
#pragma unroll
        for (int i = 0; i < 8; ++i) w[i] = *(const GAS u32x4*)(kp + (size_t)(4 * i + (lane >> 4)) * NPROJ);
        float mx = 0.f;
#pragma unroll
        for (int i = 0; i < 8; ++i) { float s = 0.f;
#pragma unroll
            for (int j = 0; j < 4; ++j) { const float lo = bf_lo(w[i][j]), hi = bf_hi(w[i][j]); s = fmaf(lo, lo, s); s = fmaf(hi, hi, s); }
            s += dpp_mov<0xB1>(s); s += dpp_mov<0x4E>(s); s += dpp_mov<0x141>(s);
            mx = fmaxf(mx, s); }
        mx = xrow16_max(mx);
        if ((lane & 55) == 0) __hip_atomic_fetch_max(tm + ((bh * 2 + (lane >> 3)) * 64 + (t32 >> 1)), __float_as_uint(mx), RLX_AGENT);
        ++ndone;
    }
    asm volatile("s_waitcnt vmcnt(0)" ::: "memory");
    if (lane == 0) __hip_atomic_fetch_add((LAS unsigned*)&F.MISC[6], ndone, __ATOMIC_RELAXED, __HIP_MEMORY_SCOPE_WORKGROUP);
    __syncthreads();
    if (wave == 0 && lane == 0) { __hip_atomic_fetch_add(cnt, F.MISC[6], RLX_AGENT); F.MISC[6] = 0u; }
}
template <int CTRL, int ROWMASK> __device__ __forceinline__ float dpp_upd0(float x) { return __builtin_bit_cast(float, __builtin_amdgcn_update_dpp(0, __builtin_bit_cast(int, x), CTRL, ROWMASK, 0xf, true)); }
__device__ __forceinline__ float wave_prefix_max(float v) {
    v = fmaxf(v, dpp_upd0<0x111, 0xf>(v)); v = fmaxf(v, dpp_upd0<0x112, 0xf>(v)); v = fmaxf(v, dpp_upd0<0x114, 0xf>(v)); v = fmaxf(v, dpp_upd0<0x118, 0xf>(v));
    v = fmaxf(v, dpp_upd0<0x142, 0xa>(v)); v = fmaxf(v, dpp_upd0<0x143, 0xc>(v));
    return v;
}

constexpr int KV_TILE_BYTES = 64 * 256;
__device__ __forceinline__ int swz_k(int row) { return row & 15; }
__device__ __forceinline__ int swz_v(int row) { return (row & 15) ^ ((row & 1) << 3); }
__device__ __forceinline__ void glds16(const void* gsrc, unsigned lds_dst) { unsigned keep;
    asm volatile("s_mov_b32 %0, m0\n\ts_mov_b32 m0, %2\n\ts_nop 0\n\tglobal_load_lds_dwordx4 %1, off\n\ts_mov_b32 m0, %0" : "=&s"(keep) : "v"(gsrc), "s"(lds_dst) : "memory"); }
__device__ __forceinline__ void glds16_so(const void* gbase, unsigned voff, unsigned lds_dst) { unsigned keep;
    asm volatile("s_mov_b32 %0, m0\n\ts_mov_b32 m0, %2\n\ts_nop 0\n\tglobal_load_lds_dwordx4 %1, %3\n\ts_mov_b32 m0, %0" : "=&s"(keep) : "v"(voff), "s"(lds_dst), "s"(gbase) : "memory"); }
__device__ __forceinline__ void kv_dma_offsets(unsigned (&dmo)[4], int wave, int lane) {
#pragma unroll
    for (int i = 0; i < 2; ++i) { const int row = 4 * (2 * wave + i) + (lane >> 4), slot = lane & 15;
        dmo[2 * i] = (unsigned)row * (NPROJ * 2) + 16 * (slot ^ swz_k(row)); dmo[2 * i + 1] = (unsigned)row * (NPROJ * 2) + 16 * (slot ^ swz_v(row)); }
}
__device__ __forceinline__ void kv_dma(LAS unsigned char* kbuf, LAS unsigned char* vbuf, const bf16* kp, const bf16* vp, int k0, int wave, const unsigned (&dmo)[4]) {
    const char* kb = (const char*)(kp + (size_t)k0 * NPROJ); const char* vb = (const char*)(vp + (size_t)k0 * NPROJ);
#pragma unroll
    for (int i = 0; i < 2; ++i) { const int pc = 2 * wave + i;
        glds16_so(kb, dmo[2 * i], (unsigned)(size_t)(kbuf + 1024 * pc));
        glds16_so(vb, dmo[2 * i + 1], (unsigned)(size_t)(vbuf + 1024 * pc)); }
}
__device__ __forceinline__ void k_dma(LAS unsigned char* kbuf, const bf16* kp, int k0, int wave, const unsigned (&dmo)[4]) {
    const char* kb = (const char*)(kp + (size_t)k0 * NPROJ);
    glds16_so(kb, dmo[0], (unsigned)(size_t)(kbuf + 1024 * (2 * wave))); glds16_so(kb, dmo[2], (unsigned)(size_t)(kbuf + 1024 * (2 * wave + 1))); }
__device__ __forceinline__ void v_dma(LAS unsigned char* vbuf, const bf16* vp, int k0, int wave, const unsigned (&dmo)[4]) {
    const char* vb = (const char*)(vp + (size_t)k0 * NPROJ);
    glds16_so(vb, dmo[1], (unsigned)(size_t)(vbuf + 1024 * (2 * wave))); glds16_so(vb, dmo[3], (unsigned)(size_t)(vbuf + 1024 * (2 * wave + 1))); }
constexpr float NEG_MASK = -1e30f;
constexpr float DIFF_THR = 6.0f;
#ifndef SCHED_FENCE
#define SCHED_FENCE() __builtin_amdgcn_sched_barrier(0)
#endif
__device__ __forceinline__ float max3_raw(float a, float b, float c) { float r; asm("v_max3_f32 %0, %1, %2, %3" : "=v"(r) : "v"(a), "v"(b), "v"(c)); return r; }
__device__ __forceinline__ float max2_raw(float a, float b) { float r; asm("v_max_f32_e32 %0, %1, %2" : "=v"(r) : "v"(a), "v"(b)); return r; }
__device__ __forceinline__ void diff_sm32(bool force, bool diag, f32x4 (&S)[2], f32x4 (&O)[8], float& m, float& l, bf16x8& pb, int kq  ) {
    if (diag) {
        int kql = kq; asm volatile("" : "+v"(kql));
#pragma unroll
        for (int a = 0; a < 2; ++a)
#pragma unroll
            for (int r = 0; r < 4; ++r) if (kql + 16 * a + r > 0) S[a][r] = NEG_MASK;
    }
    const float pl = max3_raw(max3_raw(max3_raw(S[0][0], S[0][1], S[0][2]), S[0][3], S[1][0]), max2_raw(S[1][1], S[1][2]), S[1][3]);
    if (force || !__all(pl <= DIFF_THR)) {
        const float pmax = xrow16_max(pl);
        float mn = fmaxf(pmax, 0.f);
        if (force) { const float lt = xrow16_sum(l); if (lt == 0.f) mn = pmax; }
        if (pmax < -1e29f) mn = 0.f;
        const float alpha = __builtin_amdgcn_exp2f(-mn);
#pragma unroll
        for (int c = 0; c < 8; ++c) O[c] = O[c] * alpha;
        l *= alpha; m += mn;
#pragma unroll
        for (int a = 0; a < 2; ++a) S[a] = S[a] - mn;
    }
    float ps = 0.f;
#pragma unroll
    for (int a = 0; a < 2; ++a)
#pragma unroll
        for (int r = 0; r < 4; ++r) { const float pv = __builtin_amdgcn_exp2f(S[a][r]); S[a][r] = pv; ps += pv; }
    l += ps;
    u32x4 w; w.x = pkbf(S[0][0], S[0][1]); w.y = pkbf(S[0][2], S[0][3]); w.z = pkbf(S[1][0], S[1][1]); w.w = pkbf(S[1][2], S[1][3]);
    pb = __builtin_bit_cast(bf16x8, w);
}
#ifndef DT2_KQ_EARLY
#define DT2_KQ_EARLY 0
#endif
#define DT2_LOADKQ(HH, X) do { _Pragma("unroll") for (int a = 0; a < 2; ++a) _Pragma("unroll") for (int s = 0; s < 2; ++s) { \
        kf[a][s] = *(const LAS bf16x8*)(kb + kr[X][s] + 256 * (32 * (HH) + 16 * a)); qf[a][s] = *(const LAS bf16x8*)(qb + kr[X][s] + 256 * (16 * a)); } } while (0)
#define DT2_LOADV(DST, HH, C0) do { _Pragma("unroll") for (int c = 0; c < 4; ++c) \
        DST[c] = cat8(tr_read((const LAS unsigned char*)(va[(C0) + c] + 256 * (32 * (HH)))), tr_read((const LAS unsigned char*)(va[(C0) + c] + 256 * (32 * (HH) + 16)))); } while (0)
__device__ __forceinline__ void diff_tile2(bool force, bool diag, f32x4 (&O)[2][2][8], float (&m)[2][2], float (&l)[2][2], const unsigned (&kr)[2][2], unsigned kb, unsigned qb, const unsigned (&va)[8], float slope2, int kq0  ) {
    bf16x8 kf[2][2], qf[2][2];
    DT2_LOADKQ(1, 0);
#pragma unroll
    for (int blk = 0; blk < 4; ++blk) {
        const int hh = 1 - (blk >> 1), x = blk & 1;
        bf16x8 vv[4];
        f32x4 S0[2], S1[2];
        const float b0 = slope2 * (float)(kq0 + 32 * hh) - m[x][0], b1 = slope2 * (float)(kq0 + 32 * hh - 16) - m[x][1];
#pragma unroll
        for (int a = 0; a < 2; ++a)
#pragma unroll
            for (int r = 0; r < 4; ++r) { S0[a][r] = fmaf(slope2, (float)(16 * a + r), b0); S1[a][r] = fmaf(slope2, (float)(16 * a + r), b1); }
        SCHED_FENCE();
#pragma unroll
        for (int a = 0; a < 2; ++a)
#pragma unroll
            for (int s = 0; s < 2; ++s) { S0[a] = mfma16(kf[a][s], qf[0][s], S0[a]); S1[a] = mfma16(kf[a][s], qf[1][s], S1[a]); }
        bf16x8 pb0, pb1;
        SCHED_FENCE();
        DT2_LOADV(vv, hh, 0);
        SCHED_FENCE();
        diff_sm32(force, diag, S0, O[x][0], m[x][0], l[x][0], pb0, kq0 + 32 * hh);
        diff_sm32(force, diag, S1, O[x][1], m[x][1], l[x][1], pb1, kq0 + 32 * hh - 16);
        SCHED_FENCE();
#pragma unroll
        for (int c = 0; c < 4; ++c) { O[x][0][c] = mfma16(vv[c], pb0, O[x][0][c]); O[x][1][c] = mfma16(vv[c], pb1, O[x][1][c]); }
        SCHED_FENCE();
        DT2_LOADV(vv, hh, 4);
        SCHED_FENCE();
#pragma unroll
        for (int c = 0; c < 4; ++c) { O[x][0][4 + c] = mfma16(vv[c], pb0, O[x][0][4 + c]); O[x][1][4 + c] = mfma16(vv[c], pb1, O[x][1][4 + c]); }
        SCHED_FENCE();
        if (blk == 0) DT2_LOADKQ(1, 1); else if (blk == 1) DT2_LOADKQ(0, 0); else if (blk == 2) DT2_LOADKQ(0, 1);
        SCHED_FENCE();
    }
}
#undef DT2_LOADKQ
#undef DT2_LOADV
constexpr int DQ_IMG = 0, DK_RING = 65536, DV_RING = DK_RING + 2 * KV_TILE_BYTES;
__device__ __forceinline__ void diff_unit2(Frame& F, int b, int h, int qb, int layer) {
    const int tid_ = opaque_tid(), lane = tid_ & 63;
    const int wave = F.wave, li = lane & 15, g = lane >> 4;
    const int q0 = 256 * qb, tq0 = q0 + 32 * wave + li;
    const bf16* base = W_PROJ + (size_t)(b * SEQ) * NPROJ;
    const bf16* qp = base + C_DQ + h * HD; const bf16* kp = base + C_DK + h * HD; const bf16* vp = base + C_DV + h * HD; const bf16* gp = base + C_DG + h * HD;
    const float slope2 = ALIBI_SLOPE[h] * LOG2E;
    LAS unsigned char* kring = F.lds + 65536; LAS unsigned char* vring = F.lds + 65536 + 3 * KV_TILE_BYTES; constexpr int DTAB = 65536 + 5 * KV_TILE_BYTES;
    const int jt0 = 4 * qb + 3;
#pragma unroll
    for (int i = 0; i < 8; ++i) { const int row = 32 * wave + 4 * i + (lane >> 4), slot = lane & 15;
        glds16(qp + (size_t)(q0 + row) * NPROJ + 8 * (slot ^ swz_k(row)), (unsigned)(size_t)(F.lds + DQ_IMG + 1024 * (8 * wave + i))); }
    unsigned dmo[4]; kv_dma_offsets(dmo, wave, lane);
    k_dma(kring, kp, 64 * jt0, wave, dmo); v_dma(vring, vp, 64 * jt0, wave, dmo); k_dma(kring + KV_TILE_BYTES, kp, 64 * (jt0 - 1), wave, dmo);
    f32x4 O[2][2][8]; float m[2][2], l[2][2];
#pragma unroll
    for (int x = 0; x < 2; ++x)
#pragma unroll
        for (int u = 0; u < 2; ++u) { m[x][u] = 0.f; l[x][u] = 0.f;
#pragma unroll
            for (int c = 0; c < 8; ++c) O[x][u][c] = (f32x4){0.f, 0.f, 0.f, 0.f}; }
    unsigned kr[2][2], va[8];
    {   const int q = li >> 2, p = lane & 3; const unsigned vb = (unsigned)(size_t)vring;
#pragma unroll
        for (int x = 0; x < 2; ++x)
#pragma unroll
            for (int s = 0; s < 2; ++s) kr[x][s] = 256 * li + 16 * ((8 * x + 4 * s + g) ^ swz_k(li));
#pragma unroll
        for (int c = 0; c < 8; ++c) va[c] = vb + 256 * (4 * g + q) + 16 * ((2 * c + (p >> 1)) ^ swz_v(4 * g + q)) + 8 * (p & 1); }
    const unsigned qbase = (unsigned)(size_t)(F.lds + DQ_IMG) + 256 * 32 * wave;
    LAS f32x4* qnp = (LAS f32x4*)(F.lds + DTAB) + tid_; LAS float* kprep = (LAS float*)(F.lds + DTAB + 8192 + 512 * wave);
    const bool canskip = ALIBI_SLOPE[h] * LOG2E * (float)SEQ > 200.0f;
    {   if (canskip) {
            gu32* cnt = W_CTL + CW_PRE + layer * 64; unsigned spins = 0;
            while (__builtin_amdgcn_readfirstlane(__hip_atomic_load(cnt, RLX_AGENT)) < (unsigned)(BATCH * N_DIFF * 128) && ++spins < (1u << 22)) __builtin_amdgcn_s_sleep(2);
            gu32* tm = W_CTL + CW_TMAX + layer * TMAX_LAYER + ((b * N_DIFF + h) * 2) * 64;
#pragma unroll
            for (int x = 0; x < 2; ++x) kprep[x * 64 + lane] = wave_prefix_max(sqrtf(__uint_as_float(__hip_atomic_load(tm + x * 64 + lane, RLX_AGENT))));
        }
        asm volatile("s_waitcnt vmcnt(0)" ::: "memory");
        f32x4 qv;
#pragma unroll
        for (int x = 0; x < 2; ++x)
#pragma unroll
            for (int u = 0; u < 2; ++u) { float s2 = 0.f;
#pragma unroll
                for (int s = 0; s < 2; ++s) { const u32x4 w = *(const LAS u32x4*)(qbase + kr[x][s] + 256 * (16 * u));
#pragma unroll
                    for (int j = 0; j < 4; ++j) { const float lo = bf_lo(w[j]), hi = bf_hi(w[j]); s2 = fmaf(lo, lo, s2); s2 = fmaf(hi, hi, s2); } }
                qv[2 * x + u] = sqrtf(xrow16_sum(s2)); }
        *qnp = qv;
    }
    int slot = 0, kslot = 0;
    bool first = true;
    for (int jt = jt0; jt >= 0; --jt) {
        if (jt >= 1) asm volatile("s_waitcnt vmcnt(2)\n\ts_barrier" ::: "memory"); else asm volatile("s_waitcnt vmcnt(0)\n\ts_barrier" ::: "memory");
        if (jt != jt0) {
            unsigned alld = 1u;
#pragma unroll
            for (int w = 0; w < 8; ++w) alld &= F.MISC[8 + 8 * (slot ^ 1) + w];
            if (__builtin_amdgcn_readfirstlane((int)alld)) break;
        }
        if (jt >= 1) v_dma(vring + (slot ^ 1) * KV_TILE_BYTES, vp, 64 * (jt - 1), wave, dmo);
        if (jt >= 2) k_dma(kring + (kslot == 0 ? 2 : kslot - 1) * KV_TILE_BYTES, kp, 64 * (jt - 2), wave, dmo);
        const int k0 = 64 * jt;
        if (k0 <= q0 + 32 * wave + 31) {
            const int kq0 = k0 + 4 * g - tq0;
            diff_tile2(first, k0 + 63 > q0 + 32 * wave, O, m, l, kr, (unsigned)(size_t)kring + kslot * KV_TILE_BYTES, qbase, va, slope2, kq0);
            first = false;
        }
        {
            bool wdone = false;
            if (canskip && !first && jt >= 1) {
                bool dn = true; const f32x4 qv = *qnp;
#pragma unroll
                for (int x = 0; x < 2; ++x) { const float kmx = kprep[x * 64 + jt - 1];
#pragma unroll
                    for (int u = 0; u < 2; ++u) dn = dn && (fmaf(qv[2 * x + u], kmx, slope2 * (float)(64 * jt - 1 - (tq0 + 16 * u))) - m[x][u] < -152.0f); }
                wdone = __all(dn);
            }
            if (lane == 0) F.MISC[8 + 8 * slot + wave] = wdone ? 1u : 0u;
        }
        {   const int dl = slot ? -KV_TILE_BYTES : KV_TILE_BYTES;
#pragma unroll
            for (int c = 0; c < 8; ++c) va[c] += dl; }
        slot ^= 1; kslot = kslot == 2 ? 0 : kslot + 1;
    }
    const float lam = __uint_as_float(F.MISC[5]);
    const float* gain = A_DIFFG + layer * DIFF_W + h * HD;
    int ge = g; asm volatile("" : "+v"(ge));
#pragma unroll
    for (int u = 0; u < 2; ++u) {
        const float l1 = xrow16_sum(l[0][u]), l2 = xrow16_sum(l[1][u]);
        const float c1 = 1.0f / l1, c2 = lam / l2;
        float ss = 0.f;
#pragma unroll
        for (int c = 0; c < 8; ++c)
#pragma unroll
            for (int r = 0; r < 4; ++r) { const float o = O[0][u][c][r] * c1 - O[1][u][c][r] * c2; O[0][u][c][r] = o; ss += o * o; }
        ss = xrow16_sum(ss);
        const float rstd = 1.0f / sqrtf(ss * (1.0f / HD) + LN_EPS) * (1.0f - LAMBDA_INIT[layer]);
        int tq = tq0 + 16 * u; asm volatile("" : "+v"(tq));
        const bf16* grow = gp + (size_t)tq * NPROJ;
        bf16* orow = W_MIX + (size_t)(b * SEQ + tq) * DM + MX_DIFF + h * HD;
#pragma unroll
        for (int c = 0; c < 8; ++c) { const int d = 16 * c + 4 * ge;
            const u32x2 gw = *(const GAS u32x2*)(grow + d); const f32x4 gn = *(const GAS f32x4*)(gain + d);
            const float y0 = O[0][u][c][0] * rstd * gn.x * silu_f(bf_lo(gw.x)), y1 = O[0][u][c][1] * rstd * gn.y * silu_f(bf_hi(gw.x));
            const float y2 = O[0][u][c][2] * rstd * gn.z * silu_f(bf_lo(gw.y)), y3 = O[0][u][c][3] * rstd * gn.w * silu_f(bf_hi(gw.y));
            u32x2 w; w.x = pkbf(y0, y1); w.y = pkbf(y2, y3); *(GAS u32x2*)(orow + d) = w;
            if (c & 1) asm volatile("" ::: "memory"); }
    }
    asm volatile("s_waitcnt vmcnt(0)" ::: "memory");
}

__device__ __forceinline__ float xor_partner(float own, unsigned s0, unsigned s1) { return __uint_as_float(s0 ^ s1 ^ __float_as_uint(own)); }
__device__ __forceinline__ void sb_group32(bool diag, f32x4 (&S)[2], float& R, bf16x8& pb, int kq  , int g) {
    float u[2][4], be[2][4];
#pragma unroll
    for (int a = 0; a < 2; ++a)
#pragma unroll
        for (int r = 0; r < 4; ++r) { const float e = __builtin_amdgcn_exp2f(S[a][r]); const float uu = __builtin_amdgcn_rcpf(1.0f + e); u[a][r] = uu; be[a][r] = e * uu; }
    if (diag) {
        int kql = kq; asm volatile("" : "+v"(kql));
#pragma unroll
        for (int a = 0; a < 2; ++a)
#pragma unroll
            for (int r = 0; r < 4; ++r) if (kql + 16 * a + r >= 0) { u[a][r] = 1.0f; be[a][r] = 0.f; }
    }
    float w[2][4], T[2];
#pragma unroll
    for (int a = 0; a < 2; ++a) { w[a][3] = 1.0f; w[a][2] = u[a][3]; w[a][1] = w[a][2] * u[a][2]; w[a][0] = w[a][1] * u[a][1]; T[a] = w[a][0] * u[a][0]; }
    float G[2], Tot[2];
#pragma unroll
    for (int a = 0; a < 2; ++a) {
        auto s = __builtin_amdgcn_permlane16_swap(__float_as_uint(T[a]), __float_as_uint(T[a]), false, false);
        const float pt = xor_partner(T[a], s[0], s[1]), pp = T[a] * pt;
        auto t = __builtin_amdgcn_permlane32_swap(__float_as_uint(pp), __float_as_uint(pp), false, false);
        const float po = xor_partner(pp, t[0], t[1]);
        G[a] = ((g & 1) ? 1.0f : pt) * ((g < 2) ? po : 1.0f); Tot[a] = pp * po; }
    const float c1 = R * G[1], c0 = R * Tot[1] * G[0];
#pragma unroll
    for (int r = 0; r < 4; ++r) { S[1][r] = be[1][r] * (c1 * w[1][r]); S[0][r] = be[0][r] * (c0 * w[0][r]); }
    R = R * Tot[1] * Tot[0];
    u32x4 pw; pw.x = pkbf(S[0][0], S[0][1]); pw.y = pkbf(S[0][2], S[0][3]); pw.z = pkbf(S[1][0], S[1][1]); pw.w = pkbf(S[1][2], S[1][3]);
    pb = __builtin_bit_cast(bf16x8, pw);
}
__device__ __forceinline__ void sb_unit2(Frame& F, int b, int h, int qb) {
    const int tid_ = opaque_tid(), lane = tid_ & 63;
    const int wave = F.wave, li = lane & 15, g = lane >> 4;
    const int q0 = 256 * qb, tq0 = q0 + 32 * wave + li;
    const bf16* base = W_PROJ + (size_t)(b * SEQ) * NPROJ;
    const bf16* qp = base + C_SQ + h * HD; const bf16* kp = base + C_SK + h * HD; const bf16* vp = base + C_SV + h * HD; const bf16* gp = base + C_SG + h * HD;
    LAS unsigned char* kring = F.lds + DK_RING; LAS unsigned char* vring = F.lds + DV_RING;
    const int jt0 = 4 * qb + 3;
#pragma unroll
    for (int i = 0; i < 8; ++i) { const int row = 32 * wave + 4 * i + (lane >> 4), slot = lane & 15;
        glds16(qp + (size_t)(q0 + row) * NPROJ + 8 * (slot ^ swz_k(row)), (unsigned)(size_t)(F.lds + DQ_IMG + 1024 * (8 * wave + i))); }
    unsigned dmo[4]; kv_dma_offsets(dmo, wave, lane);
    kv_dma(kring, vring, kp, vp, 64 * jt0, wave, dmo);
    f32x4 O[2][8]; float R[2] = {1.0f, 1.0f};
#pragma unroll
    for (int u = 0; u < 2; ++u)
#pragma unroll
        for (int c = 0; c < 8; ++c) O[u][c] = (f32x4){0.f, 0.f, 0.f, 0.f};
    unsigned kr[4], va[8];
    {   const int q = li >> 2, p = lane & 3; const unsigned vb = (unsigned)(size_t)vring;
#pragma unroll
        for (int s = 0; s < 4; ++s) kr[s] = 256 * li + 16 * ((4 * s + g) ^ swz_k(li));
#pragma unroll
        for (int c = 0; c < 8; ++c) va[c] = vb + 256 * (4 * g + q) + 16 * ((2 * c + (p >> 1)) ^ swz_v(4 * g + q)) + 8 * (p & 1); }
    const unsigned qbase = (unsigned)(size_t)(F.lds + DQ_IMG) + 256 * 32 * wave;
    asm volatile("s_waitcnt vmcnt(0)" ::: "memory");
    bf16x8 qf[2][4];
#pragma unroll
    for (int u = 0; u < 2; ++u)
#pragma unroll
        for (int s = 0; s < 4; ++s) qf[u][s] = *(const LAS bf16x8*)(qbase + kr[s] + 256 * (16 * u));
    int slot = 0; bool started = false;
    for (int jt = jt0; jt >= 0; --jt) {
        asm volatile("s_waitcnt vmcnt(0)\n\ts_barrier" ::: "memory");
        if (jt != jt0) {
            unsigned alld = 1u;
#pragma unroll
            for (int w = 0; w < 8; ++w) alld &= F.MISC[8 + 8 * (slot ^ 1) + w];
            if (__builtin_amdgcn_readfirstlane((int)alld)) break;
        }
        if (jt >= 1) kv_dma(kring + (slot ^ 1) * KV_TILE_BYTES, vring + (slot ^ 1) * KV_TILE_BYTES, kp, vp, 64 * (jt - 1), wave, dmo);
        const int k0 = 64 * jt;
        if (k0 <= q0 + 32 * wave + 30) {
            const bool diag = (k0 + 63 >= q0 + 32 * wave);
            const unsigned kb = (unsigned)(size_t)kring + slot * KV_TILE_BYTES;
            const int kq0 = k0 + 4 * g - tq0;
#pragma unroll
            for (int hh = 1; hh >= 0; --hh) {
                f32x4 S0[2], S1[2];
#pragma unroll
                for (int a = 0; a < 2; ++a) { S0[a] = (f32x4){0.f, 0.f, 0.f, 0.f}; S1[a] = (f32x4){0.f, 0.f, 0.f, 0.f};
#pragma unroll
                    for (int s = 0; s < 4; ++s) { const bf16x8 kf = *(const LAS bf16x8*)(kb + kr[s] + 256 * (32 * hh + 16 * a)); S0[a] = mfma16(kf, qf[0][s], S0[a]); S1[a] = mfma16(kf, qf[1][s], S1[a]); } }
                SCHED_FENCE();
                bf16x8 vv[4];
#pragma unroll
                for (int c = 0; c < 4; ++c) vv[c] = cat8(tr_read((const LAS unsigned char*)(va[c] + 256 * (32 * hh))), tr_read((const LAS unsigned char*)(va[c] + 256 * (32 * hh + 16))));
                SCHED_FENCE();
                bf16x8 pb0, pb1;
                sb_group32(diag, S0, R[0], pb0, kq0 + 32 * hh, g);
                sb_group32(diag, S1, R[1], pb1, kq0 + 32 * hh - 16, g);
                SCHED_FENCE();
#pragma unroll
                for (int c = 0; c < 4; ++c) { O[0][c] = mfma16(vv[c], pb0, O[0][c]); O[1][c] = mfma16(vv[c], pb1, O[1][c]); }
                SCHED_FENCE();
#pragma unroll
                for (int c = 0; c < 4; ++c) vv[c] = cat8(tr_read((const LAS unsigned char*)(va[4 + c] + 256 * (32 * hh))), tr_read((const LAS unsigned char*)(va[4 + c] + 256 * (32 * hh + 16))));
                SCHED_FENCE();
#pragma unroll
                for (int c = 0; c < 4; ++c) { O[0][4 + c] = mfma16(vv[c], pb0, O[0][4 + c]); O[1][4 + c] = mfma16(vv[c], pb1, O[1][4 + c]); }
                SCHED_FENCE();
            }
            started = true;
        }
        {   const bool wdone = started && __all(R[0] == 0.f && R[1] == 0.f);
            if (lane == 0) F.MISC[8 + 8 * slot + wave] = wdone ? 1u : 0u; }
        {   const int dl = slot ? -KV_TILE_BYTES : KV_TILE_BYTES;
#pragma unroll
            for (int c = 0; c < 8; ++c) va[c] += dl; }
        slot ^= 1;
    }
    int ge = g; asm volatile("" : "+v"(ge));
#pragma unroll
    for (int u = 0; u < 2; ++u) {
        int tq = tq0 + 16 * u; asm volatile("" : "+v"(tq));
        const bf16* grow = gp + (size_t)tq * NPROJ;
        bf16* orow = W_MIX + (size_t)(b * SEQ + tq) * DM + MX_SB + h * HD;
#pragma unroll
        for (int c = 0; c < 8; ++c) { const int d = 16 * c + 4 * ge;
            const u32x2 gw = *(const GAS u32x2*)(grow + d);
            const float y0 = O[u][c][0] * silu_f(bf_lo(gw.x)), y1 = O[u][c][1] * silu_f(bf_hi(gw.x)), y2 = O[u][c][2] * silu_f(bf_lo(gw.y)), y3 = O[u][c][3] * silu_f(bf_hi(gw.y));
            u32x2 w; w.x = pkbf(y0, y1); w.y = pkbf(y2, y3); *(GAS u32x2*)(orow + d) = w; }
    }
    asm volatile("s_waitcnt vmcnt(0)" ::: "memory");
}

constexpr int R_KIMG = 0, R_VIMG = IMG128, R_SIMG = 2 * IMG128, R_GTAB = 4 * IMG128;
__device__ __forceinline__ void ret_unit2(Frame& F, int b, int h, int layer) {
    const int tid = opaque_tid(), lane = tid & 63;
    int wave = F.wave; asm volatile("" : "+s"(wave));
    const int li = lane & 15, g = lane >> 4, q = li >> 2, p = lane & 3;
    const float lg2 = RET_LOG_GAMMA[h] * LOG2E;
    const float kscale = 0.08838834764831845f;
    const float cdecay = __builtin_amdgcn_exp2f(lg2 * 128.f);
    const bf16* base = W_PROJ + (size_t)(b * SEQ) * NPROJ;
    const bf16* qp = base + C_RQ + h * HD; const bf16* kp = base + C_RK + h * HD; const bf16* vp = base + C_RV + h * HD; const bf16* gp = base + C_RG + h * HD;
    float dl[4];
#pragma unroll
    for (int r = 0; r < 4; ++r) dl[r] = kscale * __builtin_amdgcn_exp2f(lg2 * (float)(li - 4 * g - r));
    const float qd = __builtin_amdgcn_exp2f(lg2 * (float)(16 * wave + li + 1));
    const unsigned lds0 = (unsigned)(size_t)F.lds;
    const unsigned a_row = lds0 + li * RS + 16 * g;
    const unsigned a_tra = lds0 + (4 * g + q) * RS + 8 * p;
    const unsigned a_trn = lds0 + (8 * g + q) * RS + 8 * p;
    LAS float* gtab = (LAS float*)(F.lds + R_GTAB);
    if (tid < HD) gtab[tid] = A_RETG[layer * RET_W + h * HD + tid];
    LAS float* kdt = gtab + 128; LAS float* g16 = gtab + 256;
    if (tid < 128) kdt[tid] = kscale * __builtin_amdgcn_exp2f(lg2 * (float)(127 - tid));
    if (tid < 8) g16[tid] = __builtin_amdgcn_exp2f(lg2 * (float)(16 * tid));
    u32x4 stK[4], stV[4];
#pragma unroll
    for (int i = 0; i < 4; ++i) { const int id = tid + 512 * i; const unsigned so = (unsigned)(id >> 4) * (NPROJ * 2) + 16 * (id & 15);
        stK[i] = *(const GAS u32x4*)((const char*)kp + so); stV[i] = *(const GAS u32x4*)((const char*)vp + so); }
    f32x4 ST[8];
#pragma unroll
    for (int d = 0; d < 8; ++d) ST[d] = (f32x4){0.f, 0.f, 0.f, 0.f};
    bf16x8 q0f, q1f, q2f, q3f;
    {   const size_t qrow = (size_t)(16 * wave + li) * NPROJ;
        q0f = *(const GAS bf16x8*)(qp + qrow + 8 * g); q1f = *(const GAS bf16x8*)(qp + qrow + 32 + 8 * g); q2f = *(const GAS bf16x8*)(qp + qrow + 64 + 8 * g); q3f = *(const GAS bf16x8*)(qp + qrow + 96 + 8 * g); }
#pragma unroll
    for (int i = 0; i < 4; ++i) { const int id = lane + 64 * i; *(LAS u32x4*)(lds0 + R_SIMG + (16 * wave + (id >> 4)) * RS + 16 * (id & 15)) = (u32x4){0u, 0u, 0u, 0u}; }
    asm volatile("" : "+v"(stK[0]), "+v"(stK[1]), "+v"(stK[2]), "+v"(stK[3]), "+v"(stV[0]), "+v"(stV[1]), "+v"(stV[2]), "+v"(stV[3]));
    for (int c = 0; c < SEQ / 128; ++c) {
        const int t0 = 128 * c;
        const int tl = opaque_tid(), li2 = tl & 15, g2 = (tl & 63) >> 4;
        asm volatile("s_barrier" ::: "memory");
#pragma unroll
        for (int i = 0; i < 4; ++i) { const int id = tl + 512 * i, row = id >> 4, sl = id & 15; *(LAS u32x4*)(lds0 + R_KIMG + row * RS + 16 * sl) = stK[i]; *(LAS u32x4*)(lds0 + R_VIMG + row * RS + 16 * sl) = stV[i]; }
        asm volatile("" ::: "memory");
        const size_t qrow = (size_t)(t0 + 16 * wave + li2) * NPROJ;
        const int tn = 128 * (c + 1);
        if (c + 1 < SEQ / 128) {
            const char* kn = (const char*)(kp + (size_t)tn * NPROJ); const char* vn = (const char*)(vp + (size_t)tn * NPROJ);
#pragma unroll
            for (int i = 0; i < 4; ++i) { const int id = tl + 512 * i; const unsigned so = (unsigned)(id >> 4) * (NPROJ * 2) + 16 * (id & 15); stK[i] = *(const GAS u32x4*)(kn + so); stV[i] = *(const GAS u32x4*)(vn + so); }
        }
        asm volatile("s_waitcnt lgkmcnt(0)\n\ts_barrier" ::: "memory");
        const int scur = R_SIMG + IMG128 * (c & 1), snxt = R_SIMG + IMG128 * ((c & 1) ^ 1);
#define R2_TRN(DST, IMG, KS, CT) DST = cat8(tr_read((const LAS unsigned char*)(a_trn + (IMG) + 32 * (KS) * RS + 32 * (CT))), tr_read((const LAS unsigned char*)(a_trn + (IMG) + 32 * (KS) * RS + 32 * (CT) + 4 * RS)))
#define R2_TRA(DST, IMG, KS, CT) DST = cat8(tr_read((const LAS unsigned char*)(a_tra + (IMG) + 32 * (KS) * RS + 32 * (CT))), tr_read((const LAS unsigned char*)(a_tra + (IMG) + 32 * (KS) * RS + 32 * (CT) + 16 * RS)))
#define R2_ROW(DST, IMG, RT, S4) DST = *(const LAS bf16x8*)(a_row + (IMG) + 16 * (RT) * RS + 64 * (S4))
#define R2_PIPE(NB, LOADF, MMAF) do { bf16x8 fa[4], fb[4]; LOADF(fa, 0); _Pragma("unroll") for (int bt = 0; bt < (NB); bt += 2) { \
            if (bt + 1 < (NB)) LOADF(fb, bt + 1); SCHED_FENCE(); MMAF(fa, bt); SCHED_FENCE(); \
            if (bt + 1 < (NB)) { if (bt + 2 < (NB)) LOADF(fa, bt + 2); SCHED_FENCE(); MMAF(fb, bt + 1); SCHED_FENCE(); } } } while (0)
        {   bf16x8 vfd[4];
            {   bf16x8 vn[4];
#pragma unroll
                for (int ks = 0; ks < 4; ++ks) R2_TRN(vn[ks], R_VIMG, ks, wave);
#pragma unroll
                for (int ks = 0; ks < 4; ++ks) { u32x4 w; const u32x4 vw = __builtin_bit_cast(u32x4, vn[ks]);
                    const f32x4 kd0 = *(const LAS f32x4*)(kdt + 32 * ks + 8 * g), kd1 = *(const LAS f32x4*)(kdt + 32 * ks + 8 * g + 4);
                    w[0] = pkbf(bf_lo(vw[0]) * kd0.x, bf_hi(vw[0]) * kd0.y); w[1] = pkbf(bf_lo(vw[1]) * kd0.z, bf_hi(vw[1]) * kd0.w);
                    w[2] = pkbf(bf_lo(vw[2]) * kd1.x, bf_hi(vw[2]) * kd1.y); w[3] = pkbf(bf_lo(vw[3]) * kd1.z, bf_hi(vw[3]) * kd1.w);
                    vfd[ks] = __builtin_bit_cast(bf16x8, w); } }
#pragma unroll
            for (int dt = 0; dt < 8; ++dt) ST[dt] = ST[dt] * cdecay;
            SCHED_FENCE();
#define R2_LD_ST(F, BT) do { _Pragma("unroll") for (int ks = 0; ks < 4; ++ks) R2_TRN(F[ks], R_KIMG, ks, (BT)); } while (0)
#define R2_MM_ST(F, BT) do { _Pragma("unroll") for (int ks = 0; ks < 4; ++ks) ST[(BT)] = mfma16(vfd[ks], F[ks], ST[(BT)]); } while (0)
            R2_PIPE(8, R2_LD_ST, R2_MM_ST);
#pragma unroll
            for (int dt = 0; dt < 8; ++dt)
#pragma unroll
                for (int r = 0; r < 4; ++r) *(LAS unsigned short*)(lds0 + (16 * wave + 4 * g2) * RS + 2 * li2 + snxt + r * RS + 32 * dt) = (unsigned short)(pkbf(ST[dt][r], 0.f) & 0xffffu);
        }
        SCHED_FENCE();
        f32x4 OUT[8];
#define R2_LD_CR(F, BT) do { _Pragma("unroll") for (int s = 0; s < 4; ++s) R2_ROW(F[s], scur, (BT), s); } while (0)
#define R2_MM_CR(F, BT) do { f32x4 acc = (f32x4){0.f, 0.f, 0.f, 0.f}; acc = mfma16(F[0], q0f, acc); acc = mfma16(F[1], q1f, acc); acc = mfma16(F[2], q2f, acc); acc = mfma16(F[3], q3f, acc); OUT[(BT)] = acc * qd; } while (0)
        R2_PIPE(8, R2_LD_CR, R2_MM_CR);
        SCHED_FENCE();
        bf16x8 pb[4];
        {   unsigned pk[8][2];
#define R2_LD_SC(F, BT) do { if ((BT) <= wave) { _Pragma("unroll") for (int s = 0; s < 4; ++s) R2_ROW(F[s], R_KIMG, (BT), s); } } while (0)
#define R2_MM_SC(F, BT) do { if ((BT) <= wave) { f32x4 S = (f32x4){0.f, 0.f, 0.f, 0.f}; S = mfma16(F[0], q0f, S); S = mfma16(F[1], q1f, S); S = mfma16(F[2], q2f, S); S = mfma16(F[3], q3f, S); \
                const float dtf = g16[wave - (BT)]; _Pragma("unroll") for (int r = 0; r < 4; ++r) { const float v = S[r] * (dl[r] * dtf); S[r] = ((BT) < wave || li - 4 * g - r >= 0) ? v : 0.f; } \
                pk[(BT)][0] = pkbf(S[0], S[1]); pk[(BT)][1] = pkbf(S[2], S[3]); } else { pk[(BT)][0] = 0u; pk[(BT)][1] = 0u; } } while (0)
            R2_PIPE(8, R2_LD_SC, R2_MM_SC);
#pragma unroll
            for (int ks = 0; ks < 4; ++ks) { u32x4 w; w.x = pk[2 * ks][0]; w.y = pk[2 * ks][1]; w.z = pk[2 * ks + 1][0]; w.w = pk[2 * ks + 1][1]; pb[ks] = __builtin_bit_cast(bf16x8, w); }
        }
        SCHED_FENCE();
        u32x2 gc[8];
#pragma unroll
        for (int et = 0; et < 8; ++et) gc[et] = *(const GAS u32x2*)(gp + qrow + 16 * et + 4 * g2);
        if (c + 1 < SEQ / 128) { const size_t qn = (size_t)(tn + 16 * wave + li2) * NPROJ;
            q0f = *(const GAS bf16x8*)(qp + qn + 8 * g2); q1f = *(const GAS bf16x8*)(qp + qn + 32 + 8 * g2); q2f = *(const GAS bf16x8*)(qp + qn + 64 + 8 * g2); q3f = *(const GAS bf16x8*)(qp + qn + 96 + 8 * g2); }
        SCHED_FENCE();
#define R2_LD_IN(F, BT) do { if (2 * ((BT) >> 1) <= wave) { _Pragma("unroll") for (int e4 = 0; e4 < 4; ++e4) R2_TRA(F[e4], R_VIMG, (BT) >> 1, 4 * ((BT) & 1) + e4); } } while (0)
#define R2_MM_IN(F, BT) do { if (2 * ((BT) >> 1) <= wave) { _Pragma("unroll") for (int e4 = 0; e4 < 4; ++e4) OUT[4 * ((BT) & 1) + e4] = mfma16(F[e4], pb[(BT) >> 1], OUT[4 * ((BT) & 1) + e4]); } } while (0)
        R2_PIPE(8, R2_LD_IN, R2_MM_IN);
#undef R2_LD_ST
#undef R2_MM_ST
#undef R2_LD_CR
#undef R2_MM_CR
#undef R2_LD_SC
#undef R2_MM_SC
#undef R2_LD_IN
#undef R2_MM_IN
#undef R2_PIPE
#undef R2_TRN
#undef R2_TRA
#undef R2_ROW
        SCHED_FENCE();
        {   float s1 = 0.f, s2 = 0.f;
#pragma unroll
            for (int et = 0; et < 8; ++et)
#pragma unroll
                for (int r = 0; r < 4; ++r) { s1 += OUT[et][r]; s2 = fmaf(OUT[et][r], OUT[et][r], s2); }
            s1 = xrow16_sum(s1); s2 = xrow16_sum(s2);
            const float mean = s1 * (1.0f / HD), var = fmaxf(s2 * (1.0f / HD) - mean * mean, 0.f), rstd = 1.0f / sqrtf(var + LN_EPS);
            asm volatile("" : "+v"(stK[0]), "+v"(stK[1]), "+v"(stK[2]), "+v"(stK[3]), "+v"(stV[0]), "+v"(stV[1]), "+v"(stV[2]), "+v"(stV[3]));
            bf16* orow = W_MIX + (size_t)(b * SEQ + t0 + 16 * wave + li2) * DM + MX_RET + h * HD + 4 * g2;
#pragma unroll
            for (int et = 0; et < 8; ++et) {
                const f32x4 gv = *(const LAS f32x4*)(gtab + 16 * et + 4 * g);
                const float y0 = (OUT[et][0] - mean) * rstd * gv.x * silu_f(bf_lo(gc[et].x)), y1 = (OUT[et][1] - mean) * rstd * gv.y * silu_f(bf_hi(gc[et].x));
                const float y2 = (OUT[et][2] - mean) * rstd * gv.z * silu_f(bf_lo(gc[et].y)), y3 = (OUT[et][3] - mean) * rstd * gv.w * silu_f(bf_hi(gc[et].y));
                u32x2 w; w.x = pkbf(y0, y1); w.y = pkbf(y2, y3); *(GAS u32x2*)(orow + 16 * et) = w; }
        }
    }
    asm volatile("s_waitcnt vmcnt(0) lgkmcnt(0)" ::: "memory");
}

__global__ void __launch_bounds__(NWAVES * 64, 2) mk_fwd(Args kernel_args  ) {
    extern __shared__ __attribute__((aligned(16))) unsigned char lds_raw[];
    Frame F;
    F.lds = (LAS unsigned char*)lds_raw;
    F.MISC = (volatile LAS unsigned*)(F.lds + MISC_OFF);
    F.wave = __builtin_amdgcn_readfirstlane((int)threadIdx.x >> 6);
    for (int u = F.wave * 64 + opaque_lane(); u < (LDS_BYTES - MISC_OFF) / 4; u += NWAVES * 64) F.MISC[u] = 0u;
    __syncthreads();
    XcdBarrier bar = xcd_barrier_post((unsigned*)(W_CTL + CW_BAR), F.MISC, (unsigned)F.wave);
#define GRID_BAR() do { XcdBarrier b_ = bar; asm volatile("" : "+s"(b_.bar), "+s"(b_.x)); xcd_barrier(b_); } while (0)

    p0_prologue(F);
    GRID_BAR();

    for (int layer = 0; layer < DEPTH; ++layer) {
        {   pg8::Gemm g{W_XB, W_WINT + (size_t)layer * NPROJ * DM, M, NPROJ, DM}; pg8::StaticOrder S; int c_ = (int)blockIdx.x; asm volatile("" : "+s"(c_)); S.init(M, NPROJ, (int)gridDim.x, c_);
            pg8::EpiBf16 E{W_PROJ, NPROJ, C_DQ / 256, (C_DQ + DIFF_W) / 256, 0.125f * LOG2E, C_SQ / 256, (C_SQ + SB_W) / 256, 0.08838834764831845f * LOG2E};
            pg8::gemm_phase<pg8::EpiBf16, pg8::StaticOrder, true, true>(F.lds, g, S, E, F.wave); }
        GRID_BAR();
        {   if (F.wave == 0) {
                const int ln = opaque_lane();
                const float a = A_LQ1[layer * 64 + ln] * A_LK1[layer * 64 + ln], c = A_LQ2[layer * 64 + ln] * A_LK2[layer * 64 + ln];
                const float lam = __expf(wave_sum(a)) - __expf(wave_sum(c)) + LAMBDA_INIT[layer];
                if (ln == 0) F.MISC[5] = __float_as_uint(lam); }
            gu32* qh = W_CTL + CW_Q + layer * 16 * 64;
            const int wg = (int)blockIdx.x;
            if (wg < BATCH * N_RET) { knorm_prepass(F, layer, F.wave); __syncthreads(); ret_unit2(F, wg / N_RET, wg % N_RET, layer); }
            {   constexpr int ND = BATCH * N_DIFF * (SEQ / 256), NSTAT = 256 - BATCH * N_RET;
                int u = wg >= BATCH * N_RET ? wg - BATCH * N_RET : NSTAT + next_unit(F, qh + 4 * 64);
                while (u < ND) { __syncthreads(); const int oc = DIFF_ORDER[u >> 2]; diff_unit2(F, u & 3, oc & 15, oc >> 4, layer); u = NSTAT + next_unit(F, qh + 4 * 64); } }
            {   constexpr int NSB = BATCH * N_SB * (SEQ / 256);
                int u = wg;
                while (u < NSB) { __syncthreads(); const int qb = SEQ / 256 - 1 - u / (BATCH * N_SB), bh = u % (BATCH * N_SB); sb_unit2(F, bh / N_SB, bh % N_SB, qb); u = 256 + next_unit(F, qh + 8 * 64); } }
        }
        GRID_BAR();
        {   pg8::Gemm g{W_MIX, W_WOUTT + (size_t)layer * DM * DM, M, DM, DM}; pg8::PanelOrder S; int c_ = (int)blockIdx.x; asm volatile("" : "+s"(c_)); S.init(M, c_);
            const float* xin = layer == 0 ? A_X : (const float*)((layer - 1) & 1 ? W_H : W_XH);
            float* xout = layer == DEPTH - 1 ? args.out : ((layer & 1) ? W_H : W_XH);
            pg8::EpiLnFused E{xin, xout, layer == DEPTH - 1 ? (bf16*)nullptr : W_XB, A_LNG + layer * DM, A_LNB + layer * DM,
                              (unsigned long long*)(args.ws + WS_SLOTS), (layer & 1) ? 0u : 0x80000000u, F.lds + 131072, F.wave};
            static_assert(pg8::EpiLnFused::ldc == DM && pg8::EpiLnFused::alpha == DEEPNORM_ALPHA, "epilogue constants");
            pg8::gemm_phase<pg8::EpiLnFused, pg8::PanelOrder, true, true>(F.lds, g, S, E, F.wave); }
        if (layer != DEPTH - 1) GRID_BAR();
    }
#undef GRID_BAR
}

extern "C" void kernel_launch(void* const* d_in, const int* in_sizes, int n_in, void* d_out, int out_size, void* d_ws, size_t ws_size, hipStream_t stream) {
    static int grid = 0;
    if (grid == 0) {
        if (n_in != 11 || in_sizes[0] != M * DM || out_size != M * DM || ws_size < WS_END) { fprintf(stderr, "kernel_launch: unexpected shapes (n_in %d, in0 %d, out %d, ws %zu); nothing launched\n", n_in, n_in > 0 ? in_sizes[0] : -1, out_size, ws_size); grid = -1; return; }
        int dev = 0, cus = 0, per_cu = 0;
        if (hipGetDevice(&dev) != hipSuccess || hipDeviceGetAttribute(&cus, hipDeviceAttributeMultiprocessorCount, dev) != hipSuccess) { grid = -1; return; }
        if (hipFuncSetAttribute((const void*)mk_fwd, hipFuncAttributeMaxDynamicSharedMemorySize, LDS_BYTES) != hipSuccess) { fprintf(stderr, "kernel_launch: hipFuncSetAttribute failed\n"); grid = -1; return; }
        if (hipOccupancyMaxActiveBlocksPerMultiprocessor(&per_cu, (const void*)mk_fwd, NWAVES * 64, LDS_BYTES) != hipSuccess || per_cu < 1) { fprintf(stderr, "kernel_launch: occupancy query reports %d workgroups per CU\n", per_cu); }
        (void)hipGetLastError();
        grid = cus;
        if (grid != 256) { fprintf(stderr, "kernel_launch: this build's fused output projection + LayerNorm needs exactly 256 workgroups (a 256-CU MI355X); found %d CUs; nothing launched\n", cus); grid = -1; return; }
    }
    if (grid < 0) return;
    if (hipMemsetAsync((char*)d_ws + WS_CTL, 0, CTL_ZERO_BYTES, stream) != hipSuccess) return;
    Args a{};
    for (int i = 0; i < 11; ++i) a.in[i] = (const float*)d_in[i];
    a.out = (float*)d_out; a.ws = (unsigned char*)d_ws;
    hipLaunchKernelGGL(mk_fwd, dim3(grid), dim3(NWAVES * 64), LDS_BYTES, stream, a);
}
```

```cpp
#include <hip/hip_runtime.h>
#include <cstdio>
#include <cstdint>
namespace pg8 {
#define PG8_LAS __attribute__((address_space(3)))
typedef unsigned short bf16_t;
typedef short bf16x8 __attribute__((ext_vector_type(8)));
typedef float f32x4 __attribute__((ext_vector_type(4)));
typedef unsigned u32x4 __attribute__((ext_vector_type(4)));
constexpr int BM = 256, BK = 64, HALF = 128, HTB = HALF * BK * 2  , STAGE_BYTES = 8 * HTB, NXCD = 8, WGM = 8;

__host__ __device__ __forceinline__ int lds_byte(int r, int c) { const int st = (r >> 4) * 2 + (c >> 5), rr = r & 15, cc = c & 31, ob = rr * 64 + cc * 2; return st * 1024 + (ob ^ (((ob >> 9) & 1) << 5)); }
__host__ __device__ __forceinline__ void stage_rc(int b, int& R, int& C) { const int st = b / 1024, sb = b % 1024, swz = sb ^ (((sb >> 9) & 1) << 5); R = (st >> 1) * 16 + swz / 64; C = (st & 1) * 32 + (swz % 64) / 2; }
__host__ __device__ __forceinline__ int perm32(int rho) { const int n = rho >> 4, i = rho & 15; return 8 * (i >> 2) + 4 * n + (i & 3); }

struct Unit { int pm, pn; };
struct Gemm { const bf16_t* A; const bf16_t* Bt; int M, N, K; };

struct StaticOrder {
    int nM, nN, nwg, G, c;
    __host__ __device__ void init(int M, int N, int G_, int c_) { nM = M / BM; nN = N / BM; nwg = nM * nN; G = G_; c = c_; }
    __host__ __device__ bool next(int i, Unit& u) const {
        const long L = (long)i * G + c; if (L >= nwg) return false;
        int wgid = (int)L; { const int q = nwg / NXCD, r = nwg % NXCD, xcd = wgid % NXCD, off = wgid / NXCD; wgid = (xcd < r ? xcd * (q + 1) : r * (q + 1) + (xcd - r) * q) + off; }
        const int nig = WGM * nN, gid = wgid / nig, fm = gid * WGM, gsz = (nM - fm) < WGM ? (nM - fm) : WGM;
        u.pm = fm + ((wgid % nig) % gsz); u.pn = (wgid % nig) / gsz; return true;
    }
    __device__ __forceinline__ void a_ready(const Unit&) const {}
    __device__ __forceinline__ void done(const Unit&) const {}
};
struct PanelOrder {
    int nM, c;
    __host__ __device__ void init(int M, int c_) { nM = M / BM; c = c_; }
    __host__ __device__ bool next(int i, Unit& u) const { if (16 * i >= nM) return false; const int x = c & 7, t = c >> 3; u.pm = 16 * i + 4 * (x >> 1) + (t >> 3); u.pn = 8 * (x & 1) + (t & 7); return true; }
    __device__ __forceinline__ void a_ready(const Unit&) const {}
    __device__ __forceinline__ void done(const Unit&) const {}
};
__device__ __forceinline__ unsigned cvt_pk_bf16(float lo, float hi) { unsigned r; asm volatile("v_cvt_pk_bf16_f32 %0, %1, %2" : "=v"(r) : "v"(lo), "v"(hi)); return r; }
struct EpiBf16 {
    static constexpr bool PERM = true, AFTER_DRAIN = false;
    bf16_t* O; int ldc; int sc_lo, sc_hi; float sc; int sd_lo, sd_hi; float sd;
    PG8_LAS unsigned char* scr;
    __device__ __forceinline__ void operator()(const f32x4 (&acc)[2][2][4][2], const Unit& u, int wr, int wc, int fr_, int fq_) const {
        int fr = fr_, fq = fq_; asm volatile("" : "+v"(fr), "+v"(fq));
        const float s = (u.pn >= sc_lo && u.pn < sc_hi) ? sc : ((u.pn >= sd_lo && u.pn < sd_hi) ? sd : 1.0f);
        const int lane = fr + 16 * fq;
        const unsigned area = (unsigned)(size_t)scr + (unsigned)(wr * 4 + wc) * 2304u;
        const unsigned wa = area + fr * 144 + fq * 16, ra = area + (lane >> 3) * 144 + (lane & 7) * 16;
        bf16_t* gp = O + (size_t)(u.pm * BM + wr * 64 + (lane >> 3)) * ldc + u.pn * BM + wc * 64 + (lane & 7) * 8;
#pragma unroll
        for (int ai = 0; ai < 2; ++ai)
#pragma unroll
            for (int m = 0; m < 4; ++m) {
                u32x4 w[2];
#pragma unroll
                for (int bj = 0; bj < 2; ++bj) { const f32x4 v0 = acc[ai][bj][m][0] * s, v1 = acc[ai][bj][m][1] * s;
                    w[bj].x = cvt_pk_bf16(v0[0], v0[1]); w[bj].y = cvt_pk_bf16(v0[2], v0[3]); w[bj].z = cvt_pk_bf16(v1[0], v1[1]); w[bj].w = cvt_pk_bf16(v1[2], v1[3]); }
                u32x4 r0, r1;
                asm volatile("ds_write_b128 %2, %3\n\tds_write_b128 %2, %4 offset:64\n\ts_waitcnt lgkmcnt(0)\n\tds_read_b128 %0, %5\n\tds_read_b128 %1, %5 offset:1152\n\ts_waitcnt lgkmcnt(0)"
                             : "=&v"(r0), "=&v"(r1) : "v"(wa), "v"(w[0]), "v"(w[1]), "v"(ra) : "memory");
                bf16_t* rowp = gp + (size_t)(ai * HALF + m * 16) * ldc;
                *(u32x4*)rowp = r0; *(u32x4*)(rowp + (size_t)8 * ldc) = r1; }
    }
};

__device__ __forceinline__ float xsum16(float x) {
    auto s = __builtin_amdgcn_permlane16_swap(__float_as_uint(x), __float_as_uint(x), false, false); x = __uint_as_float(s[0]) + __uint_as_float(s[1]);
    auto t = __builtin_amdgcn_permlane32_swap(__float_as_uint(x), __float_as_uint(x), false, false); return __uint_as_float(t[0]) + __uint_as_float(t[1]);
}
struct EpiLnFused {
    static constexpr bool PERM = false, AFTER_DRAIN = false;
    const float* X; float* XO; bf16_t* XBo; int ldc; float alpha; const float* gamma; const float* beta;
    unsigned long long* slots; unsigned* cnt; unsigned* tmo; PG8_LAS unsigned char* tab; int wave;
    __device__ __forceinline__ void operator()(f32x4 (&acc)[2][2][4][2], const Unit& u, int wr, int wc, int fr, int fq) const {
        typedef float f32x2v __attribute__((ext_vector_type(2)));
        const int row0 = u.pm * BM + wr * 64 + fr, col0 = u.pn * BM + wc * 32 + 4 * fq;
        PG8_LAS f32x2v* P = (PG8_LAS f32x2v*)tab;
        PG8_LAS f32x2v* S = (PG8_LAS f32x2v*)(tab + 8192);
        f32x4 xv[4][2][2];
        const unsigned ptab = (unsigned)(size_t)tab + (unsigned)((wr * 64 + fr) * 4 + wc) * 8u;
#define LNF_LDX(Q) do { const float* p_ = X + (size_t)(row0 + ((Q) >> 2) * HALF + ((Q) & 3) * 16) * ldc + col0; \
            asm volatile("global_load_dwordx4 %0, %4, off\n\tglobal_load_dwordx4 %1, %4, off offset:64\n\tglobal_load_dwordx4 %2, %4, off offset:512\n\tglobal_load_dwordx4 %3, %4, off offset:576" \
                         : "=&v"(xv[(Q) & 3][0][0]), "=&v"(xv[(Q) & 3][0][1]), "=&v"(xv[(Q) & 3][1][0]), "=&v"(xv[(Q) & 3][1][1]) : "v"(p_) : "memory"); } while (0)
#define LNF_WAIT(Q, N) asm volatile("s_waitcnt vmcnt(" #N ")" : "+v"(xv[(Q) & 3][0][0]), "+v"(xv[(Q) & 3][0][1]), "+v"(xv[(Q) & 3][1][0]), "+v"(xv[(Q) & 3][1][1]) :: "memory")
        static_assert(HALF == 128, "row offsets of the residual loads");
        LNF_LDX(0); LNF_LDX(1); LNF_LDX(2); LNF_LDX(3);
#pragma unroll
        for (int q = 0; q < 8; ++q) { const int ai = q >> 2, m = q & 3;
            if (q <= 4) LNF_WAIT(q, 12); else if (q == 5) LNF_WAIT(q, 8); else if (q == 6) LNF_WAIT(q, 4); else LNF_WAIT(q, 0);
            float s = 0.f, ss = 0.f;
#pragma unroll
            for (int bj = 0; bj < 2; ++bj)
#pragma unroll
                for (int n = 0; n < 2; ++n) { const f32x4 h = acc[ai][bj][m][n] + xv[q & 3][bj][n] * alpha; acc[ai][bj][m][n] = h;
                    s += (h[0] + h[1]) + (h[2] + h[3]); ss += (h[0] * h[0] + h[1] * h[1]) + (h[2] * h[2] + h[3] * h[3]); }
            if (q + 4 < 8) LNF_LDX(q + 4);
            s = xsum16(s); ss = xsum16(ss);
            if (fq == 0) { const f32x2v v_ = (f32x2v){s, ss}; asm volatile("ds_write_b64 %0, %1 offset:%2" :: "v"(ptab), "v"(v_), "n"((ai * HALF + m * 16) * 32) : "memory"); } }
#undef LNF_LDX
#undef LNF_WAIT
        asm volatile("s_waitcnt lgkmcnt(0)" ::: "memory"); __builtin_amdgcn_s_barrier(); asm volatile("" ::: "memory");
        const int lane = fr + 16 * fq, row = wave * 64 + lane;
        if (wave < 4) {
            const f32x2v a = P[row * 4 + 0], b = P[row * 4 + 1], c = P[row * 4 + 2], d = P[row * 4 + 3];
            const float s = (a.x + b.x) + (c.x + d.x), ss = (a.y + b.y) + (c.y + d.y);
            __hip_atomic_store(slots + ((size_t)(u.pm * BM + row) * 16 + u.pn), ((unsigned long long)__float_as_uint(ss) << 32) | __float_as_uint(s), __ATOMIC_RELAXED, __HIP_MEMORY_SCOPE_AGENT);
            asm volatile("s_waitcnt vmcnt(0)" ::: "memory");
        }
        __builtin_amdgcn_s_barrier(); asm volatile("" ::: "memory");
        if (wave == 0) {
            if (lane == 0) __hip_atomic_fetch_add(cnt + 64 * u.pm, 1u, __ATOMIC_RELAXED, __HIP_MEMORY_SCOPE_AGENT);
            unsigned spins = 0;
            while ((unsigned)__builtin_amdgcn_readfirstlane(__hip_atomic_load(cnt + 64 * u.pm, __ATOMIC_RELAXED, __HIP_MEMORY_SCOPE_AGENT)) < 16u) {
                if (++spins > (1u << 22)) { if (lane == 0) __hip_atomic_store(tmo, 1u, __ATOMIC_RELAXED, __HIP_MEMORY_SCOPE_AGENT); break; }
                __builtin_amdgcn_s_sleep(1); }
            __builtin_amdgcn_fence(__ATOMIC_ACQUIRE, "agent");
        }
        asm volatile("s_waitcnt vmcnt(0) lgkmcnt(0)" ::: "memory"); __builtin_amdgcn_s_barrier(); asm volatile("" ::: "memory");
        if (wave < 4) {
            const unsigned long long* sl = slots + (size_t)(u.pm * BM + row) * 16; float s = 0.f, ss = 0.f;
            f32x4 w[8];
            asm volatile("global_load_dwordx4 %0, %8, off sc1\n\tglobal_load_dwordx4 %1, %8, off offset:16 sc1\n\tglobal_load_dwordx4 %2, %8, off offset:32 sc1\n\tglobal_load_dwordx4 %3, %8, off offset:48 sc1\n\t"
                         "global_load_dwordx4 %4, %8, off offset:64 sc1\n\tglobal_load_dwordx4 %5, %8, off offset:80 sc1\n\tglobal_load_dwordx4 %6, %8, off offset:96 sc1\n\tglobal_load_dwordx4 %7, %8, off offset:112 sc1\n\t"
                         "s_waitcnt vmcnt(0)"
                         : "=&v"(w[0]), "=&v"(w[1]), "=&v"(w[2]), "=&v"(w[3]), "=&v"(w[4]), "=&v"(w[5]), "=&v"(w[6]), "=&v"(w[7]) : "v"(sl) : "memory");
#pragma unroll
            for (int t = 0; t < 8; ++t) { s += w[t][0] + w[t][2]; ss += w[t][1] + w[t][3]; }
            const float mean = s * (1.0f / 4096.0f), var = fmaxf(ss * (1.0f / 4096.0f) - mean * mean, 0.f);
            S[row] = (f32x2v){mean, 1.0f / sqrtf(var + 1e-5f)};
        }
        asm volatile("s_waitcnt lgkmcnt(0)" ::: "memory"); __builtin_amdgcn_s_barrier(); asm volatile("" ::: "memory");
        f32x4 gv[2][2], bv[2][2];
#pragma unroll
        for (int bj = 0; bj < 2; ++bj)
#pragma unroll
            for (int n = 0; n < 2; ++n) { gv[bj][n] = *(const f32x4*)(gamma + col0 + bj * HALF + n * 16); bv[bj][n] = *(const f32x4*)(beta + col0 + bj * HALF + n * 16); }
#pragma unroll
        for (int ai = 0; ai < 2; ++ai)
#pragma unroll
            for (int m = 0; m < 4; ++m) { const int r = ai * HALF + wr * 64 + m * 16 + fr; const f32x2v sr = S[r]; const size_t off = (size_t)(u.pm * BM + r) * ldc + col0;
#pragma unroll
                for (int bj = 0; bj < 2; ++bj)
#pragma unroll
                    for (int n = 0; n < 2; ++n) { const f32x4 y = ((acc[ai][bj][m][n] - sr.x) * sr.y) * gv[bj][n] + bv[bj][n];
                        *(f32x4*)(XO + off + bj * HALF + n * 16) = y;
                        if (XBo) { typedef unsigned u32x2v __attribute__((ext_vector_type(2))); u32x2v w; w.x = cvt_pk_bf16(y[0], y[1]); w.y = cvt_pk_bf16(y[2], y[3]); *(u32x2v*)(XBo + off + bj * HALF + n * 16) = w; } } }
    }
};

template <class Epi, class Sched, bool ALIGN_EPI = false, bool SP2 = false>
__device__ __forceinline__ void gemm_phase(PG8_LAS unsigned char* lds, const Gemm g, const Sched& S, const Epi& E, int wave_id  ) {
    int tid_; asm volatile("v_mbcnt_lo_u32_b32 %0, -1, 0\n\tv_mbcnt_hi_u32_b32 %0, -1, %0" : "=v"(tid_)); tid_ += 64 * wave_id;
    const int tid = tid_, wid = __builtin_amdgcn_readfirstlane(tid >> 6), lane = tid & 63, wr = wid >> 2, wc = wid & 3, fr = lane & 15, fq = lane >> 4;
    const int K = g.K, nt = K / BK;
    unsigned voffA[2], voffB[2];
#pragma unroll
    for (int i = 0; i < 2; ++i) { int R, C; stage_rc(tid * 16 + i * 8192, R, C); const int Rb = Epi::PERM ? (((R & ~31) << 1) + perm32(R & 31)) : R;
        voffA[i] = (unsigned)(R * K + C) * 2u; voffB[i] = (unsigned)(Rb * K + C) * 2u; }
    const size_t kstep = (size_t)(BK * 2);
    const size_t hstep = (size_t)HALF * K * 2;
    const size_t tstep = 2 * hstep;
    const size_t bhstep = Epi::PERM ? (size_t)32 * K * 2 : hstep;
    const unsigned ldsw = (unsigned)wid * 1024u;
    const int aoff = lds_byte(wr * 64 + fr, fq * 8), boff = lds_byte(wc * 32 + fr, fq * 8);
#define PG8_SA(b, h) (((b) * 2 + (h)) * HTB)
#define PG8_SB(b, h) ((4 + (b) * 2 + (h)) * HTB)
#define PG8_STAGE(bufoff, gbase, voff) do { _Pragma("unroll") for (int _i = 0; _i < 2; ++_i) \
        __builtin_amdgcn_global_load_lds((const unsigned*)((const char*)(gbase) + (voff)[_i]), (PG8_LAS unsigned*)(lds + (bufoff) + ldsw + _i * 8192), 16, 0, 0); } while (0)
#define PG8_LDA(dst, b, h) do { _Pragma("unroll") for (int m = 0; m < 4; ++m) _Pragma("unroll") for (int k = 0; k < 2; ++k) dst[m][k] = *(const PG8_LAS bf16x8*)(lds + PG8_SA(b, h) + aoff + m * 2048 + k * 1024); } while (0)
#define PG8_LDB(dst, b, h) do { _Pragma("unroll") for (int n = 0; n < 2; ++n) _Pragma("unroll") for (int k = 0; k < 2; ++k) dst[n][k] = *(const PG8_LAS bf16x8*)(lds + PG8_SB(b, h) + boff + n * 2048 + k * 1024); } while (0)
#define PG8_MMA(ai, bj, At, Bt) do { __builtin_amdgcn_s_setprio(1); _Pragma("unroll") for (int m = 0; m < 4; ++m) _Pragma("unroll") for (int n = 0; n < 2; ++n) _Pragma("unroll") for (int k = 0; k < 2; ++k) \
        acc[ai][bj][m][n] = __builtin_amdgcn_mfma_f32_16x16x32_bf16(Bt[n][k], At[m][k], acc[ai][bj][m][n], 0, 0, 0); __builtin_amdgcn_s_setprio(0); } while (0)
#define PG8_WAIT_V(n) asm volatile("s_waitcnt vmcnt(" #n ")" ::: "memory")
#define PG8_WAIT_L(n) asm volatile("s_waitcnt lgkmcnt(" #n ")" ::: "memory")
#define PG8_BAR __builtin_amdgcn_s_barrier()
#define PG8_SCHED __builtin_amdgcn_sched_barrier(0)
    Unit cur, nxt; int ui = 0;
    if (!S.next(0, cur)) return;
    f32x4 acc[2][2][4][2];
#pragma unroll
    for (int a = 0; a < 2; ++a)
#pragma unroll
        for (int b = 0; b < 2; ++b)
#pragma unroll
            for (int m = 0; m < 4; ++m)
#pragma unroll
                for (int n = 0; n < 2; ++n) acc[a][b][m][n] = (f32x4){0.f, 0.f, 0.f, 0.f};
    bf16x8 At[4][2], B0[2][2], B1[2][2];
    const char* cA = (const char*)g.A + (size_t)cur.pm * tstep; const char* cB = (const char*)g.Bt + (size_t)cur.pn * tstep;
    S.a_ready(cur);
    if constexpr (SP2) {
        PG8_STAGE(PG8_SB(0, 0), cB, voffB); PG8_STAGE(PG8_SB(0, 1), cB + bhstep, voffB); PG8_STAGE(PG8_SA(0, 0), cA, voffA); PG8_STAGE(PG8_SA(0, 1), cA + hstep, voffA);
        if (wr == 1) PG8_BAR;
        PG8_WAIT_V(2); PG8_BAR;
        PG8_STAGE(PG8_SB(1, 0), cB + kstep, voffB); PG8_STAGE(PG8_SA(1, 0), cA + kstep, voffA); PG8_STAGE(PG8_SB(1, 1), cB + bhstep + kstep, voffB);
        PG8_WAIT_V(6); PG8_BAR;
    } else {
        PG8_STAGE(PG8_SB(0, 0), cB, voffB); PG8_STAGE(PG8_SA(0, 0), cA, voffA); PG8_STAGE(PG8_SB(0, 1), cB + bhstep, voffB); PG8_STAGE(PG8_SA(0, 1), cA + hstep, voffA);
        if (wr == 1) PG8_BAR;
        PG8_WAIT_V(4); PG8_BAR;
        PG8_STAGE(PG8_SB(1, 0), cB + kstep, voffB); PG8_STAGE(PG8_SA(1, 0), cA + kstep, voffA); PG8_STAGE(PG8_SB(1, 1), cB + bhstep + kstep, voffB);
        PG8_WAIT_V(6); PG8_BAR;
    }
    for (;;) {
        const bool has_next = S.next(ui + 1, nxt);
        const char* nA = has_next ? (const char*)g.A + (size_t)nxt.pm * tstep : cA; const char* nB = has_next ? (const char*)g.Bt + (size_t)nxt.pn * tstep : cB;
        for (int t = 0; t < nt; t += 2) {
            const bool last = (t == nt - 2);
            const char* a1 = cA + (size_t)(t + 1) * kstep;
            const char* a2 = last ? nA : cA + (size_t)(t + 2) * kstep; const char* b2 = last ? nB : cB + (size_t)(t + 2) * kstep;
            const char* a3 = a2 + kstep; const char* b3 = b2 + kstep;
            if (last && has_next) S.a_ready(nxt);
            if constexpr (SP2) {
            PG8_LDB(B0, 0, 0); PG8_LDB(B1, 0, 1); PG8_SCHED; PG8_LDA(At, 0, 0); PG8_STAGE(PG8_SA(1, 1), a1 + hstep, voffA);
            PG8_WAIT_V(8); PG8_WAIT_L(0); PG8_BAR; PG8_MMA(0, 0, At, B0); PG8_MMA(0, 1, At, B1); PG8_BAR; PG8_SCHED;
            PG8_LDA(At, 0, 1); PG8_STAGE(PG8_SB(0, 0), b2, voffB); PG8_STAGE(PG8_SB(0, 1), b2 + bhstep, voffB); PG8_STAGE(PG8_SA(0, 0), a2, voffA);
            PG8_WAIT_V(8); PG8_WAIT_L(0); PG8_BAR; PG8_MMA(1, 0, At, B0); PG8_MMA(1, 1, At, B1); PG8_BAR; PG8_SCHED;
            PG8_LDB(B0, 1, 0); PG8_LDB(B1, 1, 1); PG8_SCHED; PG8_LDA(At, 1, 0); PG8_STAGE(PG8_SA(0, 1), a2 + hstep, voffA);
            PG8_WAIT_V(8); PG8_WAIT_L(0); PG8_BAR; PG8_MMA(0, 0, At, B0); PG8_MMA(0, 1, At, B1); PG8_BAR; PG8_SCHED;
            PG8_LDA(At, 1, 1); PG8_STAGE(PG8_SB(1, 0), b3, voffB); PG8_STAGE(PG8_SB(1, 1), b3 + bhstep, voffB); PG8_STAGE(PG8_SA(1, 0), a3, voffA);
            PG8_WAIT_V(8); PG8_WAIT_L(0); PG8_BAR; PG8_MMA(1, 0, At, B0); PG8_MMA(1, 1, At, B1); PG8_BAR; PG8_SCHED;
            } else {
            PG8_LDB(B0, 0, 0); PG8_SCHED; PG8_LDA(At, 0, 0); PG8_STAGE(PG8_SA(1, 1), a1 + hstep, voffA);
            PG8_WAIT_L(8); PG8_BAR; PG8_WAIT_L(0); PG8_MMA(0, 0, At, B0); PG8_BAR; PG8_SCHED;
            PG8_LDB(B1, 0, 1); PG8_STAGE(PG8_SB(0, 0), b2, voffB);
            PG8_BAR; PG8_WAIT_L(0); PG8_MMA(0, 1, At, B1); PG8_BAR;
            PG8_LDA(At, 0, 1); PG8_STAGE(PG8_SA(0, 0), a2, voffA);
            PG8_BAR; PG8_WAIT_L(0); PG8_MMA(1, 0, At, B0); PG8_BAR; PG8_SCHED;
            PG8_STAGE(PG8_SB(0, 1), b2 + bhstep, voffB);
            PG8_WAIT_V(6); PG8_BAR; PG8_MMA(1, 1, At, B1); PG8_BAR;
            PG8_LDB(B0, 1, 0); PG8_SCHED; PG8_LDA(At, 1, 0); PG8_STAGE(PG8_SA(0, 1), a2 + hstep, voffA);
            PG8_WAIT_L(8); PG8_BAR; PG8_WAIT_L(0); PG8_MMA(0, 0, At, B0); PG8_BAR; PG8_SCHED;
            PG8_LDB(B1, 1, 1); PG8_STAGE(PG8_SB(1, 0), b3, voffB);
            PG8_BAR; PG8_WAIT_L(0); PG8_MMA(0, 1, At, B1); PG8_BAR;
            PG8_LDA(At, 1, 1); PG8_STAGE(PG8_SA(1, 0), a3, voffA);
            PG8_BAR; PG8_WAIT_L(0); PG8_MMA(1, 0, At, B0); PG8_BAR; PG8_SCHED;
            PG8_STAGE(PG8_SB(1, 1), b3 + bhstep, voffB);
            PG8_WAIT_V(6); PG8_BAR; PG8_MMA(1, 1, At, B1); PG8_BAR;
            }
        }
        if constexpr (ALIGN_EPI) { if (wr == 0) PG8_BAR; }
        if constexpr (!Epi::AFTER_DRAIN) { E(acc, cur, wr, wc, fr, fq); S.done(cur); }
        if (!has_next) break;
#pragma unroll
        for (int a = 0; a < 2; ++a)
#pragma unroll
            for (int b = 0; b < 2; ++b)
#pragma unroll
                for (int m = 0; m < 4; ++m)
#pragma unroll
                    for (int n = 0; n < 2; ++n) acc[a][b][m][n] = (f32x4){0.f, 0.f, 0.f, 0.f};
        cur = nxt; cA = nA; cB = nB; ++ui;
        if constexpr (ALIGN_EPI) { if (wr == 1) PG8_BAR; }
    }
    PG8_WAIT_V(0);
    if constexpr (!ALIGN_EPI) { if (wr == 0) PG8_BAR; }
    PG8_BAR;
    if constexpr (Epi::AFTER_DRAIN) { E.fused(acc, cur, wr, wc, fr, fq, lds, wid, lane); S.done(cur); }
#undef PG8_SA
#undef PG8_SB
#undef PG8_STAGE
#undef PG8_LDA
#undef PG8_LDB
#undef PG8_MMA
#undef PG8_WAIT_V
#undef PG8_WAIT_L
#undef PG8_BAR
#undef PG8_SCHED
}
}

constexpr int NWAVES = 8;
constexpr int DM = 4096, BATCH = 4, SEQ = 4096, DEPTH = 4, HD = 128;
constexpr int M = BATCH * SEQ;
constexpr int NPROJ = 4 * DM;
constexpr int N_RET = 12, N_SB = 10, N_DIFF = 10;
constexpr int RET_W = N_RET * HD, SB_W = N_SB * HD, DIFF_W = N_DIFF * HD;
constexpr int C_RQ = 0, C_RK = RET_W, C_RV = 2 * RET_W, C_RG = 3 * RET_W;
constexpr int C_SQ = 4 * RET_W, C_SK = C_SQ + SB_W, C_SV = C_SQ + 2 * SB_W, C_SG = C_SQ + 3 * SB_W;
constexpr int C_DQ = 4 * RET_W + 4 * SB_W, C_DK = C_DQ + DIFF_W, C_DV = C_DQ + 2 * DIFF_W, C_DG = C_DQ + 3 * DIFF_W;
constexpr int MX_RET = 0, MX_SB = RET_W, MX_DIFF = RET_W + SB_W;
static_assert(C_DG + DIFF_W == NPROJ && MX_DIFF + DIFF_W == DM, "column map");
constexpr float LN_EPS = 1e-5f;
constexpr float LOG2E = 1.4426950408889634f, LN2 = 0.6931471805599453f;
constexpr float DEEPNORM_ALPHA = 1.681792830507429f;
__device__ const float RET_LOG_GAMMA[12] = {-3.174869716e-02f, -1.574835740e-02f, -7.843177766e-03f, -3.913899418e-03f, -1.955034910e-03f, -9.770396864e-04f, -4.884005175e-04f, -2.441704273e-04f, -1.220777631e-04f, -6.103701890e-05f, -3.051804379e-05f, -1.525890548e-05f};
__device__ const float ALIBI_SLOPE[10] = {5.000000000e-01f, 2.500000000e-01f, 1.250000000e-01f, 6.250000000e-02f, 3.125000000e-02f, 1.562500000e-02f, 7.812500000e-03f, 3.906250000e-03f, 7.071067691e-01f, 3.535533845e-01f};
__device__ const float LAMBDA_INIT[4] = {0.20000000000000007f, 0.35550906759096934f, 0.4707130183435842f, 0.5560582041556406f};

constexpr size_t MiB = 1u << 20;
constexpr size_t WS_CTL = 0, CTL_ZERO_BYTES = 1 * MiB;
constexpr size_t WS_WIN = 16 * MiB;
constexpr size_t WS_WOUT = WS_WIN + (size_t)DEPTH * NPROJ * DM * 2;
constexpr size_t WS_XB = WS_WOUT + (size_t)DEPTH * DM * DM * 2;
constexpr size_t WS_XH = WS_XB + (size_t)M * DM * 2;
constexpr size_t WS_PROJ = WS_XH + (size_t)M * DM * 4;
constexpr size_t WS_MIX = WS_PROJ + (size_t)M * NPROJ * 2;
constexpr size_t WS_H = WS_MIX + (size_t)M * DM * 2;
constexpr size_t WS_SLOTS = WS_H + (size_t)M * DM * 4;
constexpr size_t WS_END = WS_SLOTS + (size_t)M * 16 * 8;
constexpr int CW_BAR = 4096;
constexpr int CW_Q = 16384;
constexpr int CW_PRE = 49152;
constexpr int CW_LNC = 131072;
constexpr int CW_TMO = 8;
constexpr int CW_TMAX = 65536, TMAX_LAYER = BATCH * N_DIFF * 2 * 64;
constexpr int RS = 272;
constexpr int IMG64 = 64 * RS, IMG128 = 128 * RS;
constexpr int SCR_BYTES = 159744;
constexpr int MISC_OFF = SCR_BYTES;
constexpr int LDS_BYTES = SCR_BYTES + 1024;
static_assert(pg8::STAGE_BYTES + 12288 <= SCR_BYTES && LDS_BYTES <= 163840, "LDS map");

#define GAS __attribute__((address_space(1)))
#define LAS __attribute__((address_space(3)))
typedef unsigned short bf16;
typedef unsigned u32x4 __attribute__((ext_vector_type(4)));
typedef unsigned u32x2 __attribute__((ext_vector_type(2)));
typedef float f32x4 __attribute__((ext_vector_type(4)));
typedef short bf16x8 __attribute__((ext_vector_type(8)));
typedef short s16x4 __attribute__((ext_vector_type(4)));
typedef GAS unsigned gu32;
#define RLX_AGENT __ATOMIC_RELAXED, __HIP_MEMORY_SCOPE_AGENT
#define LDS_WAIT() asm volatile("s_waitcnt lgkmcnt(0)" ::: "memory")
#define VM_WAIT() asm volatile("s_waitcnt vmcnt(0)" ::: "memory")
__device__ __forceinline__ unsigned f2bf(float f) { unsigned u = __builtin_bit_cast(unsigned, f); return (u + 0x7fffu + ((u >> 16) & 1u)) >> 16; }
__device__ __forceinline__ unsigned pk2(float lo, float hi) { return f2bf(lo) | (f2bf(hi) << 16); }
__device__ __forceinline__ unsigned pkbf(float lo, float hi) { unsigned r; asm volatile("v_cvt_pk_bf16_f32 %0, %1, %2" : "=v"(r) : "v"(lo), "v"(hi)); return r; }
__device__ __forceinline__ float bf_lo(unsigned w) { return __uint_as_float(w << 16); }
__device__ __forceinline__ float bf_hi(unsigned w) { return __uint_as_float(w & 0xffff0000u); }
#define XB_TMO      128
#define XB_XCNT(j)  (256  + 64 * (j))
#define XB_XSUB(j)  (1280 + 64 * (j))
#define XB_XGEN(j)  (2304 + 64 * (j))
#define XB_TOP      3328
#define XB_TOPGEN   3392
#define XCD_BAR_WORDS 3456
#define XB_SPIN_CAP (1u << 18)

__device__ __forceinline__ unsigned xb_ld(unsigned* p)              { return __hip_atomic_load(p, __ATOMIC_RELAXED, __HIP_MEMORY_SCOPE_AGENT); }
__device__ __forceinline__ unsigned xb_add(unsigned* p, unsigned v) { return __hip_atomic_fetch_add(p, v, __ATOMIC_RELAXED, __HIP_MEMORY_SCOPE_AGENT); }
__device__ __forceinline__ unsigned xb_xcc_id() { return (unsigned)__builtin_amdgcn_s_getreg((3 << 11) | 20) & 0xFu; }
#define XB_SPIN(cond, bar) do { unsigned _sp = 0; while (cond) { __builtin_amdgcn_s_sleep(1); \
    if ((++_sp & 255u) == 0u) { if (xb_ld(&(bar)[XB_TMO])) break; if (_sp > XB_SPIN_CAP) { atomicAdd(&(bar)[XB_TMO], 1u); break; } } } } while (0)

struct XcdBarrier {
    unsigned wv;
    unsigned* bar; unsigned x;
    volatile LAS unsigned* st;
};

__device__ __forceinline__ bool xb_lane0() { int t; asm volatile("v_mbcnt_lo_u32_b32 %0, -1, 0\n\tv_mbcnt_hi_u32_b32 %0, -1, %0" : "=v"(t)); return t == 0; }
__device__ __forceinline__ XcdBarrier xcd_barrier_post(unsigned* bar, volatile LAS unsigned* st, unsigned wv) {
    XcdBarrier b; b.wv = wv; b.bar = bar; b.x = xb_xcc_id(); b.st = st;
    if (wv == 0u && xb_lane0()) (void)xb_add(&bar[XB_XCNT(b.x)], 1u);
    return b;
}
__device__ __forceinline__ void xcd_barrier_complete(unsigned* bar, unsigned x, unsigned& nloc, unsigned& nx) {
    const unsigned G = gridDim.x * gridDim.y * gridDim.z;
    unsigned sum, cnt, mine, sp = 0u;
    for (;;) {
        sum = 0u; cnt = 0u; mine = 0u;
#pragma unroll
        for (unsigned j = 0; j < 16; ++j) { const unsigned c = xb_ld(&bar[XB_XCNT(j)]); sum += c; cnt += (c > 0u) ? 1u : 0u; mine = (j == x) ? c : mine; }
        if (sum == G) break;
        __builtin_amdgcn_s_sleep(1);
        if ((++sp & 255u) == 0u) { if (xb_ld(&bar[XB_TMO])) break; if (sp > XB_SPIN_CAP) { atomicAdd(&bar[XB_TMO], 1u); break; } }
    }
    nloc = mine > 0u ? mine : 1u; nx = cnt > 0u ? cnt : 1u;
}

__device__ __forceinline__ void xcd_barrier(const XcdBarrier& b) {
    asm volatile("s_waitcnt vmcnt(0)" ::: "memory");
    __syncthreads();
    if (b.wv == 0u && xb_lane0()) {
        unsigned* bar = b.bar;
        __builtin_amdgcn_s_waitcnt(0);
        unsigned nloc = b.st[0], nx = b.st[1];
        if (nloc == 0u) { xcd_barrier_complete(bar, b.x, nloc, nx); b.st[0] = nloc; b.st[1] = nx; }
        const unsigned old = xb_add(&bar[XB_XSUB(b.x)], 1u);
        const unsigned gen = old / nloc;
        if (old + 1u == (gen + 1u) * nloc) {
            __builtin_amdgcn_fence(__ATOMIC_RELEASE, "agent");
            asm volatile("s_waitcnt vmcnt(0)" ::: "memory");
            const unsigned og = xb_add(&bar[XB_TOP], 1u);
            const unsigned tg = og / nx;
            if (og + 1u == (tg + 1u) * nx) xb_add(&bar[XB_TOPGEN], 1u);
            else XB_SPIN(xb_ld(&bar[XB_TOPGEN]) == tg, bar);
            __builtin_amdgcn_fence(__ATOMIC_ACQUIRE, "agent");
            xb_add(&bar[XB_XGEN(b.x)], 1u);
            asm volatile("s_waitcnt vmcnt(0)" ::: "memory");
        } else {
            XB_SPIN(xb_ld(&bar[XB_XGEN(b.x)]) == gen, bar);
            __builtin_amdgcn_fence(__ATOMIC_ACQUIRE, "agent");
            asm volatile("s_waitcnt vmcnt(0)" ::: "memory");
        }
    }
    __syncthreads();
}

struct Args { const float* in[11]; float* out; unsigned char* ws; };
typedef const __attribute__((address_space(4))) Args CArgs;
__device__ __forceinline__ CArgs* kargs() { CArgs* p = (CArgs*)__builtin_amdgcn_kernarg_segment_ptr(); asm volatile("" : "+s"(p)); return p; }
#define args (*kargs())
struct Frame {
    LAS unsigned char* lds;
    volatile LAS unsigned* MISC;
    int wave;
};
__device__ __forceinline__ int opaque_lane() { int t; asm volatile("v_mbcnt_lo_u32_b32 %0, -1, 0\n\tv_mbcnt_hi_u32_b32 %0, -1, %0" : "=v"(t)); return t; }
#define opaque_tid() (F.wave * 64 + opaque_lane())
#define A_X       (args.in[0])
#define A_WIN     (args.in[1])
#define A_WOUT    (args.in[2])
#define A_LNG     (args.in[3])
#define A_LNB     (args.in[4])
#define A_RETG    (args.in[5])
#define A_DIFFG   (args.in[6])
#define A_LQ1     (args.in[7])
#define A_LK1     (args.in[8])
#define A_LQ2     (args.in[9])
#define A_LK2     (args.in[10])
#define W_CTL     ((gu32*)(args.ws + WS_CTL))
#define W_WINT    ((bf16*)(args.ws + WS_WIN))
#define W_WOUTT   ((bf16*)(args.ws + WS_WOUT))
#define W_XB      ((bf16*)(args.ws + WS_XB))
#define W_XH      ((float*)(args.ws + WS_XH))
#define W_PROJ    ((bf16*)(args.ws + WS_PROJ))
#define W_MIX     ((bf16*)(args.ws + WS_MIX))
#define W_H       ((float*)(args.ws + WS_H))
template <int CTRL> __device__ __forceinline__ float dpp_mov(float x) { return __builtin_bit_cast(float, __builtin_amdgcn_mov_dpp(__builtin_bit_cast(int, x), CTRL, 0xf, 0xf, true)); }
__device__ __forceinline__ float xrow16_max(float x) {
    auto s = __builtin_amdgcn_permlane16_swap(__float_as_uint(x), __float_as_uint(x), false, false);
    x = fmaxf(__uint_as_float(s[0]), __uint_as_float(s[1]));
    auto t = __builtin_amdgcn_permlane32_swap(__float_as_uint(x), __float_as_uint(x), false, false);
    return fmaxf(__uint_as_float(t[0]), __uint_as_float(t[1]));
}
__device__ __forceinline__ float xrow16_sum(float x) {
    auto s = __builtin_amdgcn_permlane16_swap(__float_as_uint(x), __float_as_uint(x), false, false);
    x = __uint_as_float(s[0]) + __uint_as_float(s[1]);
    auto t = __builtin_amdgcn_permlane32_swap(__float_as_uint(x), __float_as_uint(x), false, false);
    return __uint_as_float(t[0]) + __uint_as_float(t[1]);
}
__device__ __forceinline__ float wave_sum(float v) {
    v += dpp_mov<0xB1>(v); v += dpp_mov<0x4E>(v); v += dpp_mov<0x141>(v); v += dpp_mov<0x140>(v);
    return xrow16_sum(v);
}
__device__ __forceinline__ f32x4 mfma16(bf16x8 a, bf16x8 b, f32x4 c) { return __builtin_amdgcn_mfma_f32_16x16x32_bf16(a, b, c, 0, 0, 0); }
__device__ __forceinline__ s16x4 tr_read(const LAS unsigned char* p) { return __builtin_amdgcn_ds_read_tr16_b64_v4i16((LAS s16x4*)p); }
__device__ __forceinline__ bf16x8 cat8(s16x4 lo, s16x4 hi) { return (bf16x8){lo[0], lo[1], lo[2], lo[3], hi[0], hi[1], hi[2], hi[3]}; }
__device__ __forceinline__ float silu_f(float x) { return x * __builtin_amdgcn_rcpf(1.0f + __builtin_amdgcn_exp2f(-x * LOG2E)); }

__device__ __forceinline__ void p0_transpose_item(const float* W, int K, int N, bf16* WT, LAS float* scr, int item, int lane) {
    const int nblk = N / 32, kb = item / nblk, nb = item % nblk, k0 = 64 * kb, n0 = 32 * nb;
#pragma unroll
    for (int i = 0; i < 32; ++i) { const int kk = 2 * i + (lane >> 5); scr[kk * 33 + (lane & 31)] = __builtin_nontemporal_load(W + (size_t)(k0 + kk) * N + n0 + (lane & 31)); }
    LDS_WAIT(); asm volatile("" ::: "memory");
    const int c = lane & 7;
#pragma unroll
    for (int j = 0; j < 4; ++j) { const int n = (lane >> 3) + 8 * j; const LAS float* s = scr + (8 * c) * 33 + n;
        u32x4 o; o.x = pk2(s[0 * 33], s[1 * 33]); o.y = pk2(s[2 * 33], s[3 * 33]); o.z = pk2(s[4 * 33], s[5 * 33]); o.w = pk2(s[6 * 33], s[7 * 33]);
        __builtin_nontemporal_store(o, (GAS u32x4*)(WT + (size_t)(n0 + n) * K + k0 + 8 * c)); }
    LDS_WAIT(); asm volatile("" ::: "memory");
}
constexpr int CV_I_IN = (DM / 64) * (NPROJ / 32), CV_I_OUT = (DM / 64) * (DM / 32), CV_ITEMS = CV_I_IN + CV_I_OUT;
__device__ __forceinline__ void convert_item(int layer, int it, LAS float* scr, int lane) {
    if (it < CV_I_IN) p0_transpose_item(A_WIN + (size_t)layer * DM * NPROJ, DM, NPROJ, W_WINT + (size_t)layer * NPROJ * DM, scr, it, lane);
    else p0_transpose_item(A_WOUT + (size_t)layer * DM * DM, DM, DM, W_WOUTT + (size_t)layer * DM * DM, scr, it - CV_I_IN, lane);
}
__device__ __forceinline__ void p0_prologue(Frame& F0) {
    struct { LAS unsigned char* lds; int tid, lane, wave; } F; F.lds = F0.lds; F.wave = F0.wave; F.lane = opaque_lane(); F.tid = F.wave * 64 + F.lane;
    LAS float* scr = (LAS float*)(F.lds + F.wave * 16384);
    const int gw = blockIdx.x * NWAVES + F.wave, NGW = gridDim.x * NWAVES;
    for (int it = gw; it < DEPTH * CV_ITEMS; it += NGW) convert_item(it / CV_ITEMS, it % CV_ITEMS, scr, F.lane);
    const size_t nthr = (size_t)gridDim.x * NWAVES * 64, t0 = (size_t)blockIdx.x * NWAVES * 64 + F.tid;
    for (size_t i = t0; i < (size_t)M * DM / 8; i += nthr) {
        const f32x4 a = *(const GAS f32x4*)(A_X + i * 8), b = *(const GAS f32x4*)(A_X + i * 8 + 4);
        u32x4 o; o.x = pk2(a.x, a.y); o.y = pk2(a.z, a.w); o.z = pk2(b.x, b.y); o.w = pk2(b.z, b.w);
        *(GAS u32x4*)(W_XB + i * 8) = o; }
}
constexpr int CV_UNIT = 32, CV_UNITS = CV_ITEMS / CV_UNIT;
static_assert(CV_ITEMS % CV_UNIT == 0, "conversion units");
__device__ __forceinline__ void convert_unit(Frame& F, int layer, int u) {
    const int lane = opaque_lane(); LAS float* scr = (LAS float*)(F.lds + F.wave * 16384);
    for (int j = 0; j < CV_UNIT / NWAVES; ++j) convert_item(layer, u * CV_UNIT + F.wave * (CV_UNIT / NWAVES) + j, scr, lane);
}

__device__ __forceinline__ int next_unit(Frame& F, gu32* head) {
    __syncthreads();
    if (F.wave == 0 && opaque_lane() == 0) F.MISC[4] = __hip_atomic_fetch_add(head, 1u, RLX_AGENT);
    __syncthreads();
    return __builtin_amdgcn_readfirstlane((int)F.MISC[4]);
}
__device__ const unsigned char DIFF_ORDER[160] = {244, 245, 246, 247, 228, 229, 230, 231, 212, 213, 214, 215, 196, 197, 198, 199, 180, 181, 182, 183, 164, 165, 166, 167, 148, 149, 150, 151, 132, 133, 134, 135, 116, 117, 118, 119, 100, 101, 102, 103, 84, 85, 86, 87, 68, 69, 70, 71, 52, 53, 54, 55, 36, 37, 38, 39, 20, 21, 22, 23, 4, 5, 6, 7, 243, 227, 211, 195, 179, 163, 147, 131, 115, 99, 83, 242, 226, 210, 194, 178, 162, 146, 130, 114, 98, 82, 66, 67, 50, 51, 241, 225, 209, 193, 177, 161, 145, 129, 113, 97, 81, 65, 49, 33, 34, 35, 249, 233, 217, 201, 185, 169, 153, 137, 121, 105, 89, 73, 57, 41, 240, 224, 208, 192, 176, 160, 144, 128, 112, 96, 80, 64, 48, 32, 16, 17, 18, 19, 25, 248, 232, 216, 200, 184, 168, 152, 136, 120, 104, 88, 72, 56, 40, 24, 0, 1, 2, 3, 8, 9};
__device__ __forceinline__ void knorm_prepass(Frame& F, int layer, int wave) {
    const int lane = opaque_lane(), gw = blockIdx.x * NWAVES + wave, NGW = BATCH * N_RET * NWAVES;
    gu32* tm = W_CTL + CW_TMAX + layer * TMAX_LAYER; gu32* cnt = W_CTL + CW_PRE + layer * 64;
    unsigned ndone = 0;
    for (int it = gw; it < BATCH * N_DIFF * 128; it += NGW) {
        const int t32 = it & 127, bh = it >> 7, b = bh / N_DIFF, h = bh % N_DIFF;
        const bf16* kp = W_PROJ + (size_t)(b * SEQ + 32 * t32) * NPROJ + C_DK + h * HD + 8 * (lane & 15);
        u32x4 w[8];
#pragma unroll
        for (int i = 0; i < 8; ++i) w[i] = *(const GAS u32x4*)(kp + (size_t)(4 * i + (lane >> 4)) * NPROJ);
        float mx = 0.f;
#pragma unroll
        for (int i = 0; i < 8; ++i) { float s = 0.f;
#pragma unroll
            for (int j = 0; j < 4; ++j) { const float lo = bf_lo(w[i][j]), hi = bf_hi(w[i][j]); s = fmaf(lo, lo, s); s = fmaf(hi, hi, s); }
            s += dpp_mov<0xB1>(s); s += dpp_mov<0x4E>(s); s += dpp_mov<0x141>(s);
            mx = fmaxf(mx, s); }
        mx = xrow16_max(mx);
        if ((lane & 55) == 0) __hip_atomic_fetch_max(tm + ((bh * 2 + (lane >> 3)) * 64 + (t32 >> 1)), __float_as_uint(mx), RLX_AGENT);
        ++ndone;
    }
    asm volatile("s_waitcnt vmcnt(0)" ::: "memory");
    if (lane == 0) __hip_atomic_fetch_add((LAS unsigned*)&F.MISC[6], ndone, __ATOMIC_RELAXED, __HIP_MEMORY_SCOPE_WORKGROUP);
    __syncthreads();
    if (wave == 0 && lane == 0) { __hip_atomic_fetch_add(cnt, F.MISC[6], RLX_AGENT); F.MISC[6] = 0u; }
}
template <int CTRL, int ROWMASK> __device__ __forceinline__ float dpp_upd0(float x) { return __builtin_bit_cast(float, __builtin_amdgcn_update_dpp(0, __builtin_bit_cast(int, x), CTRL, ROWMASK, 0xf, true)); }
__device__ __forceinline__ float wave_prefix_max(float v) {
    v = fmaxf(v, dpp_upd0<0x111, 0xf>(v)); v = fmaxf(v, dpp_upd0<0x112, 0xf>(v)); v = fmaxf(v, dpp_upd0<0x114, 0xf>(v)); v = fmaxf(v, dpp_upd0<0x118, 0xf>(v));
    v = fmaxf(v, dpp_upd0<0x142, 0xa>(v)); v = fmaxf(v, dpp_upd0<0x143, 0xc>(v));
    return v;
}

constexpr int KV_TILE_BYTES = 64 * 256;
__device__ __forceinline__ int swz_k(int row) { return row & 15; }
__device__ __forceinline__ int swz_v(int row) { return (row & 15) ^ ((row & 1) << 3); }
__device__ __forceinline__ void glds16(const void* gsrc, unsigned lds_dst) { unsigned keep;
    asm volatile("s_mov_b32 %0, m0\n\ts_mov_b32 m0, %2\n\ts_nop 0\n\tglobal_load_lds_dwordx4 %1, off\n\ts_mov_b32 m0, %0" : "=&s"(keep) : "v"(gsrc), "s"(lds_dst) : "memory"); }
__device__ __forceinline__ void glds16_so(const void* gbase, unsigned voff, unsigned lds_dst) { unsigned keep;
    asm volatile("s_mov_b32 %0, m0\n\ts_mov_b32 m0, %2\n\ts_nop 0\n\tglobal_load_lds_dwordx4 %1, %3\n\ts_mov_b32 m0, %0" : "=&s"(keep) : "v"(voff), "s"(lds_dst), "s"(gbase) : "memory"); }
__device__ __forceinline__ void kv_dma_offsets(unsigned (&dmo)[4], int wave, int lane) {
#pragma unroll
    for (int i = 0; i < 2; ++i) { const int row = 4 * (2 * wave + i) + (lane >> 4), slot = lane & 15;
        dmo[2 * i] = (unsigned)row * (NPROJ * 2) + 16 * (slot ^ swz_k(row)); dmo[2 * i + 1] = (unsigned)row * (NPROJ * 2) + 16 * (slot ^ swz_v(row)); }
}
__device__ __forceinline__ void kv_dma(LAS unsigned char* kbuf, LAS unsigned char* vbuf, const bf16* kp, const bf16* vp, int k0, int wave, const unsigned (&dmo)[4]) {
    const char* kb = (const char*)(kp + (size_t)k0 * NPROJ); const char* vb = (const char*)(vp + (size_t)k0 * NPROJ);
#pragma unroll
    for (int i = 0; i < 2; ++i) { const int pc = 2 * wave + i;
        glds16_so(kb, dmo[2 * i], (unsigned)(size_t)(kbuf + 1024 * pc));
        glds16_so(vb, dmo[2 * i + 1], (unsigned)(size_t)(vbuf + 1024 * pc)); }
}
__device__ __forceinline__ void k_dma(LAS unsigned char* kbuf, const bf16* kp, int k0, int wave, const unsigned (&dmo)[4]) {
    const char* kb = (const char*)(kp + (size_t)k0 * NPROJ);
    glds16_so(kb, dmo[0], (unsigned)(size_t)(kbuf + 1024 * (2 * wave))); glds16_so(kb, dmo[2], (unsigned)(size_t)(kbuf + 1024 * (2 * wave + 1))); }
__device__ __forceinline__ void v_dma(LAS unsigned char* vbuf, const bf16* vp, int k0, int wave, const unsigned (&dmo)[4]) {
    const char* vb = (const char*)(vp + (size_t)k0 * NPROJ);
    glds16_so(vb, dmo[1], (unsigned)(size_t)(vbuf + 1024 * (2 * wave))); glds16_so(vb, dmo[3], (unsigned)(size_t)(vbuf + 1024 * (2 * wave + 1))); }
constexpr float NEG_MASK = -1e30f;
constexpr float DIFF_THR = 6.0f;
#ifndef SCHED_FENCE
#define SCHED_FENCE() __builtin_amdgcn_sched_barrier(0)
#endif
__device__ __forceinline__ float max3_raw(float a, float b, float c) { float r; asm("v_max3_f32 %0, %1, %2, %3" : "=v"(r) : "v"(a), "v"(b), "v"(c)); return r; }
__device__ __forceinline__ float max2_raw(float a, float b) { float r; asm("v_max_f32_e32 %0, %1, %2" : "=v"(r) : "v"(a), "v"(b)); return r; }
__device__ __forceinline__ void diff_sm32(bool force, bool diag, f32x4 (&S)[2], f32x4 (&O)[8], float& m, float& l, bf16x8& pb, int kq  ) {
    if (diag) {
        int kql = kq; asm volatile("" : "+v"(kql));
#pragma unroll
        for (int a = 0; a < 2; ++a)
#pragma unroll
            for (int r = 0; r < 4; ++r) if (kql + 16 * a + r > 0) S[a][r] = NEG_MASK;
    }
    const float pl = max3_raw(max3_raw(max3_raw(S[0][0], S[0][1], S[0][2]), S[0][3], S[1][0]), max2_raw(S[1][1], S[1][2]), S[1][3]);
    if (force || !__all(pl <= DIFF_THR)) {
        const float pmax = xrow16_max(pl);
        float mn = fmaxf(pmax, 0.f);
        if (force) { const float lt = xrow16_sum(l); if (lt == 0.f) mn = pmax; }
        if (pmax < -1e29f) mn = 0.f;
        const float alpha = __builtin_amdgcn_exp2f(-mn);
#pragma unroll
        for (int c = 0; c < 8; ++c) O[c] = O[c] * alpha;
        l *= alpha; m += mn;
#pragma unroll
        for (int a = 0; a < 2; ++a) S[a] = S[a] - mn;
    }
    float ps = 0.f;
#pragma unroll
    for (int a = 0; a < 2; ++a)
#pragma unroll
        for (int r = 0; r < 4; ++r) { const float pv = __builtin_amdgcn_exp2f(S[a][r]); S[a][r] = pv; ps += pv; }
    l += ps;
    u32x4 w; w.x = pkbf(S[0][0], S[0][1]); w.y = pkbf(S[0][2], S[0][3]); w.z = pkbf(S[1][0], S[1][1]); w.w = pkbf(S[1][2], S[1][3]);
    pb = __builtin_bit_cast(bf16x8, w);
}
#ifndef DT2_KQ_EARLY
#define DT2_KQ_EARLY 0
#endif
#define DT2_LOADKQ(HH, X) do { _Pragma("unroll") for (int a = 0; a < 2; ++a) _Pragma("unroll") for (int s = 0; s < 2; ++s) { \
        kf[a][s] = *(const LAS bf16x8*)(kb + kr[X][s] + 256 * (32 * (HH) + 16 * a)); qf[a][s] = *(const LAS bf16x8*)(qb + kr[X][s] + 256 * (16 * a)); } } while (0)
#define DT2_LOADV(DST, HH, C0) do { _Pragma("unroll") for (int c = 0; c < 4; ++c) \
        DST[c] = cat8(tr_read((const LAS unsigned char*)(va[(C0) + c] + 256 * (32 * (HH)))), tr_read((const LAS unsigned char*)(va[(C0) + c] + 256 * (32 * (HH) + 16)))); } while (0)
__device__ __forceinline__ void diff_tile2(bool force, bool diag, f32x4 (&O)[2][2][8], float (&m)[2][2], float (&l)[2][2], const unsigned (&kr)[2][2], unsigned kb, unsigned qb, const unsigned (&va)[8], float slope2, int kq0  ) {
    bf16x8 kf[2][2], qf[2][2];
    DT2_LOADKQ(1, 0);
#pragma unroll
    for (int blk = 0; blk < 4; ++blk) {
        const int hh = 1 - (blk >> 1), x = blk & 1;
        bf16x8 vv[4];
        f32x4 S0[2], S1[2];
        const float b0 = slope2 * (float)(kq0 + 32 * hh) - m[x][0], b1 = slope2 * (float)(kq0 + 32 * hh - 16) - m[x][1];
#pragma unroll
        for (int a = 0; a < 2; ++a)
#pragma unroll
            for (int r = 0; r < 4; ++r) { S0[a][r] = fmaf(slope2, (float)(16 * a + r), b0); S1[a][r] = fmaf(slope2, (float)(16 * a + r), b1); }
        SCHED_FENCE();
#pragma unroll
        for (int a = 0; a < 2; ++a)
#pragma unroll
            for (int s = 0; s < 2; ++s) { S0[a] = mfma16(kf[a][s], qf[0][s], S0[a]); S1[a] = mfma16(kf[a][s], qf[1][s], S1[a]); }
        bf16x8 pb0, pb1;
        SCHED_FENCE();
        DT2_LOADV(vv, hh, 0);
        SCHED_FENCE();
        diff_sm32(force, diag, S0, O[x][0], m[x][0], l[x][0], pb0, kq0 + 32 * hh);
        diff_sm32(force, diag, S1, O[x][1], m[x][1], l[x][1], pb1, kq0 + 32 * hh - 16);
        SCHED_FENCE();
#pragma unroll
        for (int c = 0; c < 4; ++c) { O[x][0][c] = mfma16(vv[c], pb0, O[x][0][c]); O[x][1][c] = mfma16(vv[c], pb1, O[x][1][c]); }
        SCHED_FENCE();
        DT2_LOADV(vv, hh, 4);
        SCHED_FENCE();
#pragma unroll
        for (int c = 0; c < 4; ++c) { O[x][0][4 + c] = mfma16(vv[c], pb0, O[x][0][4 + c]); O[x][1][4 + c] = mfma16(vv[c], pb1, O[x][1][4 + c]); }
        SCHED_FENCE();
        if (blk == 0) DT2_LOADKQ(1, 1); else if (blk == 1) DT2_LOADKQ(0, 0); else if (blk == 2) DT2_LOADKQ(0, 1);
        SCHED_FENCE();
    }
}
#undef DT2_LOADKQ
#undef DT2_LOADV
constexpr int DQ_IMG = 0, DK_RING = 65536, DV_RING = DK_RING + 2 * KV_TILE_BYTES;
__device__ __forceinline__ void diff_unit2(Frame& F, int b, int h, int qb, int layer) {
    const int tid_ = opaque_tid(), lane = tid_ & 63;
    const int wave = F.wave, li = lane & 15, g = lane >> 4;
    const int q0 = 256 * qb, tq0 = q0 + 32 * wave + li;
    const bf16* base = W_PROJ + (size_t)(b * SEQ) * NPROJ;
    const bf16* qp = base + C_DQ + h * HD; const bf16* kp = base + C_DK + h * HD; const bf16* vp = base + C_DV + h * HD; const bf16* gp = base + C_DG + h * HD;
    const float slope2 = ALIBI_SLOPE[h] * LOG2E;
    LAS unsigned char* kring = F.lds + 65536; LAS unsigned char* vring = F.lds + 65536 + 3 * KV_TILE_BYTES; constexpr int DTAB = 65536 + 5 * KV_TILE_BYTES;
    const int jt0 = 4 * qb + 3;
#pragma unroll
    for (int i = 0; i < 8; ++i) { const int row = 32 * wave + 4 * i + (lane >> 4), slot = lane & 15;
        glds16(qp + (size_t)(q0 + row) * NPROJ + 8 * (slot ^ swz_k(row)), (unsigned)(size_t)(F.lds + DQ_IMG + 1024 * (8 * wave + i))); }
    unsigned dmo[4]; kv_dma_offsets(dmo, wave, lane);
    k_dma(kring, kp, 64 * jt0, wave, dmo); v_dma(vring, vp, 64 * jt0, wave, dmo); k_dma(kring + KV_TILE_BYTES, kp, 64 * (jt0 - 1), wave, dmo);
    f32x4 O[2][2][8]; float m[2][2], l[2][2];
#pragma unroll
    for (int x = 0; x < 2; ++x)
#pragma unroll
        for (int u = 0; u < 2; ++u) { m[x][u] = 0.f; l[x][u] = 0.f;
#pragma unroll
            for (int c = 0; c < 8; ++c) O[x][u][c] = (f32x4){0.f, 0.f, 0.f, 0.f}; }
    unsigned kr[2][2], va[8];
    {   const int q = li >> 2, p = lane & 3; const unsigned vb = (unsigned)(size_t)vring;
#pragma unroll
        for (int x = 0; x < 2; ++x)
#pragma unroll
            for (int s = 0; s < 2; ++s) kr[x][s] = 256 * li + 16 * ((8 * x + 4 * s + g) ^ swz_k(li));
#pragma unroll
        for (int c = 0; c < 8; ++c) va[c] = vb + 256 * (4 * g + q) + 16 * ((2 * c + (p >> 1)) ^ swz_v(4 * g + q)) + 8 * (p & 1); }
    const unsigned qbase = (unsigned)(size_t)(F.lds + DQ_IMG) + 256 * 32 * wave;
    LAS f32x4* qnp = (LAS f32x4*)(F.lds + DTAB) + tid_; LAS float* kprep = (LAS float*)(F.lds + DTAB + 8192 + 512 * wave);
    const bool canskip = ALIBI_SLOPE[h] * LOG2E * (float)SEQ > 200.0f;
    {   if (canskip) {
            gu32* cnt = W_CTL + CW_PRE + layer * 64; unsigned spins = 0;
            while (__builtin_amdgcn_readfirstlane(__hip_atomic_load(cnt, RLX_AGENT)) < (unsigned)(BATCH * N_DIFF * 128) && ++spins < (1u << 22)) __builtin_amdgcn_s_sleep(2);
            gu32* tm = W_CTL + CW_TMAX + layer * TMAX_LAYER + ((b * N_DIFF + h) * 2) * 64;
#pragma unroll
            for (int x = 0; x < 2; ++x) kprep[x * 64 + lane] = wave_prefix_max(sqrtf(__uint_as_float(__hip_atomic_load(tm + x * 64 + lane, RLX_AGENT))));
        }
        asm volatile("s_waitcnt vmcnt(0)" ::: "memory");
        f32x4 qv;
#pragma unroll
        for (int x = 0; x < 2; ++x)
#pragma unroll
            for (int u = 0; u < 2; ++u) { float s2 = 0.f;
#pragma unroll
                for (int s = 0; s < 2; ++s) { const u32x4 w = *(const LAS u32x4*)(qbase + kr[x][s] + 256 * (16 * u));
#pragma unroll
                    for (int j = 0; j < 4; ++j) { const float lo = bf_lo(w[j]), hi = bf_hi(w[j]); s2 = fmaf(lo, lo, s2); s2 = fmaf(hi, hi, s2); } }
                qv[2 * x + u] = sqrtf(xrow16_sum(s2)); }
        *qnp = qv;
    }
    int slot = 0, kslot = 0;
    bool first = true;
    for (int jt = jt0; jt >= 0; --jt) {
        if (jt >= 1) asm volatile("s_waitcnt vmcnt(2)\n\ts_barrier" ::: "memory"); else asm volatile("s_waitcnt vmcnt(0)\n\ts_barrier" ::: "memory");
        if (jt != jt0) {
            unsigned alld = 1u;
#pragma unroll
            for (int w = 0; w < 8; ++w) alld &= F.MISC[8 + 8 * (slot ^ 1) + w];
            if (__builtin_amdgcn_readfirstlane((int)alld)) break;
        }
        if (jt >= 1) v_dma(vring + (slot ^ 1) * KV_TILE_BYTES, vp, 64 * (jt - 1), wave, dmo);
        if (jt >= 2) k_dma(kring + (kslot == 0 ? 2 : kslot - 1) * KV_TILE_BYTES, kp, 64 * (jt - 2), wave, dmo);
        const int k0 = 64 * jt;
        if (k0 <= q0 + 32 * wave + 31) {
            const int kq0 = k0 + 4 * g - tq0;
            diff_tile2(first, k0 + 63 > q0 + 32 * wave, O, m, l, kr, (unsigned)(size_t)kring + kslot * KV_TILE_BYTES, qbase, va, slope2, kq0);
            first = false;
        }
        {
            bool wdone = false;
            if (canskip && !first && jt >= 1) {
                bool dn = true; const f32x4 qv = *qnp;
#pragma unroll
                for (int x = 0; x < 2; ++x) { const float kmx = kprep[x * 64 + jt - 1];
#pragma unroll
                    for (int u = 0; u < 2; ++u) dn = dn && (fmaf(qv[2 * x + u], kmx, slope2 * (float)(64 * jt - 1 - (tq0 + 16 * u))) - m[x][u] < -152.0f); }
                wdone = __all(dn);
            }
            if (lane == 0) F.MISC[8 + 8 * slot + wave] = wdone ? 1u : 0u;
        }
        {   const int dl = slot ? -KV_TILE_BYTES : KV_TILE_BYTES;
#pragma unroll
            for (int c = 0; c < 8; ++c) va[c] += dl; }
        slot ^= 1; kslot = kslot == 2 ? 0 : kslot + 1;
    }
    const float lam = __uint_as_float(F.MISC[5]);
    const float* gain = A_DIFFG + layer * DIFF_W + h * HD;
    int ge = g; asm volatile("" : "+v"(ge));
#pragma unroll
    for (int u = 0; u < 2; ++u) {
        const float l1 = xrow16_sum(l[0][u]), l2 = xrow16_sum(l[1][u]);
        const float c1 = 1.0f / l1, c2 = lam / l2;
        float ss = 0.f;
#pragma unroll
        for (int c = 0; c < 8; ++c)
#pragma unroll
            for (int r = 0; r < 4; ++r) { const float o = O[0][u][c][r] * c1 - O[1][u][c][r] * c2; O[0][u][c][r] = o; ss += o * o; }
        ss = xrow16_sum(ss);
        const float rstd = 1.0f / sqrtf(ss * (1.0f / HD) + LN_EPS) * (1.0f - LAMBDA_INIT[layer]);
        int tq = tq0 + 16 * u; asm volatile("" : "+v"(tq));
        const bf16* grow = gp + (size_t)tq * NPROJ;
        bf16* orow = W_MIX + (size_t)(b * SEQ + tq) * DM + MX_DIFF + h * HD;
#pragma unroll
        for (int c = 0; c < 8; ++c) { const int d = 16 * c + 4 * ge;
            const u32x2 gw = *(const GAS u32x2*)(grow + d); const f32x4 gn = *(const GAS f32x4*)(gain + d);
            const float y0 = O[0][u][c][0] * rstd * gn.x * silu_f(bf_lo(gw.x)), y1 = O[0][u][c][1] * rstd * gn.y * silu_f(bf_hi(gw.x));
            const float y2 = O[0][u][c][2] * rstd * gn.z * silu_f(bf_lo(gw.y)), y3 = O[0][u][c][3] * rstd * gn.w * silu_f(bf_hi(gw.y));
            u32x2 w; w.x = pkbf(y0, y1); w.y = pkbf(y2, y3); *(GAS u32x2*)(orow + d) = w;
            if (c & 1) asm volatile("" ::: "memory"); }
    }
    asm volatile("s_waitcnt vmcnt(0)" ::: "memory");
}

__device__ __forceinline__ float xor_partner(float own, unsigned s0, unsigned s1) { return __uint_as_float(s0 ^ s1 ^ __float_as_uint(own)); }
__device__ __forceinline__ void sb_group32(bool diag, f32x4 (&S)[2], float& R, bf16x8& pb, int kq  , int g) {
    float u[2][4], be[2][4];
#pragma unroll
    for (int a = 0; a < 2; ++a)
#pragma unroll
        for (int r = 0; r < 4; ++r) { const float e = __builtin_amdgcn_exp2f(S[a][r]); const float uu = __builtin_amdgcn_rcpf(1.0f + e); u[a][r] = uu; be[a][r] = e * uu; }
    if (diag) {
        int kql = kq; asm volatile("" : "+v"(kql));
#pragma unroll
        for (int a = 0; a < 2; ++a)
#pragma unroll
            for (int r = 0; r < 4; ++r) if (kql + 16 * a + r >= 0) { u[a][r] = 1.0f; be[a][r] = 0.f; }
    }
    float w[2][4], T[2];
#pragma unroll
    for (int a = 0; a < 2; ++a) { w[a][3] = 1.0f; w[a][2] = u[a][3]; w[a][1] = w[a][2] * u[a][2]; w[a][0] = w[a][1] * u[a][1]; T[a] = w[a][0] * u[a][0]; }
    float G[2], Tot[2];
#pragma unroll
    for (int a = 0; a < 2; ++a) {
        auto s = __builtin_amdgcn_permlane16_swap(__float_as_uint(T[a]), __float_as_uint(T[a]), false, false);
        const float pt = xor_partner(T[a], s[0], s[1]), pp = T[a] * pt;
        auto t = __builtin_amdgcn_permlane32_swap(__float_as_uint(pp), __float_as_uint(pp), false, false);
        const float po = xor_partner(pp, t[0], t[1]);
        G[a] = ((g & 1) ? 1.0f : pt) * ((g < 2) ? po : 1.0f); Tot[a] = pp * po; }
    const float c1 = R * G[1], c0 = R * Tot[1] * G[0];
#pragma unroll
    for (int r = 0; r < 4; ++r) { S[1][r] = be[1][r] * (c1 * w[1][r]); S[0][r] = be[0][r] * (c0 * w[0][r]); }
    R = R * Tot[1] * Tot[0];
    u32x4 pw; pw.x = pkbf(S[0][0], S[0][1]); pw.y = pkbf(S[0][2], S[0][3]); pw.z = pkbf(S[1][0], S[1][1]); pw.w = pkbf(S[1][2], S[1][3]);
    pb = __builtin_bit_cast(bf16x8, pw);
}
__device__ __forceinline__ void sb_unit2(Frame& F, int b, int h, int qb) {
    const int tid_ = opaque_tid(), lane = tid_ & 63;
    const int wave = F.wave, li = lane & 15, g = lane >> 4;
    const int q0 = 256 * qb, tq0 = q0 + 32 * wave + li;
    const bf16* base = W_PROJ + (size_t)(b * SEQ) * NPROJ;
    const bf16* qp = base + C_SQ + h * HD; const bf16* kp = base + C_SK + h * HD; const bf16* vp = base + C_SV + h * HD; const bf16* gp = base + C_SG + h * HD;
    LAS unsigned char* kring = F.lds + DK_RING; LAS unsigned char* vring = F.lds + DV_RING;
    const int jt0 = 4 * qb + 3;
#pragma unroll
    for (int i = 0; i < 8; ++i) { const int row = 32 * wave + 4 * i + (lane >> 4), slot = lane & 15;
        glds16(qp + (size_t)(q0 + row) * NPROJ + 8 * (slot ^ swz_k(row)), (unsigned)(size_t)(F.lds + DQ_IMG + 1024 * (8 * wave + i))); }
    unsigned dmo[4]; kv_dma_offsets(dmo, wave, lane);
    kv_dma(kring, vring, kp, vp, 64 * jt0, wave, dmo);
    f32x4 O[2][8]; float R[2] = {1.0f, 1.0f};
#pragma unroll
    for (int u = 0; u < 2; ++u)
#pragma unroll
        for (int c = 0; c < 8; ++c) O[u][c] = (f32x4){0.f, 0.f, 0.f, 0.f};
    unsigned kr[4], va[8];
    {   const int q = li >> 2, p = lane & 3; const unsigned vb = (unsigned)(size_t)vring;
#pragma unroll
        for (int s = 0; s < 4; ++s) kr[s] = 256 * li + 16 * ((4 * s + g) ^ swz_k(li));
#pragma unroll
        for (int c = 0; c < 8; ++c) va[c] = vb + 256 * (4 * g + q) + 16 * ((2 * c + (p >> 1)) ^ swz_v(4 * g + q)) + 8 * (p & 1); }
    const unsigned qbase = (unsigned)(size_t)(F.lds + DQ_IMG) + 256 * 32 * wave;
    asm volatile("s_waitcnt vmcnt(0)" ::: "memory");
    bf16x8 qf[2][4];
#pragma unroll
    for (int u = 0; u < 2; ++u)
#pragma unroll
        for (int s = 0; s < 4; ++s) qf[u][s] = *(const LAS bf16x8*)(qbase + kr[s] + 256 * (16 * u));
    int slot = 0; bool started = false;
    for (int jt = jt0; jt >= 0; --jt) {
        asm volatile("s_waitcnt vmcnt(0)\n\ts_barrier" ::: "memory");
        if (jt != jt0) {
            unsigned alld = 1u;
#pragma unroll
            for (int w = 0; w < 8; ++w) alld &= F.MISC[8 + 8 * (slot ^ 1) + w];
            if (__builtin_amdgcn_readfirstlane((int)alld)) break;
        }
        if (jt >= 1) kv_dma(kring + (slot ^ 1) * KV_TILE_BYTES, vring + (slot ^ 1) * KV_TILE_BYTES, kp, vp, 64 * (jt - 1), wave, dmo);
        const int k0 = 64 * jt;
        if (k0 <= q0 + 32 * wave + 30) {
            const bool diag = (k0 + 63 >= q0 + 32 * wave);
            const unsigned kb = (unsigned)(size_t)kring + slot * KV_TILE_BYTES;
            const int kq0 = k0 + 4 * g - tq0;
#pragma unroll
            for (int hh = 1; hh >= 0; --hh) {
                f32x4 S0[2], S1[2];
#pragma unroll
                for (int a = 0; a < 2; ++a) { S0[a] = (f32x4){0.f, 0.f, 0.f, 0.f}; S1[a] = (f32x4){0.f, 0.f, 0.f, 0.f};
#pragma unroll
                    for (int s = 0; s < 4; ++s) { const bf16x8 kf = *(const LAS bf16x8*)(kb + kr[s] + 256 * (32 * hh + 16 * a)); S0[a] = mfma16(kf, qf[0][s], S0[a]); S1[a] = mfma16(kf, qf[1][s], S1[a]); } }
                SCHED_FENCE();
                bf16x8 vv[4];
#pragma unroll
                for (int c = 0; c < 4; ++c) vv[c] = cat8(tr_read((const LAS unsigned char*)(va[c] + 256 * (32 * hh))), tr_read((const LAS unsigned char*)(va[c] + 256 * (32 * hh + 16))));
                SCHED_FENCE();
                bf16x8 pb0, pb1;
                sb_group32(diag, S0, R[0], pb0, kq0 + 32 * hh, g);
                sb_group32(diag, S1, R[1], pb1, kq0 + 32 * hh - 16, g);
                SCHED_FENCE();
#pragma unroll
                for (int c = 0; c < 4; ++c) { O[0][c] = mfma16(vv[c], pb0, O[0][c]); O[1][c] = mfma16(vv[c], pb1, O[1][c]); }
                SCHED_FENCE();
#pragma unroll
                for (int c = 0; c < 4; ++c) vv[c] = cat8(tr_read((const LAS unsigned char*)(va[4 + c] + 256 * (32 * hh))), tr_read((const LAS unsigned char*)(va[4 + c] + 256 * (32 * hh + 16))));
                SCHED_FENCE();
#pragma unroll
                for (int c = 0; c < 4; ++c) { O[0][4 + c] = mfma16(vv[c], pb0, O[0][4 + c]); O[1][4 + c] = mfma16(vv[c], pb1, O[1][4 + c]); }
                SCHED_FENCE();
            }
            started = true;
        }
        {   const bool wdone = started && __all(R[0] == 0.f && R[1] == 0.f);
            if (lane == 0) F.MISC[8 + 8 * slot + wave] = wdone ? 1u : 0u; }
        {   const int dl = slot ? -KV_TILE_BYTES : KV_TILE_BYTES;
#pragma unroll
            for (int c = 0; c < 8; ++c) va[c] += dl; }
        slot ^= 1;
    }
    int ge = g; asm volatile("" : "+v"(ge));
#pragma unroll
    for (int u = 0; u < 2; ++u) {
        int tq = tq0 + 16 * u; asm volatile("" : "+v"(tq));
        const bf16* grow = gp + (size_t)tq * NPROJ;
        bf16* orow = W_MIX + (size_t)(b * SEQ + tq) * DM + MX_SB + h * HD;
#pragma unroll
        for (int c = 0; c < 8; ++c) { const int d = 16 * c + 4 * ge;
            const u32x2 gw = *(const GAS u32x2*)(grow + d);
            const float y0 = O[u][c][0] * silu_f(bf_lo(gw.x)), y1 = O[u][c][1] * silu_f(bf_hi(gw.x)), y2 = O[u][c][2] * silu_f(bf_lo(gw.y)), y3 = O[u][c][3] * silu_f(bf_hi(gw.y));
            u32x2 w; w.x = pkbf(y0, y1); w.y = pkbf(y2, y3); *(GAS u32x2*)(orow + d) = w; }
    }
    asm volatile("s_waitcnt vmcnt(0)" ::: "memory");
}

constexpr int R_KIMG = 0, R_VIMG = IMG128, R_SIMG = 2 * IMG128, R_GTAB = 4 * IMG128;
__device__ __forceinline__ void ret_unit2(Frame& F, int b, int h, int layer) {
    const int tid = opaque_tid(), lane = tid & 63;
    int wave = F.wave; asm volatile("" : "+s"(wave));
    const int li = lane & 15, g = lane >> 4, q = li >> 2, p = lane & 3;
    const float lg2 = RET_LOG_GAMMA[h] * LOG2E;
    const float kscale = 0.08838834764831845f;
    const float cdecay = __builtin_amdgcn_exp2f(lg2 * 128.f);
    const bf16* base = W_PROJ + (size_t)(b * SEQ) * NPROJ;
    const bf16* qp = base + C_RQ + h * HD; const bf16* kp = base + C_RK + h * HD; const bf16* vp = base + C_RV + h * HD; const bf16* gp = base + C_RG + h * HD;
    float dl[4];
#pragma unroll
    for (int r = 0; r < 4; ++r) dl[r] = kscale * __builtin_amdgcn_exp2f(lg2 * (float)(li - 4 * g - r));
    const float qd = __builtin_amdgcn_exp2f(lg2 * (float)(16 * wave + li + 1));
    const unsigned lds0 = (unsigned)(size_t)F.lds;
    const unsigned a_row = lds0 + li * RS + 16 * g;
    const unsigned a_tra = lds0 + (4 * g + q) * RS + 8 * p;
    const unsigned a_trn = lds0 + (8 * g + q) * RS + 8 * p;
    LAS float* gtab = (LAS float*)(F.lds + R_GTAB);
    if (tid < HD) gtab[tid] = A_RETG[layer * RET_W + h * HD + tid];
    LAS float* kdt = gtab + 128; LAS float* g16 = gtab + 256;
    if (tid < 128) kdt[tid] = kscale * __builtin_amdgcn_exp2f(lg2 * (float)(127 - tid));
    if (tid < 8) g16[tid] = __builtin_amdgcn_exp2f(lg2 * (float)(16 * tid));
    u32x4 stK[4], stV[4];
#pragma unroll
    for (int i = 0; i < 4; ++i) { const int id = tid + 512 * i; const unsigned so = (unsigned)(id >> 4) * (NPROJ * 2) + 16 * (id & 15);
        stK[i] = *(const GAS u32x4*)((const char*)kp + so); stV[i] = *(const GAS u32x4*)((const char*)vp + so); }
    f32x4 ST[8];
#pragma unroll
    for (int d = 0; d < 8; ++d) ST[d] = (f32x4){0.f, 0.f, 0.f, 0.f};
    bf16x8 q0f, q1f, q2f, q3f;
    {   const size_t qrow = (size_t)(16 * wave + li) * NPROJ;
        q0f = *(const GAS bf16x8*)(qp + qrow + 8 * g); q1f = *(const GAS bf16x8*)(qp + qrow + 32 + 8 * g); q2f = *(const GAS bf16x8*)(qp + qrow + 64 + 8 * g); q3f = *(const GAS bf16x8*)(qp + qrow + 96 + 8 * g); }
#pragma unroll
    for (int i = 0; i < 4; ++i) { const int id = lane + 64 * i; *(LAS u32x4*)(lds0 + R_SIMG + (16 * wave + (id >> 4)) * RS + 16 * (id & 15)) = (u32x4){0u, 0u, 0u, 0u}; }
    asm volatile("" : "+v"(stK[0]), "+v"(stK[1]), "+v"(stK[2]), "+v"(stK[3]), "+v"(stV[0]), "+v"(stV[1]), "+v"(stV[2]), "+v"(stV[3]));
    for (int c = 0; c < SEQ / 128; ++c) {
        const int t0 = 128 * c;
        const int tl = opaque_tid(), li2 = tl & 15, g2 = (tl & 63) >> 4;
        asm volatile("s_barrier" ::: "memory");
#pragma unroll
        for (int i = 0; i < 4; ++i) { const int id = tl + 512 * i, row = id >> 4, sl = id & 15; *(LAS u32x4*)(lds0 + R_KIMG + row * RS + 16 * sl) = stK[i]; *(LAS u32x4*)(lds0 + R_VIMG + row * RS + 16 * sl) = stV[i]; }
        asm volatile("" ::: "memory");
        const size_t qrow = (size_t)(t0 + 16 * wave + li2) * NPROJ;
        const int tn = 128 * (c + 1);
        if (c + 1 < SEQ / 128) {
            const char* kn = (const char*)(kp + (size_t)tn * NPROJ); const char* vn = (const char*)(vp + (size_t)tn * NPROJ);
#pragma unroll
            for (int i = 0; i < 4; ++i) { const int id = tl + 512 * i; const unsigned so = (unsigned)(id >> 4) * (NPROJ * 2) + 16 * (id & 15); stK[i] = *(const GAS u32x4*)(kn + so); stV[i] = *(const GAS u32x4*)(vn + so); }
        }
        asm volatile("s_waitcnt lgkmcnt(0)\n\ts_barrier" ::: "memory");
        const int scur = R_SIMG + IMG128 * (c & 1), snxt = R_SIMG + IMG128 * ((c & 1) ^ 1);
#define R2_TRN(DST, IMG, KS, CT) DST = cat8(tr_read((const LAS unsigned char*)(a_trn + (IMG) + 32 * (KS) * RS + 32 * (CT))), tr_read((const LAS unsigned char*)(a_trn + (IMG) + 32 * (KS) * RS + 32 * (CT) + 4 * RS)))
#define R2_TRA(DST, IMG, KS, CT) DST = cat8(tr_read((const LAS unsigned char*)(a_tra + (IMG) + 32 * (KS) * RS + 32 * (CT))), tr_read((const LAS unsigned char*)(a_tra + (IMG) + 32 * (KS) * RS + 32 * (CT) + 16 * RS)))
#define R2_ROW(DST, IMG, RT, S4) DST = *(const LAS bf16x8*)(a_row + (IMG) + 16 * (RT) * RS + 64 * (S4))
#define R2_PIPE(NB, LOADF, MMAF) do { bf16x8 fa[4], fb[4]; LOADF(fa, 0); _Pragma("unroll") for (int bt = 0; bt < (NB); bt += 2) { \
            if (bt + 1 < (NB)) LOADF(fb, bt + 1); SCHED_FENCE(); MMAF(fa, bt); SCHED_FENCE(); \
            if (bt + 1 < (NB)) { if (bt + 2 < (NB)) LOADF(fa, bt + 2); SCHED_FENCE(); MMAF(fb, bt + 1); SCHED_FENCE(); } } } while (0)
        {   bf16x8 vfd[4];
            {   bf16x8 vn[4];
#pragma unroll
                for (int ks = 0; ks < 4; ++ks) R2_TRN(vn[ks], R_VIMG, ks, wave);
#pragma unroll
                for (int ks = 0; ks < 4; ++ks) { u32x4 w; const u32x4 vw = __builtin_bit_cast(u32x4, vn[ks]);
                    const f32x4 kd0 = *(const LAS f32x4*)(kdt + 32 * ks + 8 * g), kd1 = *(const LAS f32x4*)(kdt + 32 * ks + 8 * g + 4);
                    w[0] = pkbf(bf_lo(vw[0]) * kd0.x, bf_hi(vw[0]) * kd0.y); w[1] = pkbf(bf_lo(vw[1]) * kd0.z, bf_hi(vw[1]) * kd0.w);
                    w[2] = pkbf(bf_lo(vw[2]) * kd1.x, bf_hi(vw[2]) * kd1.y); w[3] = pkbf(bf_lo(vw[3]) * kd1.z, bf_hi(vw[3]) * kd1.w);
                    vfd[ks] = __builtin_bit_cast(bf16x8, w); } }
#pragma unroll
            for (int dt = 0; dt < 8; ++dt) ST[dt] = ST[dt] * cdecay;
            SCHED_FENCE();
#define R2_LD_ST(F, BT) do { _Pragma("unroll") for (int ks = 0; ks < 4; ++ks) R2_TRN(F[ks], R_KIMG, ks, (BT)); } while (0)
#define R2_MM_ST(F, BT) do { _Pragma("unroll") for (int ks = 0; ks < 4; ++ks) ST[(BT)] = mfma16(vfd[ks], F[ks], ST[(BT)]); } while (0)
            R2_PIPE(8, R2_LD_ST, R2_MM_ST);
#pragma unroll
            for (int dt = 0; dt < 8; ++dt)
#pragma unroll
                for (int r = 0; r < 4; ++r) *(LAS unsigned short*)(lds0 + (16 * wave + 4 * g2) * RS + 2 * li2 + snxt + r * RS + 32 * dt) = (unsigned short)(pkbf(ST[dt][r], 0.f) & 0xffffu);
        }
        SCHED_FENCE();
        f32x4 OUT[8];
#define R2_LD_CR(F, BT) do { _Pragma("unroll") for (int s = 0; s < 4; ++s) R2_ROW(F[s], scur, (BT), s); } while (0)
#define R2_MM_CR(F, BT) do { f32x4 acc = (f32x4){0.f, 0.f, 0.f, 0.f}; acc = mfma16(F[0], q0f, acc); acc = mfma16(F[1], q1f, acc); acc = mfma16(F[2], q2f, acc); acc = mfma16(F[3], q3f, acc); OUT[(BT)] = acc * qd; } while (0)
        R2_PIPE(8, R2_LD_CR, R2_MM_CR);
        SCHED_FENCE();
        bf16x8 pb[4];
        {   unsigned pk[8][2];
#define R2_LD_SC(F, BT) do { if ((BT) <= wave) { _Pragma("unroll") for (int s = 0; s < 4; ++s) R2_ROW(F[s], R_KIMG, (BT), s); } } while (0)
#define R2_MM_SC(F, BT) do { if ((BT) <= wave) { f32x4 S = (f32x4){0.f, 0.f, 0.f, 0.f}; S = mfma16(F[0], q0f, S); S = mfma16(F[1], q1f, S); S = mfma16(F[2], q2f, S); S = mfma16(F[3], q3f, S); \
                const float dtf = g16[wave - (BT)]; _Pragma("unroll") for (int r = 0; r < 4; ++r) { const float v = S[r] * (dl[r] * dtf); S[r] = ((BT) < wave || li - 4 * g - r >= 0) ? v : 0.f; } \
                pk[(BT)][0] = pkbf(S[0], S[1]); pk[(BT)][1] = pkbf(S[2], S[3]); } else { pk[(BT)][0] = 0u; pk[(BT)][1] = 0u; } } while (0)
            R2_PIPE(8, R2_LD_SC, R2_MM_SC);
#pragma unroll
            for (int ks = 0; ks < 4; ++ks) { u32x4 w; w.x = pk[2 * ks][0]; w.y = pk[2 * ks][1]; w.z = pk[2 * ks + 1][0]; w.w = pk[2 * ks + 1][1]; pb[ks] = __builtin_bit_cast(bf16x8, w); }
        }
        SCHED_FENCE();
        u32x2 gc[8];
#pragma unroll
        for (int et = 0; et < 8; ++et) gc[et] = *(const GAS u32x2*)(gp + qrow + 16 * et + 4 * g2);
        if (c + 1 < SEQ / 128) { const size_t qn = (size_t)(tn + 16 * wave + li2) * NPROJ;
            q0f = *(const GAS bf16x8*)(qp + qn + 8 * g2); q1f = *(const GAS bf16x8*)(qp + qn + 32 + 8 * g2); q2f = *(const GAS bf16x8*)(qp + qn + 64 + 8 * g2); q3f = *(const GAS bf16x8*)(qp + qn + 96 + 8 * g2); }
        SCHED_FENCE();
#define R2_LD_IN(F, BT) do { if (2 * ((BT) >> 1) <= wave) { _Pragma("unroll") for (int e4 = 0; e4 < 4; ++e4) R2_TRA(F[e4], R_VIMG, (BT) >> 1, 4 * ((BT) & 1) + e4); } } while (0)
#define R2_MM_IN(F, BT) do { if (2 * ((BT) >> 1) <= wave) { _Pragma("unroll") for (int e4 = 0; e4 < 4; ++e4) OUT[4 * ((BT) & 1) + e4] = mfma16(F[e4], pb[(BT) >> 1], OUT[4 * ((BT) & 1) + e4]); } } while (0)
        R2_PIPE(8, R2_LD_IN, R2_MM_IN);
#undef R2_LD_ST
#undef R2_MM_ST
#undef R2_LD_CR
#undef R2_MM_CR
#undef R2_LD_SC
#undef R2_MM_SC
#undef R2_LD_IN
#undef R2_MM_IN
#undef R2_PIPE
#undef R2_TRN
#undef R2_TRA
#undef R2_ROW
        SCHED_FENCE();
        {   float s1 = 0.f, s2 = 0.f;
#pragma unroll
            for (int et = 0; et < 8; ++et)
#pragma unroll
                for (int r = 0; r < 4; ++r) { s1 += OUT[et][r]; s2 = fmaf(OUT[et][r], OUT[et][r], s2); }
            s1 = xrow16_sum(s1); s2 = xrow16_sum(s2);
            const float mean = s1 * (1.0f / HD), var = fmaxf(s2 * (1.0f / HD) - mean * mean, 0.f), rstd = 1.0f / sqrtf(var + LN_EPS);
            asm volatile("" : "+v"(stK[0]), "+v"(stK[1]), "+v"(stK[2]), "+v"(stK[3]), "+v"(stV[0]), "+v"(stV[1]), "+v"(stV[2]), "+v"(stV[3]));
            bf16* orow = W_MIX + (size_t)(b * SEQ + t0 + 16 * wave + li2) * DM + MX_RET + h * HD + 4 * g2;
#pragma unroll
            for (int et = 0; et < 8; ++et) {
                const f32x4 gv = *(const LAS f32x4*)(gtab + 16 * et + 4 * g);
                const float y0 = (OUT[et][0] - mean) * rstd * gv.x * silu_f(bf_lo(gc[et].x)), y1 = (OUT[et][1] - mean) * rstd * gv.y * silu_f(bf_hi(gc[et].x));
                const float y2 = (OUT[et][2] - mean) * rstd * gv.z * silu_f(bf_lo(gc[et].y)), y3 = (OUT[et][3] - mean) * rstd * gv.w * silu_f(bf_hi(gc[et].y));
                u32x2 w; w.x = pkbf(y0, y1); w.y = pkbf(y2, y3); *(GAS u32x2*)(orow + 16 * et) = w; }
        }
    }
    asm volatile("s_waitcnt vmcnt(0) lgkmcnt(0)" ::: "memory");
}

__global__ void __launch_bounds__(NWAVES * 64, 2) mk_fwd(Args kernel_args  ) {
    extern __shared__ __attribute__((aligned(16))) unsigned char lds_raw[];
    Frame F;
    F.lds = (LAS unsigned char*)lds_raw;
    F.MISC = (volatile LAS unsigned*)(F.lds + MISC_OFF);
    F.wave = __builtin_amdgcn_readfirstlane((int)threadIdx.x >> 6);
    for (int u = F.wave * 64 + opaque_lane(); u < (LDS_BYTES - MISC_OFF) / 4; u += NWAVES * 64) F.MISC[u] = 0u;
    __syncthreads();
    XcdBarrier bar = xcd_barrier_post((unsigned*)(W_CTL + CW_BAR), F.MISC, (unsigned)F.wave);
#define GRID_BAR() do { XcdBarrier b_ = bar; asm volatile("" : "+s"(b_.bar), "+s"(b_.x)); xcd_barrier(b_); } while (0)

    p0_prologue(F);
    GRID_BAR();

    for (int layer = 0; layer < DEPTH; ++layer) {
        {   pg8::Gemm g{W_XB, W_WINT + (size_t)layer * NPROJ * DM, M, NPROJ, DM}; pg8::StaticOrder S; int c_ = (int)blockIdx.x; asm volatile("" : "+s"(c_)); S.init(M, NPROJ, (int)gridDim.x, c_);
            pg8::EpiBf16 E{W_PROJ, NPROJ, C_DQ / 256, (C_DQ + DIFF_W) / 256, 0.125f * LOG2E, C_SQ / 256, (C_SQ + SB_W) / 256, 0.08838834764831845f * LOG2E, F.lds + pg8::STAGE_BYTES};
            pg8::gemm_phase<pg8::EpiBf16, pg8::StaticOrder, true, true>(F.lds, g, S, E, F.wave); }
        GRID_BAR();
        {   if (F.wave == 0) {
                const int ln = opaque_lane();
                const float a = A_LQ1[layer * 64 + ln] * A_LK1[layer * 64 + ln], c = A_LQ2[layer * 64 + ln] * A_LK2[layer * 64 + ln];
                const float lam = __expf(wave_sum(a)) - __expf(wave_sum(c)) + LAMBDA_INIT[layer];
                if (ln == 0) F.MISC[5] = __float_as_uint(lam); }
            gu32* qh = W_CTL + CW_Q + layer * 16 * 64;
            const int wg = (int)blockIdx.x;
            if (wg < BATCH * N_RET) { knorm_prepass(F, layer, F.wave); __syncthreads(); ret_unit2(F, wg / N_RET, wg % N_RET, layer); }
            {   constexpr int ND = BATCH * N_DIFF * (SEQ / 256), NSTAT = 256 - BATCH * N_RET;
                int u = wg >= BATCH * N_RET ? wg - BATCH * N_RET : NSTAT + next_unit(F, qh + 4 * 64);
                while (u < ND) { __syncthreads(); const int oc = DIFF_ORDER[u >> 2]; diff_unit2(F, u & 3, oc & 15, oc >> 4, layer); u = NSTAT + next_unit(F, qh + 4 * 64); } }
            {   constexpr int NSB = BATCH * N_SB * (SEQ / 256);
                int u = wg;
                while (u < NSB) { __syncthreads(); const int qb = SEQ / 256 - 1 - u / (BATCH * N_SB), bh = u % (BATCH * N_SB); sb_unit2(F, bh / N_SB, bh % N_SB, qb); u = 256 + next_unit(F, qh + 8 * 64); } }
        }
        GRID_BAR();
        {   pg8::Gemm g{W_MIX, W_WOUTT + (size_t)layer * DM * DM, M, DM, DM}; pg8::PanelOrder S; int c_ = (int)blockIdx.x; asm volatile("" : "+s"(c_)); S.init(M, c_);
            const float* xin = layer == 0 ? A_X : (const float*)((layer - 1) & 1 ? W_H : W_XH);
            float* xout = layer == DEPTH - 1 ? args.out : ((layer & 1) ? W_H : W_XH);
            pg8::EpiLnFused E{xin, xout, layer == DEPTH - 1 ? (bf16*)nullptr : W_XB, DM, DEEPNORM_ALPHA, A_LNG + layer * DM, A_LNB + layer * DM,
                              (unsigned long long*)(args.ws + WS_SLOTS), (unsigned*)(W_CTL + CW_LNC + layer * 64 * 64), (unsigned*)(W_CTL + CW_TMO), F.lds + 131072, F.wave};
            pg8::gemm_phase<pg8::EpiLnFused, pg8::PanelOrder, true, true>(F.lds, g, S, E, F.wave); }
        if (layer != DEPTH - 1) GRID_BAR();
    }
#undef GRID_BAR
}

extern "C" void kernel_launch(void* const* d_in, const int* in_sizes, int n_in, void* d_out, int out_size, void* d_ws, size_t ws_size, hipStream_t stream) {
    static int grid = 0;
    if (grid == 0) {
        if (n_in != 11 || in_sizes[0] != M * DM || out_size != M * DM || ws_size < WS_END) { fprintf(stderr, "kernel_launch: unexpected shapes (n_in %d, in0 %d, out %d, ws %zu); nothing launched\n", n_in, n_in > 0 ? in_sizes[0] : -1, out_size, ws_size); grid = -1; return; }
        int dev = 0, cus = 0, per_cu = 0;
        if (hipGetDevice(&dev) != hipSuccess || hipDeviceGetAttribute(&cus, hipDeviceAttributeMultiprocessorCount, dev) != hipSuccess) { grid = -1; return; }
        if (hipFuncSetAttribute((const void*)mk_fwd, hipFuncAttributeMaxDynamicSharedMemorySize, LDS_BYTES) != hipSuccess) { fprintf(stderr, "kernel_launch: hipFuncSetAttribute failed\n"); grid = -1; return; }
        if (hipOccupancyMaxActiveBlocksPerMultiprocessor(&per_cu, (const void*)mk_fwd, NWAVES * 64, LDS_BYTES) != hipSuccess || per_cu < 1) { fprintf(stderr, "kernel_launch: occupancy query reports %d workgroups per CU\n", per_cu); }
        (void)hipGetLastError();
        grid = cus;
        if (grid != 256) { fprintf(stderr, "kernel_launch: this build's fused output projection + LayerNorm needs exactly 256 workgroups (a 256-CU MI355X); found %d CUs; nothing launched\n", cus); grid = -1; return; }
    }
    if (grid < 0) return;
    if (hipMemsetAsync((char*)d_ws + WS_CTL, 0, CTL_ZERO_BYTES, stream) != hipSuccess) return;
    Args a{};
    for (int i = 0; i < 11; ++i) a.in[i] = (const float*)d_in[i];
    a.out = (float*)d_out; a.ws = (unsigned char*)d_ws;
    hipLaunchKernelGGL(mk_fwd, dim3(grid), dim3(NWAVES * 64), LDS_BYTES, stream, a);
}
```

```cpp
#include <hip/hip_runtime.h>
#include <cstdio>
#include <cstdint>
namespace pg8 {
#define PG8_LAS __attribute__((address_space(3)))
typedef unsigned short bf16_t;
typedef short bf16x8 __attribute__((ext_vector_type(8)));
typedef float f32x4 __attribute__((ext_vector_type(4)));
typedef unsigned u32x4 __attribute__((ext_vector_type(4)));
constexpr int BM = 256, BK = 64, HALF = 128, HTB = HALF * BK * 2  , STAGE_BYTES = 8 * HTB, NXCD = 8, WGM = 8;

__host__ __device__ __forceinline__ int lds_byte(int r, int c) { const int st = (r >> 4) * 2 + (c >> 5), rr = r & 15, cc = c & 31, ob = rr * 64 + cc * 2; return st * 1024 + (ob ^ (((ob >> 9) & 1) << 5)); }
__host__ __device__ __forceinline__ void stage_rc(int b, int& R, int& C) { const int st = b / 1024, sb = b % 1024, swz = sb ^ (((sb >> 9) & 1) << 5); R = (st >> 1) * 16 + swz / 64; C = (st & 1) * 32 + (swz % 64) / 2; }
__host__ __device__ __forceinline__ int perm32(int rho) { const int n = rho >> 4, i = rho & 15; return 8 * (i >> 2) + 4 * n + (i & 3); }

struct Unit { int pm, pn; };
struct Gemm { const bf16_t* A; const bf16_t* Bt; int M, N, K; };

struct StaticOrder {
    int nM, nN, nwg, G, c;
    __host__ __device__ void init(int M, int N, int G_, int c_) { nM = M / BM; nN = N / BM; nwg = nM * nN; G = G_; c = c_; }
    __host__ __device__ bool next(int i, Unit& u) const {
        const long L = (long)i * G + c; if (L >= nwg) return false;
        int wgid = (int)L; { const int q = nwg / NXCD, r = nwg % NXCD, xcd = wgid % NXCD, off = wgid / NXCD; wgid = (xcd < r ? xcd * (q + 1) : r * (q + 1) + (xcd - r) * q) + off; }
        const int nig = WGM * nN, gid = wgid / nig, fm = gid * WGM, gsz = (nM - fm) < WGM ? (nM - fm) : WGM;
        u.pm = fm + ((wgid % nig) % gsz); u.pn = (wgid % nig) / gsz; return true;
    }
    __device__ __forceinline__ void a_ready(const Unit&) const {}
    __device__ __forceinline__ void done(const Unit&) const {}
};
struct PanelOrder {
    int nM, c;
    __host__ __device__ void init(int M, int c_) { nM = M / BM; c = c_; }
    __host__ __device__ bool next(int i, Unit& u) const { if (16 * i >= nM) return false; const int x = c & 7, t = c >> 3; u.pm = 16 * i + 4 * (x >> 1) + (t >> 3); u.pn = 8 * (x & 1) + (t & 7); return true; }
    __device__ __forceinline__ void a_ready(const Unit&) const {}
    __device__ __forceinline__ void done(const Unit&) const {}
};
__device__ __forceinline__ unsigned cvt_pk_bf16(float lo, float hi) { unsigned r; asm volatile("v_cvt_pk_bf16_f32 %0, %1, %2" : "=v"(r) : "v"(lo), "v"(hi)); return r; }
struct EpiBf16 {
    static constexpr bool PERM = true, AFTER_DRAIN = false;
    bf16_t* O; int ldc; int sc_lo, sc_hi; float sc; int sd_lo, sd_hi; float sd;
    PG8_LAS unsigned char* scr;
    __device__ __forceinline__ void operator()(const f32x4 (&acc)[2][2][4][2], const Unit& u, int wr, int wc, int fr_, int fq_) const {
        int fr = fr_, fq = fq_; asm volatile("" : "+v"(fr), "+v"(fq));
        const float s = (u.pn >= sc_lo && u.pn < sc_hi) ? sc : ((u.pn >= sd_lo && u.pn < sd_hi) ? sd : 1.0f);
        const int lane = fr + 16 * fq;
        const unsigned area = (unsigned)(size_t)scr + (unsigned)(wr * 4 + wc) * 2304u;
        const unsigned wa = area + fr * 144 + fq * 16, ra = area + (lane >> 3) * 144 + (lane & 7) * 16;
        bf16_t* gp = O + (size_t)(u.pm * BM + wr * 64 + (lane >> 3)) * ldc + u.pn * BM + wc * 64 + (lane & 7) * 8;
        u32x4 r0, r1;
#pragma unroll
        for (int q = 0; q < 8; ++q) { const int ai = q >> 2, m = q & 3;
            u32x4 w[2];
#pragma unroll
            for (int bj = 0; bj < 2; ++bj) { const f32x4 v0 = acc[ai][bj][m][0] * s, v1 = acc[ai][bj][m][1] * s;
                w[bj].x = cvt_pk_bf16(v0[0], v0[1]); w[bj].y = cvt_pk_bf16(v0[2], v0[3]); w[bj].z = cvt_pk_bf16(v1[0], v1[1]); w[bj].w = cvt_pk_bf16(v1[2], v1[3]); }
            if (q == 0) {
                asm volatile("ds_write_b128 %0, %1\n\tds_write_b128 %0, %2 offset:64\n\ts_waitcnt lgkmcnt(0)" :: "v"(wa), "v"(w[0]), "v"(w[1]) : "memory");
            } else {
                asm volatile("ds_write_b128 %2, %3\n\tds_write_b128 %2, %4 offset:64\n\ts_waitcnt lgkmcnt(0)" : "+v"(r0), "+v"(r1) : "v"(wa), "v"(w[0]), "v"(w[1]) : "memory");
                bf16_t* rowp = gp + (size_t)(((q - 1) >> 2) * HALF + ((q - 1) & 3) * 16) * ldc;
                *(u32x4*)rowp = r0; *(u32x4*)(rowp + (size_t)8 * ldc) = r1; }
            asm volatile("ds_read_b128 %0, %2\n\tds_read_b128 %1, %2 offset:1152" : "=&v"(r0), "=&v"(r1) : "v"(ra) : "memory"); }
        asm volatile("s_waitcnt lgkmcnt(0)" : "+v"(r0), "+v"(r1) :: "memory");
        {   bf16_t* rowp = gp + (size_t)(HALF + 3 * 16) * ldc; *(u32x4*)rowp = r0; *(u32x4*)(rowp + (size_t)8 * ldc) = r1; }
    }
};

__device__ __forceinline__ float xsum16(float x) {
    auto s = __builtin_amdgcn_permlane16_swap(__float_as_uint(x), __float_as_uint(x), false, false); x = __uint_as_float(s[0]) + __uint_as_float(s[1]);
    auto t = __builtin_amdgcn_permlane32_swap(__float_as_uint(x), __float_as_uint(x), false, false); return __uint_as_float(t[0]) + __uint_as_float(t[1]);
}
struct EpiLnFused {
    static constexpr bool PERM = false, AFTER_DRAIN = false;
    const float* X; float* XO; bf16_t* XBo; int ldc; float alpha; const float* gamma; const float* beta;
    unsigned long long* slots; unsigned* cnt; unsigned* tmo; PG8_LAS unsigned char* tab; int wave;
    __device__ __forceinline__ void operator()(f32x4 (&acc)[2][2][4][2], const Unit& u, int wr, int wc, int fr, int fq) const {
        typedef float f32x2v __attribute__((ext_vector_type(2)));
        const int row0 = u.pm * BM + wr * 64 + fr, col0 = u.pn * BM + wc * 32 + 4 * fq;
        PG8_LAS f32x2v* P = (PG8_LAS f32x2v*)tab;
        PG8_LAS f32x2v* S = (PG8_LAS f32x2v*)(tab + 8192);
        f32x4 xv[4][2][2];
        const unsigned ptab = (unsigned)(size_t)tab + (unsigned)((wr * 64 + fr) * 4 + wc) * 8u;
#define LNF_LDX(Q) do { const float* p_ = X + (size_t)(row0 + ((Q) >> 2) * HALF + ((Q) & 3) * 16) * ldc + col0; \
            asm volatile("global_load_dwordx4 %0, %4, off\n\tglobal_load_dwordx4 %1, %4, off offset:64\n\tglobal_load_dwordx4 %2, %4, off offset:512\n\tglobal_load_dwordx4 %3, %4, off offset:576" \
                         : "=&v"(xv[(Q) & 3][0][0]), "=&v"(xv[(Q) & 3][0][1]), "=&v"(xv[(Q) & 3][1][0]), "=&v"(xv[(Q) & 3][1][1]) : "v"(p_) : "memory"); } while (0)
#define LNF_WAIT(Q, N) asm volatile("s_waitcnt vmcnt(" #N ")" : "+v"(xv[(Q) & 3][0][0]), "+v"(xv[(Q) & 3][0][1]), "+v"(xv[(Q) & 3][1][0]), "+v"(xv[(Q) & 3][1][1]) :: "memory")
        static_assert(HALF == 128, "row offsets of the residual loads");
        LNF_LDX(0); LNF_LDX(1); LNF_LDX(2); LNF_LDX(3);
#pragma unroll
        for (int q = 0; q < 8; ++q) { const int ai = q >> 2, m = q & 3;
            if (q <= 4) LNF_WAIT(q, 12); else if (q == 5) LNF_WAIT(q, 8); else if (q == 6) LNF_WAIT(q, 4); else LNF_WAIT(q, 0);
            float s = 0.f, ss = 0.f;
#pragma unroll
            for (int bj = 0; bj < 2; ++bj)
#pragma unroll
                for (int n = 0; n < 2; ++n) { const f32x4 h = acc[ai][bj][m][n] + xv[q & 3][bj][n] * alpha; acc[ai][bj][m][n] = h;
                    s += (h[0] + h[1]) + (h[2] + h[3]); ss += (h[0] * h[0] + h[1] * h[1]) + (h[2] * h[2] + h[3] * h[3]); }
            if (q + 4 < 8) LNF_LDX(q + 4);
            s = xsum16(s); ss = xsum16(ss);
            if (fq == 0) { const f32x2v v_ = (f32x2v){s, ss}; asm volatile("ds_write_b64 %0, %1 offset:%2" :: "v"(ptab), "v"(v_), "n"((ai * HALF + m * 16) * 32) : "memory"); } }
#undef LNF_LDX
#undef LNF_WAIT
        asm volatile("s_waitcnt lgkmcnt(0)" ::: "memory"); __builtin_amdgcn_s_barrier(); asm volatile("" ::: "memory");
        const int lane = fr + 16 * fq, row = wave * 64 + lane;
        if (wave < 4) {
            const f32x2v a = P[row * 4 + 0], b = P[row * 4 + 1], c = P[row * 4 + 2], d = P[row * 4 + 3];
            const float s = (a.x + b.x) + (c.x + d.x), ss = (a.y + b.y) + (c.y + d.y);
            __hip_atomic_store(slots + ((size_t)(u.pm * BM + row) * 16 + u.pn), ((unsigned long long)__float_as_uint(ss) << 32) | __float_as_uint(s), __ATOMIC_RELAXED, __HIP_MEMORY_SCOPE_AGENT);
            asm volatile("s_waitcnt vmcnt(0)" ::: "memory");
        }
        __builtin_amdgcn_s_barrier(); asm volatile("" ::: "memory");
        if (wave == 0) {
            if (lane == 0) __hip_atomic_fetch_add(cnt + 64 * u.pm, 1u, __ATOMIC_RELAXED, __HIP_MEMORY_SCOPE_AGENT);
            unsigned spins = 0;
            while ((unsigned)__builtin_amdgcn_readfirstlane(__hip_atomic_load(cnt + 64 * u.pm, __ATOMIC_RELAXED, __HIP_MEMORY_SCOPE_AGENT)) < 16u) {
                if (++spins > (1u << 22)) { if (lane == 0) __hip_atomic_store(tmo, 1u, __ATOMIC_RELAXED, __HIP_MEMORY_SCOPE_AGENT); break; }
                __builtin_amdgcn_s_sleep(1); }
            __builtin_amdgcn_fence(__ATOMIC_ACQUIRE, "agent");
        }
        asm volatile("s_waitcnt vmcnt(0) lgkmcnt(0)" ::: "memory"); __builtin_amdgcn_s_barrier(); asm volatile("" ::: "memory");
        if (wave < 4) {
            const unsigned long long* sl = slots + (size_t)(u.pm * BM + row) * 16; float s = 0.f, ss = 0.f;
            f32x4 w[8];
            asm volatile("global_load_dwordx4 %0, %8, off sc1\n\tglobal_load_dwordx4 %1, %8, off offset:16 sc1\n\tglobal_load_dwordx4 %2, %8, off offset:32 sc1\n\tglobal_load_dwordx4 %3, %8, off offset:48 sc1\n\t"
                         "global_load_dwordx4 %4, %8, off offset:64 sc1\n\tglobal_load_dwordx4 %5, %8, off offset:80 sc1\n\tglobal_load_dwordx4 %6, %8, off offset:96 sc1\n\tglobal_load_dwordx4 %7, %8, off offset:112 sc1\n\t"
                         "s_waitcnt vmcnt(0)"
                         : "=&v"(w[0]), "=&v"(w[1]), "=&v"(w[2]), "=&v"(w[3]), "=&v"(w[4]), "=&v"(w[5]), "=&v"(w[6]), "=&v"(w[7]) : "v"(sl) : "memory");
#pragma unroll
            for (int t = 0; t < 8; ++t) { s += w[t][0] + w[t][2]; ss += w[t][1] + w[t][3]; }
            const float mean = s * (1.0f / 4096.0f), var = fmaxf(ss * (1.0f / 4096.0f) - mean * mean, 0.f);
            S[row] = (f32x2v){mean, 1.0f / sqrtf(var + 1e-5f)};
        }
        asm volatile("s_waitcnt lgkmcnt(0)" ::: "memory"); __builtin_amdgcn_s_barrier(); asm volatile("" ::: "memory");
        f32x4 gv[2][2], bv[2][2];
#pragma unroll
        for (int bj = 0; bj < 2; ++bj)
#pragma unroll
            for (int n = 0; n < 2; ++n) { gv[bj][n] = *(const f32x4*)(gamma + col0 + bj * HALF + n * 16); bv[bj][n] = *(const f32x4*)(beta + col0 + bj * HALF + n * 16); }
#pragma unroll
        for (int ai = 0; ai < 2; ++ai)
#pragma unroll
            for (int m = 0; m < 4; ++m) { const int r = ai * HALF + wr * 64 + m * 16 + fr; const f32x2v sr = S[r]; const size_t off = (size_t)(u.pm * BM + r) * ldc + col0;
#pragma unroll
                for (int bj = 0; bj < 2; ++bj)
#pragma unroll
                    for (int n = 0; n < 2; ++n) { const f32x4 y = ((acc[ai][bj][m][n] - sr.x) * sr.y) * gv[bj][n] + bv[bj][n];
                        *(f32x4*)(XO + off + bj * HALF + n * 16) = y;
                        if (XBo) { typedef unsigned u32x2v __attribute__((ext_vector_type(2))); u32x2v w; w.x = cvt_pk_bf16(y[0], y[1]); w.y = cvt_pk_bf16(y[2], y[3]); *(u32x2v*)(XBo + off + bj * HALF + n * 16) = w; } } }
    }
};

template <class Epi, class Sched, bool ALIGN_EPI = false, bool SP2 = false>
__device__ __forceinline__ void gemm_phase(PG8_LAS unsigned char* lds, const Gemm g, const Sched& S, const Epi& E, int wave_id  ) {
    int tid_; asm volatile("v_mbcnt_lo_u32_b32 %0, -1, 0\n\tv_mbcnt_hi_u32_b32 %0, -1, %0" : "=v"(tid_)); tid_ += 64 * wave_id;
    const int tid = tid_, wid = __builtin_amdgcn_readfirstlane(tid >> 6), lane = tid & 63, wr = wid >> 2, wc = wid & 3, fr = lane & 15, fq = lane >> 4;
    const int K = g.K, nt = K / BK;
    unsigned voffA[2], voffB[2];
#pragma unroll
    for (int i = 0; i < 2; ++i) { int R, C; stage_rc(tid * 16 + i * 8192, R, C); const int Rb = Epi::PERM ? (((R & ~31) << 1) + perm32(R & 31)) : R;
        voffA[i] = (unsigned)(R * K + C) * 2u; voffB[i] = (unsigned)(Rb * K + C) * 2u; }
    const size_t kstep = (size_t)(BK * 2);
    const size_t hstep = (size_t)HALF * K * 2;
    const size_t tstep = 2 * hstep;
    const size_t bhstep = Epi::PERM ? (size_t)32 * K * 2 : hstep;
    const unsigned ldsw = (unsigned)wid * 1024u;
    const int aoff = lds_byte(wr * 64 + fr, fq * 8), boff = lds_byte(wc * 32 + fr, fq * 8);
#define PG8_SA(b, h) (((b) * 2 + (h)) * HTB)
#define PG8_SB(b, h) ((4 + (b) * 2 + (h)) * HTB)
#define PG8_STAGE(bufoff, gbase, voff) do { _Pragma("unroll") for (int _i = 0; _i < 2; ++_i) \
        __builtin_amdgcn_global_load_lds((const unsigned*)((const char*)(gbase) + (voff)[_i]), (PG8_LAS unsigned*)(lds + (bufoff) + ldsw + _i * 8192), 16, 0, 0); } while (0)
#define PG8_LDA(dst, b, h) do { _Pragma("unroll") for (int m = 0; m < 4; ++m) _Pragma("unroll") for (int k = 0; k < 2; ++k) dst[m][k] = *(const PG8_LAS bf16x8*)(lds + PG8_SA(b, h) + aoff + m * 2048 + k * 1024); } while (0)
#define PG8_LDB(dst, b, h) do { _Pragma("unroll") for (int n = 0; n < 2; ++n) _Pragma("unroll") for (int k = 0; k < 2; ++k) dst[n][k] = *(const PG8_LAS bf16x8*)(lds + PG8_SB(b, h) + boff + n * 2048 + k * 1024); } while (0)
#define PG8_MMA(ai, bj, At, Bt) do { __builtin_amdgcn_s_setprio(1); _Pragma("unroll") for (int m = 0; m < 4; ++m) _Pragma("unroll") for (int n = 0; n < 2; ++n) _Pragma("unroll") for (int k = 0; k < 2; ++k) \
        acc[ai][bj][m][n] = __builtin_amdgcn_mfma_f32_16x16x32_bf16(Bt[n][k], At[m][k], acc[ai][bj][m][n], 0, 0, 0); __builtin_amdgcn_s_setprio(0); } while (0)
#define PG8_WAIT_V(n) asm volatile("s_waitcnt vmcnt(" #n ")" ::: "memory")
#define PG8_WAIT_L(n) asm volatile("s_waitcnt lgkmcnt(" #n ")" ::: "memory")
#define PG8_BAR __builtin_amdgcn_s_barrier()
#define PG8_SCHED __builtin_amdgcn_sched_barrier(0)
    Unit cur, nxt; int ui = 0;
    if (!S.next(0, cur)) return;
    f32x4 acc[2][2][4][2];
#pragma unroll
    for (int a = 0; a < 2; ++a)
#pragma unroll
        for (int b = 0; b < 2; ++b)
#pragma unroll
            for (int m = 0; m < 4; ++m)
#pragma unroll
                for (int n = 0; n < 2; ++n) acc[a][b][m][n] = (f32x4){0.f, 0.f, 0.f, 0.f};
    bf16x8 At[4][2], B0[2][2], B1[2][2];
    const char* cA = (const char*)g.A + (size_t)cur.pm * tstep; const char* cB = (const char*)g.Bt + (size_t)cur.pn * tstep;
    S.a_ready(cur);
    if constexpr (SP2) {
        PG8_STAGE(PG8_SB(0, 0), cB, voffB); PG8_STAGE(PG8_SB(0, 1), cB + bhstep, voffB); PG8_STAGE(PG8_SA(0, 0), cA, voffA); PG8_STAGE(PG8_SA(0, 1), cA + hstep, voffA);
        if (wr == 1) PG8_BAR;
        PG8_WAIT_V(2); PG8_BAR;
        PG8_STAGE(PG8_SB(1, 0), cB + kstep, voffB); PG8_STAGE(PG8_SA(1, 0), cA + kstep, voffA); PG8_STAGE(PG8_SB(1, 1), cB + bhstep + kstep, voffB);
        PG8_WAIT_V(6); PG8_BAR;
    } else {
        PG8_STAGE(PG8_SB(0, 0), cB, voffB); PG8_STAGE(PG8_SA(0, 0), cA, voffA); PG8_STAGE(PG8_SB(0, 1), cB + bhstep, voffB); PG8_STAGE(PG8_SA(0, 1), cA + hstep, voffA);
        if (wr == 1) PG8_BAR;
        PG8_WAIT_V(4); PG8_BAR;
        PG8_STAGE(PG8_SB(1, 0), cB + kstep, voffB); PG8_STAGE(PG8_SA(1, 0), cA + kstep, voffA); PG8_STAGE(PG8_SB(1, 1), cB + bhstep + kstep, voffB);
        PG8_WAIT_V(6); PG8_BAR;
    }
    for (;;) {
        const bool has_next = S.next(ui + 1, nxt);
        const char* nA = has_next ? (const char*)g.A + (size_t)nxt.pm * tstep : cA; const char* nB = has_next ? (const char*)g.Bt + (size_t)nxt.pn * tstep : cB;
        for (int t = 0; t < nt; t += 2) {
            const bool last = (t == nt - 2);
            const char* a1 = cA + (size_t)(t + 1) * kstep;
            const char* a2 = last ? nA : cA + (size_t)(t + 2) * kstep; const char* b2 = last ? nB : cB + (size_t)(t + 2) * kstep;
            const char* a3 = a2 + kstep; const char* b3 = b2 + kstep;
            if (last && has_next) S.a_ready(nxt);
            if constexpr (SP2) {
            PG8_LDB(B0, 0, 0); PG8_LDB(B1, 0, 1); PG8_SCHED; PG8_LDA(At, 0, 0); PG8_STAGE(PG8_SA(1, 1), a1 + hstep, voffA);
            PG8_WAIT_V(8); PG8_WAIT_L(0); PG8_BAR; PG8_MMA(0, 0, At, B0); PG8_MMA(0, 1, At, B1); PG8_BAR; PG8_SCHED;
            PG8_LDA(At, 0, 1); PG8_STAGE(PG8_SB(0, 0), b2, voffB); PG8_STAGE(PG8_SB(0, 1), b2 + bhstep, voffB); PG8_STAGE(PG8_SA(0, 0), a2, voffA);
            PG8_WAIT_V(8); PG8_WAIT_L(0); PG8_BAR; PG8_MMA(1, 0, At, B0); PG8_MMA(1, 1, At, B1); PG8_BAR; PG8_SCHED;
            PG8_LDB(B0, 1, 0); PG8_LDB(B1, 1, 1); PG8_SCHED; PG8_LDA(At, 1, 0); PG8_STAGE(PG8_SA(0, 1), a2 + hstep, voffA);
            PG8_WAIT_V(8); PG8_WAIT_L(0); PG8_BAR; PG8_MMA(0, 0, At, B0); PG8_MMA(0, 1, At, B1); PG8_BAR; PG8_SCHED;
            PG8_LDA(At, 1, 1); PG8_STAGE(PG8_SB(1, 0), b3, voffB); PG8_STAGE(PG8_SB(1, 1), b3 + bhstep, voffB); PG8_STAGE(PG8_SA(1, 0), a3, voffA);
            PG8_WAIT_V(8); PG8_WAIT_L(0); PG8_BAR; PG8_MMA(1, 0, At, B0); PG8_MMA(1, 1, At, B1); PG8_BAR; PG8_SCHED;
            } else {
            PG8_LDB(B0, 0, 0); PG8_SCHED; PG8_LDA(At, 0, 0); PG8_STAGE(PG8_SA(1, 1), a1 + hstep, voffA);
            PG8_WAIT_L(8); PG8_BAR; PG8_WAIT_L(0); PG8_MMA(0, 0, At, B0); PG8_BAR; PG8_SCHED;
            PG8_LDB(B1, 0, 1); PG8_STAGE(PG8_SB(0, 0), b2, voffB);
            PG8_BAR; PG8_WAIT_L(0); PG8_MMA(0, 1, At, B1); PG8_BAR;
            PG8_LDA(At, 0, 1); PG8_STAGE(PG8_SA(0, 0), a2, voffA);
            PG8_BAR; PG8_WAIT_L(0); PG8_MMA(1, 0, At, B0); PG8_BAR; PG8_SCHED;
            PG8_STAGE(PG8_SB(0, 1), b2 + bhstep, voffB);
            PG8_WAIT_V(6); PG8_BAR; PG8_MMA(1, 1, At, B1); PG8_BAR;
            PG8_LDB(B0, 1, 0); PG8_SCHED; PG8_LDA(At, 1, 0); PG8_STAGE(PG8_SA(0, 1), a2 + hstep, voffA);
            PG8_WAIT_L(8); PG8_BAR; PG8_WAIT_L(0); PG8_MMA(0, 0, At, B0); PG8_BAR; PG8_SCHED;
            PG8_LDB(B1, 1, 1); PG8_STAGE(PG8_SB(1, 0), b3, voffB);
            PG8_BAR; PG8_WAIT_L(0); PG8_MMA(0, 1, At, B1); PG8_BAR;
            PG8_LDA(At, 1, 1); PG8_STAGE(PG8_SA(1, 0), a3, voffA);
            PG8_BAR; PG8_WAIT_L(0); PG8_MMA(1, 0, At, B0); PG8_BAR; PG8_SCHED;
            PG8_STAGE(PG8_SB(1, 1), b3 + bhstep, voffB);
            PG8_WAIT_V(6); PG8_BAR; PG8_MMA(1, 1, At, B1); PG8_BAR;
            }
        }
        if constexpr (ALIGN_EPI) { if (wr == 0) PG8_BAR; }
        if constexpr (!Epi::AFTER_DRAIN) { E(acc, cur, wr, wc, fr, fq); S.done(cur); }
        if (!has_next) break;
#pragma unroll
        for (int a = 0; a < 2; ++a)
#pragma unroll
            for (int b = 0; b < 2; ++b)
#pragma unroll
                for (int m = 0; m < 4; ++m)
#pragma unroll
                    for (int n = 0; n < 2; ++n) acc[a][b][m][n] = (f32x4){0.f, 0.f, 0.f, 0.f};
        cur = nxt; cA = nA; cB = nB; ++ui;
        if constexpr (ALIGN_EPI) { if (wr == 1) PG8_BAR; }
    }
    PG8_WAIT_V(0);
    if constexpr (!ALIGN_EPI) { if (wr == 0) PG8_BAR; }
    PG8_BAR;
    if constexpr (Epi::AFTER_DRAIN) { E.fused(acc, cur, wr, wc, fr, fq, lds, wid, lane); S.done(cur); }
#undef PG8_SA
#undef PG8_SB
#undef PG8_STAGE
#undef PG8_LDA
#undef PG8_LDB
#undef PG8_MMA
#undef PG8_WAIT_V
#undef PG8_WAIT_L
#undef PG8_BAR
#undef PG8_SCHED
}
}

constexpr int NWAVES = 8;
constexpr int DM = 4096, BATCH = 4, SEQ = 4096, DEPTH = 4, HD = 128;
constexpr int M = BATCH * SEQ;
constexpr int NPROJ = 4 * DM;
constexpr int N_RET = 12, N_SB = 10, N_DIFF = 10;
constexpr int RET_W = N_RET * HD, SB_W = N_SB * HD, DIFF_W = N_DIFF * HD;
constexpr int C_RQ = 0, C_RK = RET_W, C_RV = 2 * RET_W, C_RG = 3 * RET_W;
constexpr int C_SQ = 4 * RET_W, C_SK = C_SQ + SB_W, C_SV = C_SQ + 2 * SB_W, C_SG = C_SQ + 3 * SB_W;
constexpr int C_DQ = 4 * RET_W + 4 * SB_W, C_DK = C_DQ + DIFF_W, C_DV = C_DQ + 2 * DIFF_W, C_DG = C_DQ + 3 * DIFF_W;
constexpr int MX_RET = 0, MX_SB = RET_W, MX_DIFF = RET_W + SB_W;
static_assert(C_DG + DIFF_W == NPROJ && MX_DIFF + DIFF_W == DM, "column map");
constexpr float LN_EPS = 1e-5f;
constexpr float LOG2E = 1.4426950408889634f, LN2 = 0.6931471805599453f;
constexpr float DEEPNORM_ALPHA = 1.681792830507429f;
__device__ const float RET_LOG_GAMMA[12] = {-3.174869716e-02f, -1.574835740e-02f, -7.843177766e-03f, -3.913899418e-03f, -1.955034910e-03f, -9.770396864e-04f, -4.884005175e-04f, -2.441704273e-04f, -1.220777631e-04f, -6.103701890e-05f, -3.051804379e-05f, -1.525890548e-05f};
__device__ const float ALIBI_SLOPE[10] = {5.000000000e-01f, 2.500000000e-01f, 1.250000000e-01f, 6.250000000e-02f, 3.125000000e-02f, 1.562500000e-02f, 7.812500000e-03f, 3.906250000e-03f, 7.071067691e-01f, 3.535533845e-01f};
__device__ const float LAMBDA_INIT[4] = {0.20000000000000007f, 0.35550906759096934f, 0.4707130183435842f, 0.5560582041556406f};

constexpr size_t MiB = 1u << 20;
constexpr size_t WS_CTL = 0, CTL_ZERO_BYTES = 1 * MiB;
constexpr size_t WS_WIN = 16 * MiB;
constexpr size_t WS_WOUT = WS_WIN + (size_t)DEPTH * NPROJ * DM * 2;
constexpr size_t WS_XB = WS_WOUT + (size_t)DEPTH * DM * DM * 2;
constexpr size_t WS_XH = WS_XB + (size_t)M * DM * 2;
constexpr size_t WS_PROJ = WS_XH + (size_t)M * DM * 4;
constexpr size_t WS_MIX = WS_PROJ + (size_t)M * NPROJ * 2;
constexpr size_t WS_H = WS_MIX + (size_t)M * DM * 2;
constexpr size_t WS_SLOTS = WS_H + (size_t)M * DM * 4;
constexpr size_t WS_END = WS_SLOTS + (size_t)M * 16 * 8;
constexpr int CW_BAR = 4096;
constexpr int CW_Q = 16384;
constexpr int CW_PRE = 49152;
constexpr int CW_LNC = 131072;
constexpr int CW_TMO = 8;
constexpr int CW_TMAX = 65536, TMAX_LAYER = BATCH * N_DIFF * 2 * 64;
constexpr int RS = 272;
constexpr int IMG64 = 64 * RS, IMG128 = 128 * RS;
constexpr int SCR_BYTES = 159744;
constexpr int MISC_OFF = SCR_BYTES;
constexpr int LDS_BYTES = SCR_BYTES + 1024;
static_assert(pg8::STAGE_BYTES + 12288 <= SCR_BYTES && LDS_BYTES <= 163840, "LDS map");

#define GAS __attribute__((address_space(1)))
#define LAS __attribute__((address_space(3)))
typedef unsigned short bf16;
typedef unsigned u32x4 __attribute__((ext_vector_type(4)));
typedef unsigned u32x2 __attribute__((ext_vector_type(2)));
typedef float f32x4 __attribute__((ext_vector_type(4)));
typedef short bf16x8 __attribute__((ext_vector_type(8)));
typedef short s16x4 __attribute__((ext_vector_type(4)));
typedef GAS unsigned gu32;
#define RLX_AGENT __ATOMIC_RELAXED, __HIP_MEMORY_SCOPE_AGENT
#define LDS_WAIT() asm volatile("s_waitcnt lgkmcnt(0)" ::: "memory")
#define VM_WAIT() asm volatile("s_waitcnt vmcnt(0)" ::: "memory")
__device__ __forceinline__ unsigned f2bf(float f) { unsigned u = __builtin_bit_cast(unsigned, f); return (u + 0x7fffu + ((u >> 16) & 1u)) >> 16; }
__device__ __forceinline__ unsigned pk2(float lo, float hi) { return f2bf(lo) | (f2bf(hi) << 16); }
__device__ __forceinline__ unsigned pkbf(float lo, float hi) { unsigned r; asm volatile("v_cvt_pk_bf16_f32 %0, %1, %2" : "=v"(r) : "v"(lo), "v"(hi)); return r; }
__device__ __forceinline__ float bf_lo(unsigned w) { return __uint_as_float(w << 16); }
__device__ __forceinline__ float bf_hi(unsigned w) { return __uint_as_float(w & 0xffff0000u); }
#define XB_TMO      128
#define XB_XCNT(j)  (256  + 64 * (j))
#define XB_XSUB(j)  (1280 + 64 * (j))
#define XB_XGEN(j)  (2304 + 64 * (j))
#define XB_TOP      3328
#define XB_TOPGEN   3392
#define XCD_BAR_WORDS 3456
#define XB_SPIN_CAP (1u << 18)

__device__ __forceinline__ unsigned xb_ld(unsigned* p)              { return __hip_atomic_load(p, __ATOMIC_RELAXED, __HIP_MEMORY_SCOPE_AGENT); }
__device__ __forceinline__ unsigned xb_add(unsigned* p, unsigned v) { return __hip_atomic_fetch_add(p, v, __ATOMIC_RELAXED, __HIP_MEMORY_SCOPE_AGENT); }
__device__ __forceinline__ unsigned xb_xcc_id() { return (unsigned)__builtin_amdgcn_s_getreg((3 << 11) | 20) & 0xFu; }
#define XB_SPIN(cond, bar) do { unsigned _sp = 0; while (cond) { __builtin_amdgcn_s_sleep(1); \
    if ((++_sp & 255u) == 0u) { if (xb_ld(&(bar)[XB_TMO])) break; if (_sp > XB_SPIN_CAP) { atomicAdd(&(bar)[XB_TMO], 1u); break; } } } } while (0)

struct XcdBarrier {
    unsigned wv;
    unsigned* bar; unsigned x;
    volatile LAS unsigned* st;
};

__device__ __forceinline__ bool xb_lane0() { int t; asm volatile("v_mbcnt_lo_u32_b32 %0, -1, 0\n\tv_mbcnt_hi_u32_b32 %0, -1, %0" : "=v"(t)); return t == 0; }
__device__ __forceinline__ XcdBarrier xcd_barrier_post(unsigned* bar, volatile LAS unsigned* st, unsigned wv) {
    XcdBarrier b; b.wv = wv; b.bar = bar; b.x = xb_xcc_id(); b.st = st;
    if (wv == 0u && xb_lane0()) (void)xb_add(&bar[XB_XCNT(b.x)], 1u);
    return b;
}
__device__ __forceinline__ void xcd_barrier_complete(unsigned* bar, unsigned x, unsigned& nloc, unsigned& nx) {
    const unsigned G = gridDim.x * gridDim.y * gridDim.z;
    unsigned sum, cnt, mine, sp = 0u;
    for (;;) {
        sum = 0u; cnt = 0u; mine = 0u;
#pragma unroll
        for (unsigned j = 0; j < 16; ++j) { const unsigned c = xb_ld(&bar[XB_XCNT(j)]); sum += c; cnt += (c > 0u) ? 1u : 0u; mine = (j == x) ? c : mine; }
        if (sum == G) break;
        __builtin_amdgcn_s_sleep(1);
        if ((++sp & 255u) == 0u) { if (xb_ld(&bar[XB_TMO])) break; if (sp > XB_SPIN_CAP) { atomicAdd(&bar[XB_TMO], 1u); break; } }
    }
    nloc = mine > 0u ? mine : 1u; nx = cnt > 0u ? cnt : 1u;
}

__device__ __forceinline__ void xcd_barrier(const XcdBarrier& b) {
    asm volatile("s_waitcnt vmcnt(0)" ::: "memory");
    __syncthreads();
    if (b.wv == 0u && xb_lane0()) {
        unsigned* bar = b.bar;
        __builtin_amdgcn_s_waitcnt(0);
        unsigned nloc = b.st[0], nx = b.st[1];
        if (nloc == 0u) { xcd_barrier_complete(bar, b.x, nloc, nx); b.st[0] = nloc; b.st[1] = nx; }
        const unsigned old = xb_add(&bar[XB_XSUB(b.x)], 1u);
        const unsigned gen = old / nloc;
        if (old + 1u == (gen + 1u) * nloc) {
            __builtin_amdgcn_fence(__ATOMIC_RELEASE, "agent");
            asm volatile("s_waitcnt vmcnt(0)" ::: "memory");
            const unsigned og = xb_add(&bar[XB_TOP], 1u);
            const unsigned tg = og / nx;
            if (og + 1u == (tg + 1u) * nx) xb_add(&bar[XB_TOPGEN], 1u);
            else XB_SPIN(xb_ld(&bar[XB_TOPGEN]) == tg, bar);
            __builtin_amdgcn_fence(__ATOMIC_ACQUIRE, "agent");
            xb_add(&bar[XB_XGEN(b.x)], 1u);
            asm volatile("s_waitcnt vmcnt(0)" ::: "memory");
        } else {
            XB_SPIN(xb_ld(&bar[XB_XGEN(b.x)]) == gen, bar);
            __builtin_amdgcn_fence(__ATOMIC_ACQUIRE, "agent");
            asm volatile("s_waitcnt vmcnt(0)" ::: "memory");
        }
    }
    __syncthreads();
}

struct Args { const float* in[11]; float* out; unsigned char* ws; };
typedef const __attribute__((address_space(4))) Args CArgs;
__device__ __forceinline__ CArgs* kargs() { CArgs* p = (CArgs*)__builtin_amdgcn_kernarg_segment_ptr(); asm volatile("" : "+s"(p)); return p; }
#define args (*kargs())
struct Frame {
    LAS unsigned char* lds;
    volatile LAS unsigned* MISC;
    int wave;
};
__device__ __forceinline__ int opaque_lane() { int t; asm volatile("v_mbcnt_lo_u32_b32 %0, -1, 0\n\tv_mbcnt_hi_u32_b32 %0, -1, %0" : "=v"(t)); return t; }
#define opaque_tid() (F.wave * 64 + opaque_lane())
#define A_X       (args.in[0])
#define A_WIN     (args.in[1])
#define A_WOUT    (args.in[2])
#define A_LNG     (args.in[3])
#define A_LNB     (args.in[4])
#define A_RETG    (args.in[5])
#define A_DIFFG   (args.in[6])
#define A_LQ1     (args.in[7])
#define A_LK1     (args.in[8])
#define A_LQ2     (args.in[9])
#define A_LK2     (args.in[10])
#define W_CTL     ((gu32*)(args.ws + WS_CTL))
#define W_WINT    ((bf16*)(args.ws + WS_WIN))
#define W_WOUTT   ((bf16*)(args.ws + WS_WOUT))
#define W_XB      ((bf16*)(args.ws + WS_XB))
#define W_XH      ((float*)(args.ws + WS_XH))
#define W_PROJ    ((bf16*)(args.ws + WS_PROJ))
#define W_MIX     ((bf16*)(args.ws + WS_MIX))
#define W_H       ((float*)(args.ws + WS_H))
template <int CTRL> __device__ __forceinline__ float dpp_mov(float x) { return __builtin_bit_cast(float, __builtin_amdgcn_mov_dpp(__builtin_bit_cast(int, x), CTRL, 0xf, 0xf, true)); }
__device__ __forceinline__ float xrow16_max(float x) {
    auto s = __builtin_amdgcn_permlane16_swap(__float_as_uint(x), __float_as_uint(x), false, false);
    x = fmaxf(__uint_as_float(s[0]), __uint_as_float(s[1]));
    auto t = __builtin_amdgcn_permlane32_swap(__float_as_uint(x), __float_as_uint(x), false, false);
    return fmaxf(__uint_as_float(t[0]), __uint_as_float(t[1]));
}
__device__ __forceinline__ float xrow16_sum(float x) {
    auto s = __builtin_amdgcn_permlane16_swap(__float_as_uint(x), __float_as_uint(x), false, false);
    x = __uint_as_float(s[0]) + __uint_as_float(s[1]);
    auto t = __builtin_amdgcn_permlane32_swap(__float_as_uint(x), __float_as_uint(x), false, false);
    return __uint_as_float(t[0]) + __uint_as_float(t[1]);
}
__device__ __forceinline__ float wave_sum(float v) {
    v += dpp_mov<0xB1>(v); v += dpp_mov<0x4E>(v); v += dpp_mov<0x141>(v); v += dpp_mov<0x140>(v);
    return xrow16_sum(v);
}
__device__ __forceinline__ f32x4 mfma16(bf16x8 a, bf16x8 b, f32x4 c) { return __builtin_amdgcn_mfma_f32_16x16x32_bf16(a, b, c, 0, 0, 0); }
__device__ __forceinline__ s16x4 tr_read(const LAS unsigned char* p) { return __builtin_amdgcn_ds_read_tr16_b64_v4i16((LAS s16x4*)p); }
__device__ __forceinline__ bf16x8 cat8(s16x4 lo, s16x4 hi) { return (bf16x8){lo[0], lo[1], lo[2], lo[3], hi[0], hi[1], hi[2], hi[3]}; }
__device__ __forceinline__ float silu_f(float x) { return x * __builtin_amdgcn_rcpf(1.0f + __builtin_amdgcn_exp2f(-x * LOG2E)); }

__device__ __forceinline__ void p0_transpose_item(const float* W, int K, int N, bf16* WT, LAS float* scr, int item, int lane) {
    const int nblk = N / 32, kb = item / nblk, nb = item % nblk, k0 = 64 * kb, n0 = 32 * nb;
#pragma unroll
    for (int i = 0; i < 32; ++i) { const int kk = 2 * i + (lane >> 5); scr[kk * 33 + (lane & 31)] = __builtin_nontemporal_load(W + (size_t)(k0 + kk) * N + n0 + (lane & 31)); }
    LDS_WAIT(); asm volatile("" ::: "memory");
    const int c = lane & 7;
#pragma unroll
    for (int j = 0; j < 4; ++j) { const int n = (lane >> 3) + 8 * j; const LAS float* s = scr + (8 * c) * 33 + n;
        u32x4 o; o.x = pk2(s[0 * 33], s[1 * 33]); o.y = pk2(s[2 * 33], s[3 * 33]); o.z = pk2(s[4 * 33], s[5 * 33]); o.w = pk2(s[6 * 33], s[7 * 33]);
        __builtin_nontemporal_store(o, (GAS u32x4*)(WT + (size_t)(n0 + n) * K + k0 + 8 * c)); }
    LDS_WAIT(); asm volatile("" ::: "memory");
}
constexpr int CV_I_IN = (DM / 64) * (NPROJ / 32), CV_I_OUT = (DM / 64) * (DM / 32), CV_ITEMS = CV_I_IN + CV_I_OUT;
__device__ __forceinline__ void convert_item(int layer, int it, LAS float* scr, int lane) {
    if (it < CV_I_IN) p0_transpose_item(A_WIN + (size_t)layer * DM * NPROJ, DM, NPROJ, W_WINT + (size_t)layer * NPROJ * DM, scr, it, lane);
    else p0_transpose_item(A_WOUT + (size_t)layer * DM * DM, DM, DM, W_WOUTT + (size_t)layer * DM * DM, scr, it - CV_I_IN, lane);
}
__device__ __forceinline__ void p0_prologue(Frame& F0) {
    struct { LAS unsigned char* lds; int tid, lane, wave; } F; F.lds = F0.lds; F.wave = F0.wave; F.lane = opaque_lane(); F.tid = F.wave * 64 + F.lane;
    LAS float* scr = (LAS float*)(F.lds + F.wave * 16384);
    const int gw = blockIdx.x * NWAVES + F.wave, NGW = gridDim.x * NWAVES;
    for (int it = gw; it < DEPTH * CV_ITEMS; it += NGW) convert_item(it / CV_ITEMS, it % CV_ITEMS, scr, F.lane);
    const size_t nthr = (size_t)gridDim.x * NWAVES * 64, t0 = (size_t)blockIdx.x * NWAVES * 64 + F.tid;
    for (size_t i = t0; i < (size_t)M * DM / 8; i += nthr) {
        const f32x4 a = *(const GAS f32x4*)(A_X + i * 8), b = *(const GAS f32x4*)(A_X + i * 8 + 4);
        u32x4 o; o.x = pk2(a.x, a.y); o.y = pk2(a.z, a.w); o.z = pk2(b.x, b.y); o.w = pk2(b.z, b.w);
        *(GAS u32x4*)(W_XB + i * 8) = o; }
}
constexpr int CV_UNIT = 32, CV_UNITS = CV_ITEMS / CV_UNIT;
static_assert(CV_ITEMS % CV_UNIT == 0, "conversion units");
__device__ __forceinline__ void convert_unit(Frame& F, int layer, int u) {
    const int lane = opaque_lane(); LAS float* scr = (LAS float*)(F.lds + F.wave * 16384);
    for (int j = 0; j < CV_UNIT / NWAVES; ++j) convert_item(layer, u * CV_UNIT + F.wave * (CV_UNIT / NWAVES) + j, scr, lane);
}

__device__ __forceinline__ int next_unit(Frame& F, gu32* head) {
    __syncthreads();
    if (F.wave == 0 && opaque_lane() == 0) F.MISC[4] = __hip_atomic_fetch_add(head, 1u, RLX_AGENT);
    __syncthreads();
    return __builtin_amdgcn_readfirstlane((int)F.MISC[4]);
}
__device__ const unsigned char DIFF_ORDER[160] = {244, 245, 246, 247, 228, 229, 230, 231, 212, 213, 214, 215, 196, 197, 198, 199, 180, 181, 182, 183, 164, 165, 166, 167, 148, 149, 150, 151, 132, 133, 134, 135, 116, 117, 118, 119, 100, 101, 102, 103, 84, 85, 86, 87, 68, 69, 70, 71, 52, 53, 54, 55, 36, 37, 38, 39, 20, 21, 22, 23, 4, 5, 6, 7, 243, 227, 211, 195, 179, 163, 147, 131, 115, 99, 83, 242, 226, 210, 194, 178, 162, 146, 130, 114, 98, 82, 66, 67, 50, 51, 241, 225, 209, 193, 177, 161, 145, 129, 113, 97, 81, 65, 49, 33, 34, 35, 249, 233, 217, 201, 185, 169, 153, 137, 121, 105, 89, 73, 57, 41, 240, 224, 208, 192, 176, 160, 144, 128, 112, 96, 80, 64, 48, 32, 16, 17, 18, 19, 25, 248, 232, 216, 200, 184, 168, 152, 136, 120, 104, 88, 72, 56, 40, 24, 0, 1, 2, 3, 8, 9};
__device__ __forceinline__ void knorm_prepass(Frame& F, int layer, int wave) {
    const int lane = opaque_lane(), gw = blockIdx.x * NWAVES + wave, NGW = BATCH * N_RET * NWAVES;
    gu32* tm = W_CTL + CW_TMAX + layer * TMAX_LAYER; gu32* cnt = W_CTL + CW_PRE + layer * 64;
    unsigned ndone = 0;
    for (int it = gw; it < BATCH * N_DIFF * 128; it += NGW) {
        const int t32 = it & 127, bh = it >> 7, b = bh / N_DIFF, h = bh % N_DIFF;
        const bf16* kp = W_PROJ + (size_t)(b * SEQ + 32 * t32) * NPROJ + C_DK + h * HD + 8 * (lane & 15);
        u32x4 w[8];
#pragma unroll
        for (int i = 0; i < 8; ++i) w[i] = *(const GAS u32x4*)(kp + (size_t)(4 * i + (lane >> 4)) * NPROJ);
        float mx = 0.f;
#pragma unroll
        for (int i = 0; i < 8; ++i) { float s = 0.f;
#pragma unroll
            for (int j = 0; j < 4; ++j) { const float lo = bf_lo(w[i][j]), hi = bf_hi(w[i][j]); s = fmaf(lo, lo, s); s = fmaf(hi, hi, s); }
            s += dpp_mov<0xB1>(s); s += dpp_mov<0x4E>(s); s += dpp_mov<0x141>(s);
            mx = fmaxf(mx, s); }
        mx = xrow16_max(mx);
        if ((lane & 55) == 0) __hip_atomic_fetch_max(tm + ((bh * 2 + (lane >> 3)) * 64 + (t32 >> 1)), __float_as_uint(mx), RLX_AGENT);
        ++ndone;
    }
    asm volatile("s_waitcnt vmcnt(0)" ::: "memory");
    if (lane == 0) __hip_atomic_fetch_add((LAS unsigned*)&F.MISC[6], ndone, __ATOMIC_RELAXED, __HIP_MEMORY_SCOPE_WORKGROUP);
    __syncthreads();
    if (wave == 0 && lane == 0) { __hip_atomic_fetch_add(cnt, F.MISC[6], RLX_AGENT); F.MISC[6] = 0u; }
}
template <int CTRL, int ROWMASK> __device__ __forceinline__ float dpp_upd0(float x) { return __builtin_bit_cast(float, __builtin_amdgcn_update_dpp(0, __builtin_bit_cast(int, x), CTRL, ROWMASK, 0xf, true)); }
__device__ __forceinline__ float wave_prefix_max(float v) {
    v = fmaxf(v, dpp_upd0<0x111, 0xf>(v)); v = fmaxf(v, dpp_upd0<0x112, 0xf>(v)); v = fmaxf(v, dpp_upd0<0x114, 0xf>(v)); v = fmaxf(v, dpp_upd0<0x118, 0xf>(v));
    v = fmaxf(v, dpp_upd0<0x142, 0xa>(v)); v = fmaxf(v, dpp_upd0<0x143, 0xc>(v));
    return v;
}

constexpr int KV_TILE_BYTES = 64 * 256;
__device__ __forceinline__ int swz_k(int row) { return row & 15; }
__device__ __forceinline__ int swz_v(int row) { return (row & 15) ^ ((row & 1) << 3); }
__device__ __forceinline__ void glds16(const void* gsrc, unsigned lds_dst) { unsigned keep;
    asm volatile("s_mov_b32 %0, m0\n\ts_mov_b32 m0, %2\n\ts_nop 0\n\tglobal_load_lds_dwordx4 %1, off\n\ts_mov_b32 m0, %0" : "=&s"(keep) : "v"(gsrc), "s"(lds_dst) : "memory"); }
__device__ __forceinline__ void glds16_so(const void* gbase, unsigned voff, unsigned lds_dst) { unsigned keep;
    asm volatile("s_mov_b32 %0, m0\n\ts_mov_b32 m0, %2\n\ts_nop 0\n\tglobal_load_lds_dwordx4 %1, %3\n\ts_mov_b32 m0, %0" : "=&s"(keep) : "v"(voff), "s"(lds_dst), "s"(gbase) : "memory"); }
__device__ __forceinline__ void kv_dma_offsets(unsigned (&dmo)[4], int wave, int lane) {
#pragma unroll
    for (int i = 0; i < 2; ++i) { const int row = 4 * (2 * wave + i) + (lane >> 4), slot = lane & 15;
        dmo[2 * i] = (unsigned)row * (NPROJ * 2) + 16 * (slot ^ swz_k(row)); dmo[2 * i + 1] = (unsigned)row * (NPROJ * 2) + 16 * (slot ^ swz_v(row)); }
}
__device__ __forceinline__ void kv_dma(LAS unsigned char* kbuf, LAS unsigned char* vbuf, const bf16* kp, const bf16* vp, int k0, int wave, const unsigned (&dmo)[4]) {
    const char* kb = (const char*)(kp + (size_t)k0 * NPROJ); const char* vb = (const char*)(vp + (size_t)k0 * NPROJ);
#pragma unroll
    for (int i = 0; i < 2; ++i) { const int pc = 2 * wave + i;
        glds16_so(kb, dmo[2 * i], (unsigned)(size_t)(kbuf + 1024 * pc));
        glds16_so(vb, dmo[2 * i + 1], (unsigned)(size_t)(vbuf + 1024 * pc)); }
}
__device__ __forceinline__ void k_dma(LAS unsigned char* kbuf, const bf16* kp, int k0, int wave, const unsigned (&dmo)[4]) {
    const char* kb = (const char*)(kp + (size_t)k0 * NPROJ);
    glds16_so(kb, dmo[0], (unsigned)(size_t)(kbuf + 1024 * (2 * wave))); glds16_so(kb, dmo[2], (unsigned)(size_t)(kbuf + 1024 * (2 * wave + 1))); }
__device__ __forceinline__ void v_dma(LAS unsigned char* vbuf, const bf16* vp, int k0, int wave, const unsigned (&dmo)[4]) {
    const char* vb = (const char*)(vp + (size_t)k0 * NPROJ);
    glds16_so(vb, dmo[1], (unsigned)(size_t)(vbuf + 1024 * (2 * wave))); glds16_so(vb, dmo[3], (unsigned)(size_t)(vbuf + 1024 * (2 * wave + 1))); }
constexpr float NEG_MASK = -1e30f;
constexpr float DIFF_THR = 6.0f;
#ifndef SCHED_FENCE
#define SCHED_FENCE() __builtin_amdgcn_sched_barrier(0)
#endif
__device__ __forceinline__ float max3_raw(float a, float b, float c) { float r; asm("v_max3_f32 %0, %1, %2, %3" : "=v"(r) : "v"(a), "v"(b), "v"(c)); return r; }
__device__ __forceinline__ float max2_raw(float a, float b) { float r; asm("v_max_f32_e32 %0, %1, %2" : "=v"(r) : "v"(a), "v"(b)); return r; }
__device__ __forceinline__ void diff_sm32(bool force, bool diag, f32x4 (&S)[2], f32x4 (&O)[8], float& m, float& l, bf16x8& pb, int kq  ) {
    if (diag) {
        int kql = kq; asm volatile("" : "+v"(kql));
#pragma unroll
        for (int a = 0; a < 2; ++a)
#pragma unroll
            for (int r = 0; r < 4; ++r) if (kql + 16 * a + r > 0) S[a][r] = NEG_MASK;
    }
    const float pl = max3_raw(max3_raw(max3_raw(S[0][0], S[0][1], S[0][2]), S[0][3], S[1][0]), max2_raw(S[1][1], S[1][2]), S[1][3]);
    if (force || !__all(pl <= DIFF_THR)) {
        const float pmax = xrow16_max(pl);
        float mn = fmaxf(pmax, 0.f);
        if (force) { const float lt = xrow16_sum(l); if (lt == 0.f) mn = pmax; }
        if (pmax < -1e29f) mn = 0.f;
        const float alpha = __builtin_amdgcn_exp2f(-mn);
#pragma unroll
        for (int c = 0; c < 8; ++c) O[c] = O[c] * alpha;
        l *= alpha; m += mn;
#pragma unroll
        for (int a = 0; a < 2; ++a) S[a] = S[a] - mn;
    }
    float ps = 0.f;
#pragma unroll
    for (int a = 0; a < 2; ++a)
#pragma unroll
        for (int r = 0; r < 4; ++r) { const float pv = __builtin_amdgcn_exp2f(S[a][r]); S[a][r] = pv; ps += pv; }
    l += ps;
    u32x4 w; w.x = pkbf(S[0][0], S[0][1]); w.y = pkbf(S[0][2], S[0][3]); w.z = pkbf(S[1][0], S[1][1]); w.w = pkbf(S[1][2], S[1][3]);
    pb = __builtin_bit_cast(bf16x8, w);
}
#ifndef DT2_KQ_EARLY
#define DT2_KQ_EARLY 0
#endif
#define DT2_LOADKQ(HH, X) do { _Pragma("unroll") for (int a = 0; a < 2; ++a) _Pragma("unroll") for (int s = 0; s < 2; ++s) { \
        kf[a][s] = *(const LAS bf16x8*)(kb + kr[X][s] + 256 * (32 * (HH) + 16 * a)); qf[a][s] = *(const LAS bf16x8*)(qb + kr[X][s] + 256 * (16 * a)); } } while (0)
#define DT2_LOADV(DST, HH, C0) do { _Pragma("unroll") for (int c = 0; c < 4; ++c) \
        DST[c] = cat8(tr_read((const LAS unsigned char*)(va[(C0) + c] + 256 * (32 * (HH)))), tr_read((const LAS unsigned char*)(va[(C0) + c] + 256 * (32 * (HH) + 16)))); } while (0)
__device__ __forceinline__ void diff_tile2(bool force, bool diag, f32x4 (&O)[2][2][8], float (&m)[2][2], float (&l)[2][2], const unsigned (&kr)[2][2], unsigned kb, unsigned qb, const unsigned (&va)[8], float slope2, int kq0  ) {
    bf16x8 kf[2][2], qf[2][2];
    DT2_LOADKQ(1, 0);
#pragma unroll
    for (int blk = 0; blk < 4; ++blk) {
        const int hh = 1 - (blk >> 1), x = blk & 1;
        bf16x8 vv[4];
        f32x4 S0[2], S1[2];
        const float b0 = slope2 * (float)(kq0 + 32 * hh) - m[x][0], b1 = slope2 * (float)(kq0 + 32 * hh - 16) - m[x][1];
#pragma unroll
        for (int a = 0; a < 2; ++a)
#pragma unroll
            for (int r = 0; r < 4; ++r) { S0[a][r] = fmaf(slope2, (float)(16 * a + r), b0); S1[a][r] = fmaf(slope2, (float)(16 * a + r), b1); }
        SCHED_FENCE();
#pragma unroll
        for (int a = 0; a < 2; ++a)
#pragma unroll
            for (int s = 0; s < 2; ++s) { S0[a] = mfma16(kf[a][s], qf[0][s], S0[a]); S1[a] = mfma16(kf[a][s], qf[1][s], S1[a]); }
        bf16x8 pb0, pb1;
        SCHED_FENCE();
        DT2_LOADV(vv, hh, 0);
        SCHED_FENCE();
        diff_sm32(force, diag, S0, O[x][0], m[x][0], l[x][0], pb0, kq0 + 32 * hh);
        diff_sm32(force, diag, S1, O[x][1], m[x][1], l[x][1], pb1, kq0 + 32 * hh - 16);
        SCHED_FENCE();
#pragma unroll
        for (int c = 0; c < 4; ++c) { O[x][0][c] = mfma16(vv[c], pb0, O[x][0][c]); O[x][1][c] = mfma16(vv[c], pb1, O[x][1][c]); }
        SCHED_FENCE();
        DT2_LOADV(vv, hh, 4);
        SCHED_FENCE();
#pragma unroll
        for (int c = 0; c < 4; ++c) { O[x][0][4 + c] = mfma16(vv[c], pb0, O[x][0][4 + c]); O[x][1][4 + c] = mfma16(vv[c], pb1, O[x][1][4 + c]); }
        SCHED_FENCE();
        if (blk == 0) DT2_LOADKQ(1, 1); else if (blk == 1) DT2_LOADKQ(0, 0); else if (blk == 2) DT2_LOADKQ(0, 1);
        SCHED_FENCE();
    }
}
#undef DT2_LOADKQ
#undef DT2_LOADV
constexpr int DQ_IMG = 0, DK_RING = 65536, DV_RING = DK_RING + 2 * KV_TILE_BYTES;
__device__ __forceinline__ void diff_unit2(Frame& F, int b, int h, int qb, int layer) {
    const int tid_ = opaque_tid(), lane = tid_ & 63;
    const int wave = F.wave, li = lane & 15, g = lane >> 4;
    const int q0 = 256 * qb, tq0 = q0 + 32 * wave + li;
    const bf16* base = W_PROJ + (size_t)(b * SEQ) * NPROJ;
    const bf16* qp = base + C_DQ + h * HD; const bf16* kp = base + C_DK + h * HD; const bf16* vp = base + C_DV + h * HD; const bf16* gp = base + C_DG + h * HD;
    const float slope2 = ALIBI_SLOPE[h] * LOG2E;
    LAS unsigned char* kring = F.lds + 65536; LAS unsigned char* vring = F.lds + 65536 + 3 * KV_TILE_BYTES; constexpr int DTAB = 65536 + 5 * KV_TILE_BYTES;
    const int jt0 = 4 * qb + 3;
#pragma unroll
    for (int i = 0; i < 8; ++i) { const int row = 32 * wave + 4 * i + (lane >> 4), slot = lane & 15;
        glds16(qp + (size_t)(q0 + row) * NPROJ + 8 * (slot ^ swz_k(row)), (unsigned)(size_t)(F.lds + DQ_IMG + 1024 * (8 * wave + i))); }
    unsigned dmo[4]; kv_dma_offsets(dmo, wave, lane);
    k_dma(kring, kp, 64 * jt0, wave, dmo); v_dma(vring, vp, 64 * jt0, wave, dmo); k_dma(kring + KV_TILE_BYTES, kp, 64 * (jt0 - 1), wave, dmo);
    f32x4 O[2][2][8]; float m[2][2], l[2][2];
#pragma unroll
    for (int x = 0; x < 2; ++x)
#pragma unroll
        for (int u = 0; u < 2; ++u) { m[x][u] = 0.f; l[x][u] = 0.f;
#pragma unroll
            for (int c = 0; c < 8; ++c) O[x][u][c] = (f32x4){0.f, 0.f, 0.f, 0.f}; }
    unsigned kr[2][2], va[8];
    {   const int q = li >> 2, p = lane & 3; const unsigned vb = (unsigned)(size_t)vring;
#pragma unroll
        for (int x = 0; x < 2; ++x)
#pragma unroll
            for (int s = 0; s < 2; ++s) kr[x][s] = 256 * li + 16 * ((8 * x + 4 * s + g) ^ swz_k(li));
#pragma unroll
        for (int c = 0; c < 8; ++c) va[c] = vb + 256 * (4 * g + q) + 16 * ((2 * c + (p >> 1)) ^ swz_v(4 * g + q)) + 8 * (p & 1); }
    const unsigned qbase = (unsigned)(size_t)(F.lds + DQ_IMG) + 256 * 32 * wave;
    LAS f32x4* qnp = (LAS f32x4*)(F.lds + DTAB) + tid_; LAS float* kprep = (LAS float*)(F.lds + DTAB + 8192 + 512 * wave);
    const bool canskip = ALIBI_SLOPE[h] * LOG2E * (float)SEQ > 200.0f;
    {   if (canskip) {
            gu32* cnt = W_CTL + CW_PRE + layer * 64; unsigned spins = 0;
            while (__builtin_amdgcn_readfirstlane(__hip_atomic_load(cnt, RLX_AGENT)) < (unsigned)(BATCH * N_DIFF * 128) && ++spins < (1u << 22)) __builtin_amdgcn_s_sleep(2);
            gu32* tm = W_CTL + CW_TMAX + layer * TMAX_LAYER + ((b * N_DIFF + h) * 2) * 64;
#pragma unroll
            for (int x = 0; x < 2; ++x) kprep[x * 64 + lane] = wave_prefix_max(sqrtf(__uint_as_float(__hip_atomic_load(tm + x * 64 + lane, RLX_AGENT))));
        }
        asm volatile("s_waitcnt vmcnt(0)" ::: "memory");
        f32x4 qv;
#pragma unroll
        for (int x = 0; x < 2; ++x)
#pragma unroll
            for (int u = 0; u < 2; ++u) { float s2 = 0.f;
#pragma unroll
                for (int s = 0; s < 2; ++s) { const u32x4 w = *(const LAS u32x4*)(qbase + kr[x][s] + 256 * (16 * u));
#pragma unroll
                    for (int j = 0; j < 4; ++j) { const float lo = bf_lo(w[j]), hi = bf_hi(w[j]); s2 = fmaf(lo, lo, s2); s2 = fmaf(hi, hi, s2); } }
                qv[2 * x + u] = sqrtf(xrow16_sum(s2)); }
        *qnp = qv;
    }
    int slot = 0, kslot = 0;
    bool first = true;
    for (int jt = jt0; jt >= 0; --jt) {
        if (jt >= 1) asm volatile("s_waitcnt vmcnt(2)\n\ts_barrier" ::: "memory"); else asm volatile("s_waitcnt vmcnt(0)\n\ts_barrier" ::: "memory");
        if (jt != jt0) {
            unsigned alld = 1u;
#pragma unroll
            for (int w = 0; w < 8; ++w) alld &= F.MISC[8 + 8 * (slot ^ 1) + w];
            if (__builtin_amdgcn_readfirstlane((int)alld)) break;
        }
        if (jt >= 1) v_dma(vring + (slot ^ 1) * KV_TILE_BYTES, vp, 64 * (jt - 1), wave, dmo);
        if (jt >= 2) k_dma(kring + (kslot == 0 ? 2 : kslot - 1) * KV_TILE_BYTES, kp, 64 * (jt - 2), wave, dmo);
        const int k0 = 64 * jt;
        if (k0 <= q0 + 32 * wave + 31) {
            const int kq0 = k0 + 4 * g - tq0;
            diff_tile2(first, k0 + 63 > q0 + 32 * wave, O, m, l, kr, (unsigned)(size_t)kring + kslot * KV_TILE_BYTES, qbase, va, slope2, kq0);
            first = false;
        }
        {
            bool wdone = false;
            if (canskip && !first && jt >= 1) {
                bool dn = true; const f32x4 qv = *qnp;
#pragma unroll
                for (int x = 0; x < 2; ++x) { const float kmx = kprep[x * 64 + jt - 1];
#pragma unroll
                    for (int u = 0; u < 2; ++u) dn = dn && (fmaf(qv[2 * x + u], kmx, slope2 * (float)(64 * jt - 1 - (tq0 + 16 * u))) - m[x][u] < -152.0f); }
                wdone = __all(dn);
            }
            if (lane == 0) F.MISC[8 + 8 * slot + wave] = wdone ? 1u : 0u;
        }
        {   const int dl = slot ? -KV_TILE_BYTES : KV_TILE_BYTES;
#pragma unroll
            for (int c = 0; c < 8; ++c) va[c] += dl; }
        slot ^= 1; kslot = kslot == 2 ? 0 : kslot + 1;
    }
    const float lam = __uint_as_float(F.MISC[5]);
    const float* gain = A_DIFFG + layer * DIFF_W + h * HD;
    int ge = g; asm volatile("" : "+v"(ge));
#pragma unroll
    for (int u = 0; u < 2; ++u) {
        const float l1 = xrow16_sum(l[0][u]), l2 = xrow16_sum(l[1][u]);
        const float c1 = 1.0f / l1, c2 = lam / l2;
        float ss = 0.f;
#pragma unroll
        for (int c = 0; c < 8; ++c)
#pragma unroll
            for (int r = 0; r < 4; ++r) { const float o = O[0][u][c][r] * c1 - O[1][u][c][r] * c2; O[0][u][c][r] = o; ss += o * o; }
        ss = xrow16_sum(ss);
        const float rstd = 1.0f / sqrtf(ss * (1.0f / HD) + LN_EPS) * (1.0f - LAMBDA_INIT[layer]);
        int tq = tq0 + 16 * u; asm volatile("" : "+v"(tq));
        const bf16* grow = gp + (size_t)tq * NPROJ;
        bf16* orow = W_MIX + (size_t)(b * SEQ + tq) * DM + MX_DIFF + h * HD;
#pragma unroll
        for (int c = 0; c < 8; ++c) { const int d = 16 * c + 4 * ge;
            const u32x2 gw = *(const GAS u32x2*)(grow + d); const f32x4 gn = *(const GAS f32x4*)(gain + d);
            const float y0 = O[0][u][c][0] * rstd * gn.x * silu_f(bf_lo(gw.x)), y1 = O[0][u][c][1] * rstd * gn.y * silu_f(bf_hi(gw.x));
            const float y2 = O[0][u][c][2] * rstd * gn.z * silu_f(bf_lo(gw.y)), y3 = O[0][u][c][3] * rstd * gn.w * silu_f(bf_hi(gw.y));
            u32x2 w; w.x = pkbf(y0, y1); w.y = pkbf(y2, y3); *(GAS u32x2*)(orow + d) = w;
            if (c & 1) asm volatile("" ::: "memory"); }
    }
    asm volatile("s_waitcnt vmcnt(0)" ::: "memory");
}

__device__ __forceinline__ float xor_partner(float own, unsigned s0, unsigned s1) { return __uint_as_float(s0 ^ s1 ^ __float_as_uint(own)); }
__device__ __forceinline__ void sb_group32(bool diag, f32x4 (&S)[2], float& R, bf16x8& pb, int kq  , int g) {
    float u[2][4], be[2][4];
#pragma unroll
    for (int a = 0; a < 2; ++a)
#pragma unroll
        for (int r = 0; r < 4; ++r) { const float e = __builtin_amdgcn_exp2f(S[a][r]); const float uu = __builtin_amdgcn_rcpf(1.0f + e); u[a][r] = uu; be[a][r] = e * uu; }
    if (diag) {
        int kql = kq; asm volatile("" : "+v"(kql));
#pragma unroll
        for (int a = 0; a < 2; ++a)
#pragma unroll
            for (int r = 0; r < 4; ++r) if (kql + 16 * a + r >= 0) { u[a][r] = 1.0f; be[a][r] = 0.f; }
    }
    float w[2][4], T[2];
#pragma unroll
    for (int a = 0; a < 2; ++a) { w[a][3] = 1.0f; w[a][2] = u[a][3]; w[a][1] = w[a][2] * u[a][2]; w[a][0] = w[a][1] * u[a][1]; T[a] = w[a][0] * u[a][0]; }
    float G[2], Tot[2];
#pragma unroll
    for (int a = 0; a < 2; ++a) {
        auto s = __builtin_amdgcn_permlane16_swap(__float_as_uint(T[a]), __float_as_uint(T[a]), false, false);
        const float pt = xor_partner(T[a], s[0], s[1]), pp = T[a] * pt;
        auto t = __builtin_amdgcn_permlane32_swap(__float_as_uint(pp), __float_as_uint(pp), false, false);
        const float po = xor_partner(pp, t[0], t[1]);
        G[a] = ((g & 1) ? 1.0f : pt) * ((g < 2) ? po : 1.0f); Tot[a] = pp * po; }
    const float c1 = R * G[1], c0 = R * Tot[1] * G[0];
#pragma unroll
    for (int r = 0; r < 4; ++r) { S[1][r] = be[1][r] * (c1 * w[1][r]); S[0][r] = be[0][r] * (c0 * w[0][r]); }
    R = R * Tot[1] * Tot[0];
    u32x4 pw; pw.x = pkbf(S[0][0], S[0][1]); pw.y = pkbf(S[0][2], S[0][3]); pw.z = pkbf(S[1][0], S[1][1]); pw.w = pkbf(S[1][2], S[1][3]);
    pb = __builtin_bit_cast(bf16x8, pw);
}
__device__ __forceinline__ void sb_unit2(Frame& F, int b, int h, int qb) {
    const int tid_ = opaque_tid(), lane = tid_ & 63;
    const int wave = F.wave, li = lane & 15, g = lane >> 4;
    const int q0 = 256 * qb, tq0 = q0 + 32 * wave + li;
    const bf16* base = W_PROJ + (size_t)(b * SEQ) * NPROJ;
    const bf16* qp = base + C_SQ + h * HD; const bf16* kp = base + C_SK + h * HD; const bf16* vp = base + C_SV + h * HD; const bf16* gp = base + C_SG + h * HD;
    LAS unsigned char* kring = F.lds + DK_RING; LAS unsigned char* vring = F.lds + DV_RING;
    const int jt0 = 4 * qb + 3;
#pragma unroll
    for (int i = 0; i < 8; ++i) { const int row = 32 * wave + 4 * i + (lane >> 4), slot = lane & 15;
        glds16(qp + (size_t)(q0 + row) * NPROJ + 8 * (slot ^ swz_k(row)), (unsigned)(size_t)(F.lds + DQ_IMG + 1024 * (8 * wave + i))); }
    unsigned dmo[4]; kv_dma_offsets(dmo, wave, lane);
    kv_dma(kring, vring, kp, vp, 64 * jt0, wave, dmo);
    f32x4 O[2][8]; float R[2] = {1.0f, 1.0f};
#pragma unroll
    for (int u = 0; u < 2; ++u)
#pragma unroll
        for (int c = 0; c < 8; ++c) O[u][c] = (f32x4){0.f, 0.f, 0.f, 0.f};
    unsigned kr[4], va[8];
    {   const int q = li >> 2, p = lane & 3; const unsigned vb = (unsigned)(size_t)vring;
#pragma unroll
        for (int s = 0; s < 4; ++s) kr[s] = 256 * li + 16 * ((4 * s + g) ^ swz_k(li));
#pragma unroll
        for (int c = 0; c < 8; ++c) va[c] = vb + 256 * (4 * g + q) + 16 * ((2 * c + (p >> 1)) ^ swz_v(4 * g + q)) + 8 * (p & 1); }
    const unsigned qbase = (unsigned)(size_t)(F.lds + DQ_IMG) + 256 * 32 * wave;
    asm volatile("s_waitcnt vmcnt(0)" ::: "memory");
    bf16x8 qf[2][4];
#pragma unroll
    for (int u = 0; u < 2; ++u)
#pragma unroll
        for (int s = 0; s < 4; ++s) qf[u][s] = *(const LAS bf16x8*)(qbase + kr[s] + 256 * (16 * u));
    int slot = 0; bool started = false;
    for (int jt = jt0; jt >= 0; --jt) {
        asm volatile("s_waitcnt vmcnt(0)\n\ts_barrier" ::: "memory");
        if (jt != jt0) {
            unsigned alld = 1u;
#pragma unroll
            for (int w = 0; w < 8; ++w) alld &= F.MISC[8 + 8 * (slot ^ 1) + w];
            if (__builtin_amdgcn_readfirstlane((int)alld)) break;
        }
        if (jt >= 1) kv_dma(kring + (slot ^ 1) * KV_TILE_BYTES, vring + (slot ^ 1) * KV_TILE_BYTES, kp, vp, 64 * (jt - 1), wave, dmo);
        const int k0 = 64 * jt;
        if (k0 <= q0 + 32 * wave + 30) {
            const bool diag = (k0 + 63 >= q0 + 32 * wave);
            const unsigned kb = (unsigned)(size_t)kring + slot * KV_TILE_BYTES;
            const int kq0 = k0 + 4 * g - tq0;
#pragma unroll
            for (int hh = 1; hh >= 0; --hh) {
                f32x4 S0[2], S1[2];
#pragma unroll
                for (int a = 0; a < 2; ++a) { S0[a] = (f32x4){0.f, 0.f, 0.f, 0.f}; S1[a] = (f32x4){0.f, 0.f, 0.f, 0.f};
#pragma unroll
                    for (int s = 0; s < 4; ++s) { const bf16x8 kf = *(const LAS bf16x8*)(kb + kr[s] + 256 * (32 * hh + 16 * a)); S0[a] = mfma16(kf, qf[0][s], S0[a]); S1[a] = mfma16(kf, qf[1][s], S1[a]); } }
                SCHED_FENCE();
                bf16x8 vv[4];
#pragma unroll
                for (int c = 0; c < 4; ++c) vv[c] = cat8(tr_read((const LAS unsigned char*)(va[c] + 256 * (32 * hh))), tr_read((const LAS unsigned char*)(va[c] + 256 * (32 * hh + 16))));
                SCHED_FENCE();
                bf16x8 pb0, pb1;
                sb_group32(diag, S0, R[0], pb0, kq0 + 32 * hh, g);
                sb_group32(diag, S1, R[1], pb1, kq0 + 32 * hh - 16, g);
                SCHED_FENCE();
#pragma unroll
                for (int c = 0; c < 4; ++c) { O[0][c] = mfma16(vv[c], pb0, O[0][c]); O[1][c] = mfma16(vv[c], pb1, O[1][c]); }
                SCHED_FENCE();
#pragma unroll
                for (int c = 0; c < 4; ++c) vv[c] = cat8(tr_read((const LAS unsigned char*)(va[4 + c] + 256 * (32 * hh))), tr_read((const LAS unsigned char*)(va[4 + c] + 256 * (32 * hh + 16))));
                SCHED_FENCE();
#pragma unroll
                for (int c = 0; c < 4; ++c) { O[0][4 + c] = mfma16(vv[c], pb0, O[0][4 + c]); O[1][4 + c] = mfma16(vv[c], pb1, O[1][4 + c]); }
                SCHED_FENCE();
            }
            started = true;
        }
        {   const bool wdone = started && __all(R[0] == 0.f && R[1] == 0.f);
            if (lane == 0) F.MISC[8 + 8 * slot + wave] = wdone ? 1u : 0u; }
        {   const int dl = slot ? -KV_TILE_BYTES : KV_TILE_BYTES;
#pragma unroll
            for (int c = 0; c < 8; ++c) va[c] += dl; }
        slot ^= 1;
    }
    int ge = g; asm volatile("" : "+v"(ge));
#pragma unroll
    for (int u = 0; u < 2; ++u) {
        int tq = tq0 + 16 * u; asm volatile("" : "+v"(tq));
        const bf16* grow = gp + (size_t)tq * NPROJ;
        bf16* orow = W_MIX + (size_t)(b * SEQ + tq) * DM + MX_SB + h * HD;
#pragma unroll
        for (int c = 0; c < 8; ++c) { const int d = 16 * c + 4 * ge;
            const u32x2 gw = *(const GAS u32x2*)(grow + d);
            const float y0 = O[u][c][0] * silu_f(bf_lo(gw.x)), y1 = O[u][c][1] * silu_f(bf_hi(gw.x)), y2 = O[u][c][2] * silu_f(bf_lo(gw.y)), y3 = O[u][c][3] * silu_f(bf_hi(gw.y));
            u32x2 w; w.x = pkbf(y0, y1); w.y = pkbf(y2, y3); *(GAS u32x2*)(orow + d) = w; }
    }
    asm volatile("s_waitcnt vmcnt(0)" ::: "memory");
}

constexpr int R_KIMG = 0, R_VIMG = IMG128, R_SIMG = 2 * IMG128, R_GTAB = 4 * IMG128;
__device__ __forceinline__ void ret_unit2(Frame& F, int b, int h, int layer) {
    const int tid = opaque_tid(), lane = tid & 63;
    int wave = F.wave; asm volatile("" : "+s"(wave));
    const int li = lane & 15, g = lane >> 4, q = li >> 2, p = lane & 3;
    const float lg2 = RET_LOG_GAMMA[h] * LOG2E;
    const float kscale = 0.08838834764831845f;
    const float cdecay = __builtin_amdgcn_exp2f(lg2 * 128.f);
    const bf16* base = W_PROJ + (size_t)(b * SEQ) * NPROJ;
    const bf16* qp = base + C_RQ + h * HD; const bf16* kp = base + C_RK + h * HD; const bf16* vp = base + C_RV + h * HD; const bf16* gp = base + C_RG + h * HD;
    float dl[4];
#pragma unroll
    for (int r = 0; r < 4; ++r) dl[r] = kscale * __builtin_amdgcn_exp2f(lg2 * (float)(li - 4 * g - r));
    const float qd = __builtin_amdgcn_exp2f(lg2 * (float)(16 * wave + li + 1));
    const unsigned lds0 = (unsigned)(size_t)F.lds;
    const unsigned a_row = lds0 + li * RS + 16 * g;
    const unsigned a_tra = lds0 + (4 * g + q) * RS + 8 * p;
    const unsigned a_trn = lds0 + (8 * g + q) * RS + 8 * p;
    LAS float* gtab = (LAS float*)(F.lds + R_GTAB);
    if (tid < HD) gtab[tid] = A_RETG[layer * RET_W + h * HD + tid];
    LAS float* kdt = gtab + 128; LAS float* g16 = gtab + 256;
    if (tid < 128) kdt[tid] = kscale * __builtin_amdgcn_exp2f(lg2 * (float)(127 - tid));
    if (tid < 8) g16[tid] = __builtin_amdgcn_exp2f(lg2 * (float)(16 * tid));
    u32x4 stK[4], stV[4];
#pragma unroll
    for (int i = 0; i < 4; ++i) { const int id = tid + 512 * i; const unsigned so = (unsigned)(id >> 4) * (NPROJ * 2) + 16 * (id & 15);
        stK[i] = *(const GAS u32x4*)((const char*)kp + so); stV[i] = *(const GAS u32x4*)((const char*)vp + so); }
    f32x4 ST[8];
#pragma unroll
    for (int d = 0; d < 8; ++d) ST[d] = (f32x4){0.f, 0.f, 0.f, 0.f};
    bf16x8 q0f, q1f, q2f, q3f;
    {   const size_t qrow = (size_t)(16 * wave + li) * NPROJ;
        q0f = *(const GAS bf16x8*)(qp + qrow + 8 * g); q1f = *(const GAS bf16x8*)(qp + qrow + 32 + 8 * g); q2f = *(const GAS bf16x8*)(qp + qrow + 64 + 8 * g); q3f = *(const GAS bf16x8*)(qp + qrow + 96 + 8 * g); }
#pragma unroll
    for (int i = 0; i < 4; ++i) { const int id = lane + 64 * i; *(LAS u32x4*)(lds0 + R_SIMG + (16 * wave + (id >> 4)) * RS + 16 * (id & 15)) = (u32x4){0u, 0u, 0u, 0u}; }
    asm volatile("" : "+v"(stK[0]), "+v"(stK[1]), "+v"(stK[2]), "+v"(stK[3]), "+v"(stV[0]), "+v"(stV[1]), "+v"(stV[2]), "+v"(stV[3]));
    for (int c = 0; c < SEQ / 128; ++c) {
        const int t0 = 128 * c;
        const int tl = opaque_tid(), li2 = tl & 15, g2 = (tl & 63) >> 4;
        asm volatile("s_barrier" ::: "memory");
#pragma unroll
        for (int i = 0; i < 4; ++i) { const int id = tl + 512 * i, row = id >> 4, sl = id & 15; *(LAS u32x4*)(lds0 + R_KIMG + row * RS + 16 * sl) = stK[i]; *(LAS u32x4*)(lds0 + R_VIMG + row * RS + 16 * sl) = stV[i]; }
        asm volatile("" ::: "memory");
        const size_t qrow = (size_t)(t0 + 16 * wave + li2) * NPROJ;
        const int tn = 128 * (c + 1);
        if (c + 1 < SEQ / 128) {
            const char* kn = (const char*)(kp + (size_t)tn * NPROJ); const char* vn = (const char*)(vp + (size_t)tn * NPROJ);
#pragma unroll
            for (int i = 0; i < 4; ++i) { const int id = tl + 512 * i; const unsigned so = (unsigned)(id >> 4) * (NPROJ * 2) + 16 * (id & 15); stK[i] = *(const GAS u32x4*)(kn + so); stV[i] = *(const GAS u32x4*)(vn + so); }
        }
        asm volatile("s_waitcnt lgkmcnt(0)\n\ts_barrier" ::: "memory");
        const int scur = R_SIMG + IMG128 * (c & 1), snxt = R_SIMG + IMG128 * ((c & 1) ^ 1);
#define R2_TRN(DST, IMG, KS, CT) DST = cat8(tr_read((const LAS unsigned char*)(a_trn + (IMG) + 32 * (KS) * RS + 32 * (CT))), tr_read((const LAS unsigned char*)(a_trn + (IMG) + 32 * (KS) * RS + 32 * (CT) + 4 * RS)))
#define R2_TRA(DST, IMG, KS, CT) DST = cat8(tr_read((const LAS unsigned char*)(a_tra + (IMG) + 32 * (KS) * RS + 32 * (CT))), tr_read((const LAS unsigned char*)(a_tra + (IMG) + 32 * (KS) * RS + 32 * (CT) + 16 * RS)))
#define R2_ROW(DST, IMG, RT, S4) DST = *(const LAS bf16x8*)(a_row + (IMG) + 16 * (RT) * RS + 64 * (S4))
#define R2_PIPE(NB, LOADF, MMAF) do { bf16x8 fa[4], fb[4]; LOADF(fa, 0); _Pragma("unroll") for (int bt = 0; bt < (NB); bt += 2) { \
            if (bt + 1 < (NB)) LOADF(fb, bt + 1); SCHED_FENCE(); MMAF(fa, bt); SCHED_FENCE(); \
            if (bt + 1 < (NB)) { if (bt + 2 < (NB)) LOADF(fa, bt + 2); SCHED_FENCE(); MMAF(fb, bt + 1); SCHED_FENCE(); } } } while (0)
        {   bf16x8 vfd[4];
            {   bf16x8 vn[4];
#pragma unroll
                for (int ks = 0; ks < 4; ++ks) R2_TRN(vn[ks], R_VIMG, ks, wave);
#pragma unroll
                for (int ks = 0; ks < 4; ++ks) { u32x4 w; const u32x4 vw = __builtin_bit_cast(u32x4, vn[ks]);
                    const f32x4 kd0 = *(const LAS f32x4*)(kdt + 32 * ks + 8 * g), kd1 = *(const LAS f32x4*)(kdt + 32 * ks + 8 * g + 4);
                    w[0] = pkbf(bf_lo(vw[0]) * kd0.x, bf_hi(vw[0]) * kd0.y); w[1] = pkbf(bf_lo(vw[1]) * kd0.z, bf_hi(vw[1]) * kd0.w);
                    w[2] = pkbf(bf_lo(vw[2]) * kd1.x, bf_hi(vw[2]) * kd1.y); w[3] = pkbf(bf_lo(vw[3]) * kd1.z, bf_hi(vw[3]) * kd1.w);
                    vfd[ks] = __builtin_bit_cast(bf16x8, w); } }
#pragma unroll
            for (int dt = 0; dt < 8; ++dt) ST[dt] = ST[dt] * cdecay;
            SCHED_FENCE();
#define R2_LD_ST(F, BT) do { _Pragma("unroll") for (int ks = 0; ks < 4; ++ks) R2_TRN(F[ks], R_KIMG, ks, (BT)); } while (0)
#define R2_MM_ST(F, BT) do { _Pragma("unroll") for (int ks = 0; ks < 4; ++ks) ST[(BT)] = mfma16(vfd[ks], F[ks], ST[(BT)]); } while (0)
            R2_PIPE(8, R2_LD_ST, R2_MM_ST);
#pragma unroll
            for (int dt = 0; dt < 8; ++dt)
#pragma unroll
                for (int r = 0; r < 4; ++r) *(LAS unsigned short*)(lds0 + (16 * wave + 4 * g2) * RS + 2 * li2 + snxt + r * RS + 32 * dt) = (unsigned short)(pkbf(ST[dt][r], 0.f) & 0xffffu);
        }
        SCHED_FENCE();
        f32x4 OUT[8];
#define R2_LD_CR(F, BT) do { _Pragma("unroll") for (int s = 0; s < 4; ++s) R2_ROW(F[s], scur, (BT), s); } while (0)
#define R2_MM_CR(F, BT) do { f32x4 acc = (f32x4){0.f, 0.f, 0.f, 0.f}; acc = mfma16(F[0], q0f, acc); acc = mfma16(F[1], q1f, acc); acc = mfma16(F[2], q2f, acc); acc = mfma16(F[3], q3f, acc); OUT[(BT)] = acc * qd; } while (0)
        R2_PIPE(8, R2_LD_CR, R2_MM_CR);
        SCHED_FENCE();
        bf16x8 pb[4];
        {   unsigned pk[8][2];
#define R2_LD_SC(F, BT) do { if ((BT) <= wave) { _Pragma("unroll") for (int s = 0; s < 4; ++s) R2_ROW(F[s], R_KIMG, (BT), s); } } while (0)
#define R2_MM_SC(F, BT) do { if ((BT) <= wave) { f32x4 S = (f32x4){0.f, 0.f, 0.f, 0.f}; S = mfma16(F[0], q0f, S); S = mfma16(F[1], q1f, S); S = mfma16(F[2], q2f, S); S = mfma16(F[3], q3f, S); \
                const float dtf = g16[wave - (BT)]; _Pragma("unroll") for (int r = 0; r < 4; ++r) { const float v = S[r] * (dl[r] * dtf); S[r] = ((BT) < wave || li - 4 * g - r >= 0) ? v : 0.f; } \
                pk[(BT)][0] = pkbf(S[0], S[1]); pk[(BT)][1] = pkbf(S[2], S[3]); } else { pk[(BT)][0] = 0u; pk[(BT)][1] = 0u; } } while (0)
            R2_PIPE(8, R2_LD_SC, R2_MM_SC);
#pragma unroll
            for (int ks = 0; ks < 4; ++ks) { u32x4 w; w.x = pk[2 * ks][0]; w.y = pk[2 * ks][1]; w.z = pk[2 * ks + 1][0]; w.w = pk[2 * ks + 1][1]; pb[ks] = __builtin_bit_cast(bf16x8, w); }
        }
        SCHED_FENCE();
        u32x2 gc[8];
#pragma unroll
        for (int et = 0; et < 8; ++et) gc[et] = *(const GAS u32x2*)(gp + qrow + 16 * et + 4 * g2);
        if (c + 1 < SEQ / 128) { const size_t qn = (size_t)(tn + 16 * wave + li2) * NPROJ;
            q0f = *(const GAS bf16x8*)(qp + qn + 8 * g2); q1f = *(const GAS bf16x8*)(qp + qn + 32 + 8 * g2); q2f = *(const GAS bf16x8*)(qp + qn + 64 + 8 * g2); q3f = *(const GAS bf16x8*)(qp + qn + 96 + 8 * g2); }
        SCHED_FENCE();
#define R2_LD_IN(F, BT) do { if (2 * ((BT) >> 1) <= wave) { _Pragma("unroll") for (int e4 = 0; e4 < 4; ++e4) R2_TRA(F[e4], R_VIMG, (BT) >> 1, 4 * ((BT) & 1) + e4); } } while (0)
#define R2_MM_IN(F, BT) do { if (2 * ((BT) >> 1) <= wave) { _Pragma("unroll") for (int e4 = 0; e4 < 4; ++e4) OUT[4 * ((BT) & 1) + e4] = mfma16(F[e4], pb[(BT) >> 1], OUT[4 * ((BT) & 1) + e4]); } } while (0)
        R2_PIPE(8, R2_LD_IN, R2_MM_IN);
#undef R2_LD_ST
#undef R2_MM_ST
#undef R2_LD_CR
#undef R2_MM_CR
#undef R2_LD_SC
#undef R2_MM_SC
#undef R2_LD_IN
#undef R2_MM_IN
#undef R2_PIPE
#undef R2_TRN
#undef R2_TRA
#undef R2_ROW
        SCHED_FENCE();
        {   float s1 = 0.f, s2 = 0.f;
#pragma unroll
            for (int et = 0; et < 8; ++et)
#pragma unroll
                for (int r = 0; r < 4; ++r) { s1 += OUT[et][r]; s2 = fmaf(OUT[et][r], OUT[et][r], s2); }
            s1 = xrow16_sum(s1); s2 = xrow16_sum(s2);
            const float mean = s1 * (1.0f / HD), var = fmaxf(s2 * (1.0f / HD) - mean * mean, 0.f), rstd = 1.0f / sqrtf(var + LN_EPS);
            asm volatile("" : "+v"(stK[0]), "+v"(stK[1]), "+v"(stK[2]), "+v"(stK[3]), "+v"(stV[0]), "+v"(stV[1]), "+v"(stV[2]), "+v"(stV[3]));
            bf16* orow = W_MIX + (size_t)(b * SEQ + t0 + 16 * wave + li2) * DM + MX_RET + h * HD + 4 * g2;
#pragma unroll
            for (int et = 0; et < 8; ++et) {
                const f32x4 gv = *(const LAS f32x4*)(gtab + 16 * et + 4 * g);
                const float y0 = (OUT[et][0] - mean) * rstd * gv.x * silu_f(bf_lo(gc[et].x)), y1 = (OUT[et][1] - mean) * rstd * gv.y * silu_f(bf_hi(gc[et].x));
                const float y2 = (OUT[et][2] - mean) * rstd * gv.z * silu_f(bf_lo(gc[et].y)), y3 = (OUT[et][3] - mean) * rstd * gv.w * silu_f(bf_hi(gc[et].y));
                u32x2 w; w.x = pkbf(y0, y1); w.y = pkbf(y2, y3); *(GAS u32x2*)(orow + 16 * et) = w; }
        }
    }
    asm volatile("s_waitcnt vmcnt(0) lgkmcnt(0)" ::: "memory");
}

__global__ void __launch_bounds__(NWAVES * 64, 2) mk_fwd(Args kernel_args  ) {
    extern __shared__ __attribute__((aligned(16))) unsigned char lds_raw[];
    Frame F;
    F.lds = (LAS unsigned char*)lds_raw;
    F.MISC = (volatile LAS unsigned*)(F.lds + MISC_OFF);
    F.wave = __builtin_amdgcn_readfirstlane((int)threadIdx.x >> 6);
    for (int u = F.wave * 64 + opaque_lane(); u < (LDS_BYTES - MISC_OFF) / 4; u += NWAVES * 64) F.MISC[u] = 0u;
    __syncthreads();
    XcdBarrier bar = xcd_barrier_post((unsigned*)(W_CTL + CW_BAR), F.MISC, (unsigned)F.wave);
#define GRID_BAR() do { XcdBarrier b_ = bar; asm volatile("" : "+s"(b_.bar), "+s"(b_.x)); xcd_barrier(b_); } while (0)

    p0_prologue(F);
    GRID_BAR();

    for (int layer = 0; layer < DEPTH; ++layer) {
        {   pg8::Gemm g{W_XB, W_WINT + (size_t)layer * NPROJ * DM, M, NPROJ, DM}; pg8::StaticOrder S; int c_ = (int)blockIdx.x; asm volatile("" : "+s"(c_)); S.init(M, NPROJ, (int)gridDim.x, c_);
            pg8::EpiBf16 E{W_PROJ, NPROJ, C_DQ / 256, (C_DQ + DIFF_W) / 256, 0.125f * LOG2E, C_SQ / 256, (C_SQ + SB_W) / 256, 0.08838834764831845f * LOG2E, F.lds + pg8::STAGE_BYTES};
            pg8::gemm_phase<pg8::EpiBf16, pg8::StaticOrder, true, true>(F.lds, g, S, E, F.wave); }
        GRID_BAR();
        {   if (F.wave == 0) {
                const int ln = opaque_lane();
                const float a = A_LQ1[layer * 64 + ln] * A_LK1[layer * 64 + ln], c = A_LQ2[layer * 64 + ln] * A_LK2[layer * 64 + ln];
                const float lam = __expf(wave_sum(a)) - __expf(wave_sum(c)) + LAMBDA_INIT[layer];
                if (ln == 0) F.MISC[5] = __float_as_uint(lam); }
            gu32* qh = W_CTL + CW_Q + layer * 16 * 64;
            const int wg = (int)blockIdx.x;
            if (wg < BATCH * N_RET) { knorm_prepass(F, layer, F.wave); __syncthreads(); ret_unit2(F, wg / N_RET, wg % N_RET, layer); }
            {   constexpr int ND = BATCH * N_DIFF * (SEQ / 256), NSTAT = 256 - BATCH * N_RET;
                int u = wg >= BATCH * N_RET ? wg - BATCH * N_RET : NSTAT + next_unit(F, qh + 4 * 64);
                while (u < ND) { __syncthreads(); const int oc = DIFF_ORDER[u >> 2]; diff_unit2(F, u & 3, oc & 15, oc >> 4, layer); u = NSTAT + next_unit(F, qh + 4 * 64); } }
            {   constexpr int NSB = BATCH * N_SB * (SEQ / 256);
                int u = wg;
                while (u < NSB) { __syncthreads(); const int qb = SEQ / 256 - 1 - u / (BATCH * N_SB), bh = u % (BATCH * N_SB); sb_unit2(F, bh / N_SB, bh % N_SB, qb); u = 256 + next_unit(F, qh + 8 * 64); } }
        }
        GRID_BAR();
        {   pg8::Gemm g{W_MIX, W_WOUTT + (size_t)layer * DM * DM, M, DM, DM}; pg8::PanelOrder S; int c_ = (int)blockIdx.x; asm volatile("" : "+s"(c_)); S.init(M, c_);
            const float* xin = layer == 0 ? A_X : (const float*)((layer - 1) & 1 ? W_H : W_XH);
            float* xout = layer == DEPTH - 1 ? args.out : ((layer & 1) ? W_H : W_XH);
            pg8::EpiLnFused E{xin, xout, layer == DEPTH - 1 ? (bf16*)nullptr : W_XB, DM, DEEPNORM_ALPHA, A_LNG + layer * DM, A_LNB + layer * DM,
                              (unsigned long long*)(args.ws + WS_SLOTS), (unsigned*)(W_CTL + CW_LNC + layer * 64 * 64), (unsigned*)(W_CTL + CW_TMO), F.lds + 131072, F.wave};
            pg8::gemm_phase<pg8::EpiLnFused, pg8::PanelOrder, true, true>(F.lds, g, S, E, F.wave); }
        if (layer != DEPTH - 1) GRID_BAR();
    }
#undef GRID_BAR
}

extern "C" void kernel_launch(void* const* d_in, const int* in_sizes, int n_in, void* d_out, int out_size, void* d_ws, size_t ws_size, hipStream_t stream) {
    static int grid = 0;
    if (grid == 0) {
        if (n_in != 11 || in_sizes[0] != M * DM || out_size != M * DM || ws_size < WS_END) { fprintf(stderr, "kernel_launch: unexpected shapes (n_in %d, in0 %d, out %d, ws %zu); nothing launched\n", n_in, n_in > 0 ? in_sizes[0] : -1, out_size, ws_size); grid = -1; return; }
        int dev = 0, cus = 0, per_cu = 0;
        if (hipGetDevice(&dev) != hipSuccess || hipDeviceGetAttribute(&cus, hipDeviceAttributeMultiprocessorCount, dev) != hipSuccess) { grid = -1; return; }
        if (hipFuncSetAttribute((const void*)mk_fwd, hipFuncAttributeMaxDynamicSharedMemorySize, LDS_BYTES) != hipSuccess) { fprintf(stderr, "kernel_launch: hipFuncSetAttribute failed\n"); grid = -1; return; }
        if (hipOccupancyMaxActiveBlocksPerMultiprocessor(&per_cu, (const void*)mk_fwd, NWAVES * 64, LDS_BYTES) != hipSuccess || per_cu < 1) { fprintf(stderr, "kernel_launch: occupancy query reports %d workgroups per CU\n", per_cu); }
        (void)hipGetLastError();
        grid = cus;
        if (grid != 256) { fprintf(stderr, "kernel_launch: this build's fused output projection + LayerNorm needs exactly 256 workgroups (a 256-CU MI355X); found %d CUs; nothing launched\n", cus); grid = -1; return; }
    }
    if (grid < 0) return;
    if (hipMemsetAsync((char*)d_ws + WS_CTL, 0, CTL_ZERO_BYTES, stream) != hipSuccess) return;
    Args a{};
    for (int i = 0; i < 11; ++i) a.in[i] = (const float*)d_in[i];
    a.out = (float*)d_out; a.ws = (unsigned char*)d_ws;
    hipLaunchKernelGGL(mk_fwd, dim3(grid), dim3(NWAVES * 64), LDS_BYTES, stream, a);
}
```
